# Optimizing an MI355X kernel written in HIP

```python
import math
import jax
import jax.numpy as jnp
from jax import lax
import numpy as np

D_MODEL = 1024
BATCH = 16
SEQ = 2048
DEPTH = 2

N_GROUPS = 4
GROUP_WIDTH = D_MODEL // N_GROUPS
HEADS = 4
HEAD_DIM = GROUP_WIDTH // HEADS
GDN_CONV = 4
GDN_CHUNK = 64
HGRN_CHUNK = 16
MOBA_BLOCK = 256
MOBA_TOPK = 3
MOBA_Q_CHUNK = 32
DIFF_DIM = HEAD_DIM // 2
ATTN_Q_BLOCK = 128
NORM_EPS = 1e-6
GDN_COLS = 4 * GROUP_WIDTH + 2 * HEADS
HGRN_COLS = 4 * GROUP_WIDTH
MOBA_COLS = 4 * GROUP_WIDTH
DIFF_COLS = 4 * GROUP_WIDTH
IN_COLS = GDN_COLS + HGRN_COLS + MOBA_COLS + DIFF_COLS

kernel_name = 'hybrid_parallel_heads_gdn_hgrn2_moba_diffattn'


def rmsnorm(x, g):
    xf = x.astype(jnp.float32)
    y = xf * lax.rsqrt(jnp.mean(xf * xf, axis=-1, keepdims=True) + NORM_EPS)
    return y * g.astype(jnp.float32)


def l2norm(x):
    return x * lax.rsqrt(jnp.sum(x * x, axis=-1, keepdims=True) + NORM_EPS)


def to_heads(t):
    B, T, _ = t.shape
    return t.reshape(B, T, HEADS, -1).transpose(0, 2, 1, 3)


def from_heads(t):
    B, H, T, d = t.shape
    return t.transpose(0, 2, 1, 3).reshape(B, T, H * d)


def causal_conv(x, w):
    K = w.shape[0]
    T = x.shape[1]
    xp = jnp.pad(x, ((0, 0), (K - 1, 0), (0, 0)))
    return sum(xp[:, j:j + T] * w[j] for j in range(K))


def gated_delta_rule(q, k, v, g, beta):
    B, H, T, dk = q.shape
    dv = v.shape[-1]
    C = GDN_CHUNK
    N = T // C

    def chunks(t):
        return t.reshape(B, H, N, C, *t.shape[3:])

    q = chunks(q * dk ** -0.5)
    k = chunks(k)
    v = chunks(v)
    beta = chunks(beta)
    g = jnp.cumsum(chunks(g), axis=-1)
    lower = jnp.tril(jnp.ones((C, C), dtype=bool))
    strict = jnp.tril(jnp.ones((C, C), dtype=bool), -1)
    decay = jnp.exp(jnp.where(lower, g[..., :, None] - g[..., None, :], -jnp.inf))
    k_beta = k * beta[..., None]
    a_kk = jnp.where(strict, jnp.einsum('bhncd,bhnsd->bhncs', k_beta, k) * decay, 0.0)
    eye = jnp.eye(C, dtype=q.dtype)
    t_inv = lax.linalg.triangular_solve(eye + a_kk, jnp.broadcast_to(eye, a_kk.shape),
                                        left_side=True, lower=True, unit_diagonal=True)
    u = t_inv @ (v * beta[..., None])
    w = t_inv @ (k_beta * jnp.exp(g)[..., None])
    a_qk = jnp.einsum('bhncd,bhnsd->bhncs', q, k) * decay
    q_dec = q * jnp.exp(g)[..., None]
    k_dec = k * jnp.exp(g[..., -1:] - g)[..., None]
    d_last = jnp.exp(g[..., -1])

    def step(S, inp):
        q_c, k_c, u_c, w_c, a_c, d_c = inp
        v_new = u_c - w_c @ S
        o = q_c @ S + a_c @ v_new
        S = S * d_c[..., None, None] + jnp.einsum('bhcd,bhce->bhde', k_c, v_new)
        return S, o

    xs = tuple(jnp.moveaxis(t, 2, 0) for t in (q_dec, k_dec, u, w, a_qk, d_last))
    _, o = lax.scan(step, jnp.zeros((B, H, dk, dv), q.dtype), xs)
    return jnp.moveaxis(o, 0, 2).reshape(B, H, T, dv)


def gdn_branch(p, conv_w, a_log, dt_bias, norm_g):
    W = GROUP_WIDTH
    qkv, a, b, z = jnp.split(p, [3 * W, 3 * W + HEADS, 3 * W + 2 * HEADS], axis=-1)
    qkv = jax.nn.silu(causal_conv(qkv, conv_w.astype(jnp.float32)))
    q, k, v = jnp.split(qkv, 3, axis=-1)
    q = l2norm(to_heads(q))
    k = l2norm(to_heads(k))
    v = to_heads(v)
    g = -jnp.exp(a_log.astype(jnp.float32)) * jax.nn.softplus(a + dt_bias.astype(jnp.float32))
    beta = jax.nn.sigmoid(b)
    o = gated_delta_rule(q, k, v, g.transpose(0, 2, 1), beta.transpose(0, 2, 1))
    return from_heads(rmsnorm(o, norm_g)) * jax.nn.silu(z)


def hgrn2_recurrence(q, k, v, log_f):
    B, H, T, dk = q.shape
    dv = v.shape[-1]
    C = HGRN_CHUNK
    N = T // C
    MID = C // 2

    def chunks(t):
        return t.reshape(B, H, N, C, t.shape[-1])

    q, k, v = chunks(q), chunks(k), chunks(v)
    G = jnp.cumsum(chunks(log_f), axis=3)
    G_ref = G[..., MID:MID + 1, :]
    causal = jnp.tril(jnp.ones((C, C), dtype=bool))
    a_qk = jnp.einsum('bhncd,bhnsd->bhncs', q * jnp.exp(G - G_ref), k * jnp.exp(G_ref - G))
    o_intra = jnp.where(causal, a_qk, 0.0) @ v
    q_dec = q * jnp.exp(G)
    k_dec = k * jnp.exp(G[..., -1:, :] - G)
    d_last = jnp.exp(G[..., -1, :])

    def step(S, inp):
        q_c, k_c, v_c, d_c, oi = inp
        o = q_c @ S + oi
        S = S * d_c[..., :, None] + jnp.einsum('bhcd,bhce->bhde', k_c, v_c)
        return S, o

    xs = tuple(jnp.moveaxis(t, 2, 0) for t in (q_dec, k_dec, v, d_last, o_intra))
    _, o = lax.scan(step, jnp.zeros((B, H, dk, dv), q.dtype), xs)
    return jnp.moveaxis(o, 0, 2).reshape(B, H, T, dv)


def hgrn2_branch(p, lb, norm_g):
    q, f, i, z = jnp.split(p, 4, axis=-1)
    log_f = jnp.logaddexp(jnp.log(lb), jnp.log1p(-lb) + jax.nn.log_sigmoid(f))
    k = (1.0 - lb) * jax.nn.sigmoid(-f)
    q = jax.nn.silu(q)
    o = hgrn2_recurrence(to_heads(q), to_heads(k), to_heads(i), to_heads(log_f))
    return from_heads(rmsnorm(o, norm_g)) * jax.nn.silu(z)


def moba_attention(q, k, v, slopes):
    B, H, T, d = q.shape
    Tp = -(-T // MOBA_BLOCK) * MOBA_BLOCK
    pad = ((0, 0), (0, 0), (0, Tp - T), (0, 0))
    q, k, v = jnp.pad(q, pad), jnp.pad(k, pad), jnp.pad(v, pad)
    nb = Tp // MOBA_BLOCK
    kk = min(MOBA_TOPK, nb)
    scale = d ** -0.5
    kb = k.reshape(B, H, nb, MOBA_BLOCK, d)
    vb = v.reshape(B, H, nb, MOBA_BLOCK, d)
    gate = jnp.einsum('bhtd,bhnd->bhtn', q, kb.mean(axis=3))
    past = jnp.arange(nb)[None, :] < (jnp.arange(Tp) // MOBA_BLOCK)[:, None]
    _, sel = lax.top_k(jnp.where(past, gate, -jnp.inf), kk)
    bi = jnp.arange(B)[:, None, None, None]
    hi = jnp.arange(H)[None, :, None, None]
    blk = jnp.arange(MOBA_BLOCK)

    def chunk_fn(c):
        t0 = c * MOBA_Q_CHUNK
        qc = lax.dynamic_slice_in_dim(q, t0, MOBA_Q_CHUNK, axis=2)
        sel_c = lax.dynamic_slice_in_dim(sel, t0, MOBA_Q_CHUNK, axis=2)
        pos_q = t0 + jnp.arange(MOBA_Q_CHUNK)
        own = t0 // MOBA_BLOCK
        k_sel = kb[bi, hi, sel_c]
        v_sel = vb[bi, hi, sel_c]
        s_sel = jnp.einsum('bhqd,bhqnsd->bhqns', qc, k_sel) * scale
        dist_sel = pos_q[None, None, :, None, None] - (sel_c[..., None] * MOBA_BLOCK + blk)
        s_sel = s_sel - slopes[None, :, None, None, None] * dist_sel
        s_sel = jnp.where((sel_c < own)[..., None], s_sel, -jnp.inf)
        k_own = lax.dynamic_slice_in_dim(kb, own, 1, axis=2)[:, :, 0]
        v_own = lax.dynamic_slice_in_dim(vb, own, 1, axis=2)[:, :, 0]
        dist_own = pos_q[:, None] - (own * MOBA_BLOCK + blk)[None, :]
        s_own = jnp.einsum('bhqd,bhsd->bhqs', qc, k_own) * scale - slopes[None, :, None, None] * dist_own
        s_own = jnp.where(dist_own >= 0, s_own, -jnp.inf)
        logits = jnp.concatenate([s_sel.reshape(B, H, MOBA_Q_CHUNK, kk * MOBA_BLOCK), s_own], axis=-1)
        pr = jax.nn.softmax(logits.astype(jnp.float32), axis=-1)
        p_sel = pr[..., :kk * MOBA_BLOCK].reshape(B, H, MOBA_Q_CHUNK, kk, MOBA_BLOCK)
        p_own = pr[..., kk * MOBA_BLOCK:]
        return (jnp.einsum('bhqns,bhqnsd->bhqd', p_sel, v_sel)
                + jnp.einsum('bhqs,bhsd->bhqd', p_own, v_own))

    outs = lax.map(chunk_fn, jnp.arange(Tp // MOBA_Q_CHUNK))
    return jnp.moveaxis(outs, 0, 2).reshape(B, H, Tp, d)[:, :, :T]


def moba_branch(p, slopes):
    q, k, v, z = jnp.split(p, 4, axis=-1)
    o = moba_attention(to_heads(q), to_heads(k), to_heads(v), slopes)
    return from_heads(o) * jax.nn.silu(z)


def differential_attention(q1, q2, k1, k2, v, lam, slopes):
    T, d = q1.shape[2], q1.shape[3]
    scale = d ** -0.5
    outs = []
    for s in range(0, T, ATTN_Q_BLOCK):
        e = s + ATTN_Q_BLOCK
        dist = jnp.arange(s, e)[:, None] - jnp.arange(e)[None, :]
        bias = jnp.where(dist >= 0, -slopes[:, None, None] * dist, -jnp.inf)
        a1 = jax.nn.softmax(jnp.einsum('bhqd,bhkd->bhqk', q1[:, :, s:e], k1[:, :, :e]) * scale + bias, axis=-1)
        a2 = jax.nn.softmax(jnp.einsum('bhqd,bhkd->bhqk', q2[:, :, s:e], k2[:, :, :e]) * scale + bias, axis=-1)
        outs.append(jnp.einsum('bhqk,bhkd->bhqd', a1 - lam * a2, v[:, :, :e]))
    return jnp.concatenate(outs, axis=2)


def diff_branch(p, lq1, lk1, lq2, lk2, norm_g, lam_init, slopes):
    B, T, _ = p.shape
    q, k, v, z = jnp.split(p, 4, axis=-1)
    q = q.reshape(B, T, HEADS, 2, DIFF_DIM).transpose(3, 0, 2, 1, 4)
    k = k.reshape(B, T, HEADS, 2, DIFF_DIM).transpose(3, 0, 2, 1, 4)
    f32 = jnp.float32
    lam = (jnp.exp(jnp.dot(lq1.astype(f32), lk1.astype(f32)))
           - jnp.exp(jnp.dot(lq2.astype(f32), lk2.astype(f32))) + lam_init)
    o = differential_attention(q[0], q[1], k[0], k[1], to_heads(v), lam, slopes)
    o = rmsnorm(o, norm_g) * (1.0 - lam_init)
    return from_heads(o) * jax.nn.silu(z)


def setup_inputs(seed: int = 0) -> dict:
    key = jax.random.key(seed)
    ks = jax.random.split(key, 16)
    f32 = jnp.float32

    def nrm(k, shape, s):
        return s * jax.random.normal(k, shape, f32)

    def gain(k, shape):
        return 1.0 + nrm(k, shape, 0.02)

    dt = jnp.exp(jax.random.uniform(ks[5], (DEPTH, HEADS), f32, math.log(1e-3), math.log(1e-1)))
    return {
        'x': nrm(ks[0], (BATCH, SEQ, D_MODEL), 1.0),
        'pre_norm_g': gain(ks[1], (DEPTH, D_MODEL)),
        'post_norm_g': gain(ks[2], (DEPTH, D_MODEL)),
        'w_in': nrm(ks[3], (DEPTH, D_MODEL, IN_COLS), D_MODEL ** -0.5),
        'conv_w': nrm(ks[4], (DEPTH, GDN_CONV, 3 * GROUP_WIDTH), GDN_CONV ** -0.5),
        'gdn_a_log': jnp.log(jax.random.uniform(ks[6], (DEPTH, HEADS), f32, 1.0, 16.0)),
        'gdn_dt_bias': dt + jnp.log(-jnp.expm1(-dt)),
        'gdn_norm_g': gain(ks[7], (DEPTH, HEAD_DIM)),
        'hgrn_lb': nrm(ks[8], (DEPTH, GROUP_WIDTH), 0.1),
        'hgrn_norm_g': gain(ks[9], (DEPTH, HEAD_DIM)),
        'diff_lq1': nrm(ks[10], (DEPTH, DIFF_DIM), 0.1),
        'diff_lk1': nrm(ks[11], (DEPTH, DIFF_DIM), 0.1),
        'diff_lq2': nrm(ks[12], (DEPTH, DIFF_DIM), 0.1),
        'diff_lk2': nrm(ks[13], (DEPTH, DIFF_DIM), 0.1),
        'diff_norm_g': gain(ks[14], (DEPTH, HEAD_DIM)),
        'w_out': nrm(ks[15], (DEPTH, D_MODEL, D_MODEL), D_MODEL ** -0.5),
    }


def reference(x, pre_norm_g, post_norm_g, w_in, conv_w, gdn_a_log, gdn_dt_bias, gdn_norm_g,
              hgrn_lb, hgrn_norm_g, diff_lq1, diff_lk1, diff_lq2, diff_lk2, diff_norm_g, w_out):
    f32 = jnp.float32
    alibi = 2.0 ** (-jnp.arange(1, 2 * HEADS + 1, dtype=f32))
    slopes_diff = alibi[0::2]
    slopes_moba = alibi[1::2]
    lb_all = jnp.cumsum(jax.nn.softmax(hgrn_lb.astype(f32), axis=0), axis=0)
    lb_all = lb_all - lb_all[0]
    splits = [GDN_COLS, GDN_COLS + HGRN_COLS, GDN_COLS + HGRN_COLS + MOBA_COLS]
    for l in range(DEPTH):
        h = rmsnorm(x, pre_norm_g[l])
        proj = jnp.einsum('btd,dc->btc', h, w_in[l].astype(f32))
        p_gdn, p_hgrn, p_moba, p_diff = jnp.split(proj, splits, axis=-1)
        lam_init = 0.8 - 0.6 * math.exp(-0.3 * l)
        y = jnp.concatenate([
            gdn_branch(p_gdn, conv_w[l], gdn_a_log[l], gdn_dt_bias[l], gdn_norm_g[l]),
            hgrn2_branch(p_hgrn, lb_all[l], hgrn_norm_g[l]),
            moba_branch(p_moba, slopes_moba),
            diff_branch(p_diff, diff_lq1[l], diff_lk1[l], diff_lq2[l], diff_lk2[l], diff_norm_g[l],
                        lam_init, slopes_diff),
        ], axis=-1)
        y = jnp.einsum('btc,cd->btd', y, w_out[l].astype(f32))
        x = x + rmsnorm(y, post_norm_g[l]).astype(x.dtype)
    return x
```

```cpp
#include <hip/hip_runtime.h>
#include <hip/hip_cooperative_groups.h>
#include <cstdio>
#include <cstdint>
#include <cmath>
namespace cg = cooperative_groups;
__device__ __forceinline__ int TIDX() { int t = threadIdx.x; asm volatile("" : "+v"(t)); return t; }
__device__ __forceinline__ int BIDX() { int b = blockIdx.x; asm volatile("" : "+s"(b)); return b; }
namespace pg8 {
#define PG8_LAS __attribute__((address_space(3)))
typedef unsigned short bf16_t;
typedef short bf16x8 __attribute__((ext_vector_type(8)));
typedef float f32x4 __attribute__((ext_vector_type(4)));
typedef unsigned u32x4 __attribute__((ext_vector_type(4)));
constexpr int BM = 256, BK = 64, HALF = 128, HTB = HALF * BK * 2  , STAGE_BYTES = 8 * HTB, NXCD = 8, WGM = 8;

__host__ __device__ __forceinline__ int lds_byte(int r, int c) { const int st = (r >> 4) * 2 + (c >> 5), rr = r & 15, cc = c & 31, ob = rr * 64 + cc * 2; return st * 1024 + (ob ^ (((ob >> 9) & 1) << 5)); }
__host__ __device__ __forceinline__ void stage_rc(int b, int& R, int& C) { const int st = b / 1024, sb = b % 1024, swz = sb ^ (((sb >> 9) & 1) << 5); R = (st >> 1) * 16 + swz / 64; C = (st & 1) * 32 + (swz % 64) / 2; }
__host__ __device__ __forceinline__ int perm32(int rho) { const int n = rho >> 4, i = rho & 15; return 8 * (i >> 2) + 4 * n + (i & 3); }

struct Unit { int pm, pn; };
struct Gemm { const bf16_t* A; const bf16_t* Bt; int M, N, K; };

struct StaticOrder {
    int nM, nN, nwg, G, c;
    __host__ __device__ void init(int M, int N, int G_, int c_) { nM = M / BM; nN = N / BM; nwg = nM * nN; G = G_; c = c_; }
    __host__ __device__ bool next(int i, Unit& u) const {
        const long L = (long)i * G + c; if (L >= nwg) return false;
        int wgid = (int)L; { const int q = nwg / NXCD, r = nwg % NXCD, xcd = wgid % NXCD, off = wgid / NXCD; wgid = (xcd < r ? xcd * (q + 1) : r * (q + 1) + (xcd - r) * q) + off; }
        const int nig = WGM * nN, gid = wgid / nig, fm = gid * WGM, gsz = (nM - fm) < WGM ? (nM - fm) : WGM;
        u.pm = fm + ((wgid % nig) % gsz); u.pn = (wgid % nig) / gsz; return true;
    }
    __device__ __forceinline__ void a_ready(const Unit&) const {}
    __device__ __forceinline__ void done(const Unit&) const {}
};
__device__ __forceinline__ unsigned cvt_pk_bf16(float lo, float hi) { unsigned r; asm volatile("v_cvt_pk_bf16_f32 %0, %1, %2" : "=v"(r) : "v"(lo), "v"(hi)); return r; }
struct EpiProj {
    static constexpr bool PERM = true, AFTER_DRAIN = false;
    bf16_t* O; int ldc; const float* rstd;
    __device__ __forceinline__ void operator()(const f32x4 (&acc)[2][2][4][2], const Unit& u, int wr, int wc, int fr, int fq) const {
        const int row0 = u.pm * BM + wr * 64 + fr, col0 = u.pn * BM + wc * 32 + 8 * fq;
#pragma unroll
        for (int ai = 0; ai < 2; ++ai)
#pragma unroll
            for (int m = 0; m < 4; ++m) { const int row = row0 + ai * HALF + m * 16; const float s = rstd[row]; bf16_t* rowp = O + (size_t)row * ldc + col0;
#pragma unroll
                for (int bj = 0; bj < 2; ++bj) { const f32x4 v0 = acc[ai][bj][m][0] * s, v1 = acc[ai][bj][m][1] * s;
                    u32x4 w; w.x = cvt_pk_bf16(v0[0], v0[1]); w.y = cvt_pk_bf16(v0[2], v0[3]); w.z = cvt_pk_bf16(v1[0], v1[1]); w.w = cvt_pk_bf16(v1[2], v1[3]);
                    *(u32x4*)(rowp + bj * HALF) = w; } }
    }
};
struct EpiF32 {
    static constexpr bool PERM = false, AFTER_DRAIN = false;
    float* O; int ldc;
    __device__ __forceinline__ void operator()(const f32x4 (&acc)[2][2][4][2], const Unit& u, int wr, int wc, int fr, int fq) const {
        const int row0 = u.pm * BM + wr * 64 + fr, col0 = u.pn * BM + wc * 32 + 4 * fq;
#pragma unroll
        for (int ai = 0; ai < 2; ++ai)
#pragma unroll
            for (int m = 0; m < 4; ++m) { float* rowp = O + (size_t)(row0 + ai * HALF + m * 16) * ldc + col0;
#pragma unroll
                for (int bj = 0; bj < 2; ++bj)
#pragma unroll
                    for (int n = 0; n < 2; ++n) *(f32x4*)(rowp + bj * HALF + n * 16) = acc[ai][bj][m][n]; }
    }
};
struct EpiBf16Plain {
    static constexpr bool PERM = true, AFTER_DRAIN = false;
    bf16_t* O; int ldc;
    __device__ __forceinline__ void operator()(const f32x4 (&acc)[2][2][4][2], const Unit& u, int wr, int wc, int fr, int fq) const {
        const int row0 = u.pm * BM + wr * 64 + fr, col0 = u.pn * BM + wc * 32 + 8 * fq;
#pragma unroll
        for (int ai = 0; ai < 2; ++ai)
#pragma unroll
            for (int m = 0; m < 4; ++m) { bf16_t* rowp = O + (size_t)(row0 + ai * HALF + m * 16) * ldc + col0;
#pragma unroll
                for (int bj = 0; bj < 2; ++bj) { const f32x4 v0 = acc[ai][bj][m][0], v1 = acc[ai][bj][m][1];
                    u32x4 w; w.x = cvt_pk_bf16(v0[0], v0[1]); w.y = cvt_pk_bf16(v0[2], v0[3]); w.z = cvt_pk_bf16(v1[0], v1[1]); w.w = cvt_pk_bf16(v1[2], v1[3]);
                    *(u32x4*)(rowp + bj * HALF) = w; } }
    }
};
template <class Epi, class Sched, bool ALIGN_EPI = false, bool SP2 = false>
__device__ __forceinline__ void gemm_phase(PG8_LAS unsigned char* lds, const Gemm g, const Sched& S, const Epi& E) {
    const int tid = TIDX(), wid = __builtin_amdgcn_readfirstlane(tid >> 6), lane = tid & 63, wr = wid >> 2, wc = wid & 3, fr = lane & 15, fq = lane >> 4;
    const int K = g.K, nt = K / BK;
    unsigned voffA[2], voffB[2];
#pragma unroll
    for (int i = 0; i < 2; ++i) { int R, C; stage_rc(tid * 16 + i * 8192, R, C); const int Rb = Epi::PERM ? ((R & ~31) + perm32(R & 31)) : R;
        voffA[i] = (unsigned)(R * K + C) * 2u; voffB[i] = (unsigned)(Rb * K + C) * 2u; }
    const size_t kstep = (size_t)(BK * 2);
    const size_t hstep = (size_t)HALF * K * 2;
    const size_t tstep = 2 * hstep;
    const unsigned ldsw = (unsigned)wid * 1024u;
    const int aoff = lds_byte(wr * 64 + fr, fq * 8), boff = lds_byte(wc * 32 + fr, fq * 8);
#define PG8_SA(b, h) (((b) * 2 + (h)) * HTB)
#define PG8_SB(b, h) ((4 + (b) * 2 + (h)) * HTB)
#define PG8_STAGE(bufoff, gbase, voff) do { _Pragma("unroll") for (int _i = 0; _i < 2; ++_i) \
        __builtin_amdgcn_global_load_lds((const unsigned*)((const char*)(gbase) + (voff)[_i]), (PG8_LAS unsigned*)(lds + (bufoff) + ldsw + _i * 8192), 16, 0, 0); } while (0)
#define PG8_LDA(dst, b, h) do { _Pragma("unroll") for (int m = 0; m < 4; ++m) _Pragma("unroll") for (int k = 0; k < 2; ++k) dst[m][k] = *(const PG8_LAS bf16x8*)(lds + PG8_SA(b, h) + aoff + m * 2048 + k * 1024); } while (0)
#define PG8_LDB(dst, b, h) do { _Pragma("unroll") for (int n = 0; n < 2; ++n) _Pragma("unroll") for (int k = 0; k < 2; ++k) dst[n][k] = *(const PG8_LAS bf16x8*)(lds + PG8_SB(b, h) + boff + n * 2048 + k * 1024); } while (0)
#define PG8_MMA(ai, bj, At, Bt) do { __builtin_amdgcn_s_setprio(1); _Pragma("unroll") for (int m = 0; m < 4; ++m) _Pragma("unroll") for (int n = 0; n < 2; ++n) _Pragma("unroll") for (int k = 0; k < 2; ++k) \
        acc[ai][bj][m][n] = __builtin_amdgcn_mfma_f32_16x16x32_bf16(Bt[n][k], At[m][k], acc[ai][bj][m][n], 0, 0, 0); __builtin_amdgcn_s_setprio(0); } while (0)
#define PG8_WAIT_V(n) asm volatile("s_waitcnt vmcnt(" #n ")" ::: "memory")
#define PG8_WAIT_L(n) asm volatile("s_waitcnt lgkmcnt(" #n ")" ::: "memory")
#define PG8_BAR __builtin_amdgcn_s_barrier()
#define PG8_SCHED __builtin_amdgcn_sched_barrier(0)
    Unit cur, nxt; int ui = 0;
    if (!S.next(0, cur)) return;
    f32x4 acc[2][2][4][2];
#pragma unroll
    for (int a = 0; a < 2; ++a)
#pragma unroll
        for (int b = 0; b < 2; ++b)
#pragma unroll
            for (int m = 0; m < 4; ++m)
#pragma unroll
                for (int n = 0; n < 2; ++n) acc[a][b][m][n] = (f32x4){0.f, 0.f, 0.f, 0.f};
    bf16x8 At[4][2], B0[2][2], B1[2][2];
    const char* cA = (const char*)g.A + (size_t)cur.pm * tstep; const char* cB = (const char*)g.Bt + (size_t)cur.pn * tstep;
    S.a_ready(cur);
    if constexpr (SP2) {
        PG8_STAGE(PG8_SB(0, 0), cB, voffB); PG8_STAGE(PG8_SB(0, 1), cB + hstep, voffB); PG8_STAGE(PG8_SA(0, 0), cA, voffA); PG8_STAGE(PG8_SA(0, 1), cA + hstep, voffA);
        if (wr == 1) PG8_BAR;
        PG8_WAIT_V(2); PG8_BAR;
        PG8_STAGE(PG8_SB(1, 0), cB + kstep, voffB); PG8_STAGE(PG8_SA(1, 0), cA + kstep, voffA); PG8_STAGE(PG8_SB(1, 1), cB + hstep + kstep, voffB);
        PG8_WAIT_V(6); PG8_BAR;
    } else {
        PG8_STAGE(PG8_SB(0, 0), cB, voffB); PG8_STAGE(PG8_SA(0, 0), cA, voffA); PG8_STAGE(PG8_SB(0, 1), cB + hstep, voffB); PG8_STAGE(PG8_SA(0, 1), cA + hstep, voffA);
        if (wr == 1) PG8_BAR;
        PG8_WAIT_V(4); PG8_BAR;
        PG8_STAGE(PG8_SB(1, 0), cB + kstep, voffB); PG8_STAGE(PG8_SA(1, 0), cA + kstep, voffA); PG8_STAGE(PG8_SB(1, 1), cB + hstep + kstep, voffB);
        PG8_WAIT_V(6); PG8_BAR;
    }
    for (;;) {
        const bool has_next = S.next(ui + 1, nxt);
        const char* nA = has_next ? (const char*)g.A + (size_t)nxt.pm * tstep : cA; const char* nB = has_next ? (const char*)g.Bt + (size_t)nxt.pn * tstep : cB;
        for (int t = 0; t < nt; t += 2) {
            const bool last = (t == nt - 2);
            const char* a1 = cA + (size_t)(t + 1) * kstep;
            const char* a2 = last ? nA : cA + (size_t)(t + 2) * kstep; const char* b2 = last ? nB : cB + (size_t)(t + 2) * kstep;
            const char* a3 = a2 + kstep; const char* b3 = b2 + kstep;
            if (last && has_next) S.a_ready(nxt);
            if constexpr (SP2) {
            PG8_LDB(B0, 0, 0); PG8_LDB(B1, 0, 1); PG8_SCHED; PG8_LDA(At, 0, 0); PG8_STAGE(PG8_SA(1, 1), a1 + hstep, voffA);
            PG8_WAIT_V(8); PG8_WAIT_L(0); PG8_BAR; PG8_MMA(0, 0, At, B0); PG8_MMA(0, 1, At, B1); PG8_BAR; PG8_SCHED;
            PG8_LDA(At, 0, 1); PG8_STAGE(PG8_SB(0, 0), b2, voffB); PG8_STAGE(PG8_SB(0, 1), b2 + hstep, voffB); PG8_STAGE(PG8_SA(0, 0), a2, voffA);
            PG8_WAIT_V(8); PG8_WAIT_L(0); PG8_BAR; PG8_MMA(1, 0, At, B0); PG8_MMA(1, 1, At, B1); PG8_BAR; PG8_SCHED;
            PG8_LDB(B0, 1, 0); PG8_LDB(B1, 1, 1); PG8_SCHED; PG8_LDA(At, 1, 0); PG8_STAGE(PG8_SA(0, 1), a2 + hstep, voffA);
            PG8_WAIT_V(8); PG8_WAIT_L(0); PG8_BAR; PG8_MMA(0, 0, At, B0); PG8_MMA(0, 1, At, B1); PG8_BAR; PG8_SCHED;
            PG8_LDA(At, 1, 1); PG8_STAGE(PG8_SB(1, 0), b3, voffB); PG8_STAGE(PG8_SB(1, 1), b3 + hstep, voffB); PG8_STAGE(PG8_SA(1, 0), a3, voffA);
            PG8_WAIT_V(8); PG8_WAIT_L(0); PG8_BAR; PG8_MMA(1, 0, At, B0); PG8_MMA(1, 1, At, B1); PG8_BAR; PG8_SCHED;
            } else {
            PG8_LDB(B0, 0, 0); PG8_SCHED; PG8_LDA(At, 0, 0); PG8_STAGE(PG8_SA(1, 1), a1 + hstep, voffA);
            PG8_WAIT_L(8); PG8_BAR; PG8_WAIT_L(0); PG8_MMA(0, 0, At, B0); PG8_BAR; PG8_SCHED;
            PG8_LDB(B1, 0, 1); PG8_STAGE(PG8_SB(0, 0), b2, voffB);
            PG8_BAR; PG8_WAIT_L(0); PG8_MMA(0, 1, At, B1); PG8_BAR;
            PG8_LDA(At, 0, 1); PG8_STAGE(PG8_SA(0, 0), a2, voffA);
            PG8_BAR; PG8_WAIT_L(0); PG8_MMA(1, 0, At, B0); PG8_BAR; PG8_SCHED;
            PG8_STAGE(PG8_SB(0, 1), b2 + hstep, voffB);
            PG8_WAIT_V(6); PG8_BAR; PG8_MMA(1, 1, At, B1); PG8_BAR;
            PG8_LDB(B0, 1, 0); PG8_SCHED; PG8_LDA(At, 1, 0); PG8_STAGE(PG8_SA(0, 1), a2 + hstep, voffA);
            PG8_WAIT_L(8); PG8_BAR; PG8_WAIT_L(0); PG8_MMA(0, 0, At, B0); PG8_BAR; PG8_SCHED;
            PG8_LDB(B1, 1, 1); PG8_STAGE(PG8_SB(1, 0), b3, voffB);
            PG8_BAR; PG8_WAIT_L(0); PG8_MMA(0, 1, At, B1); PG8_BAR;
            PG8_LDA(At, 1, 1); PG8_STAGE(PG8_SA(1, 0), a3, voffA);
            PG8_BAR; PG8_WAIT_L(0); PG8_MMA(1, 0, At, B0); PG8_BAR; PG8_SCHED;
            PG8_STAGE(PG8_SB(1, 1), b3 + hstep, voffB);
            PG8_WAIT_V(6); PG8_BAR; PG8_MMA(1, 1, At, B1); PG8_BAR;
            }
        }
        if constexpr (ALIGN_EPI) { if (wr == 0) PG8_BAR; }
        if constexpr (!Epi::AFTER_DRAIN) { E(acc, cur, wr, wc, fr, fq); S.done(cur); }
        if (!has_next) break;
#pragma unroll
        for (int a = 0; a < 2; ++a)
#pragma unroll
            for (int b = 0; b < 2; ++b)
#pragma unroll
                for (int m = 0; m < 4; ++m)
#pragma unroll
                    for (int n = 0; n < 2; ++n) acc[a][b][m][n] = (f32x4){0.f, 0.f, 0.f, 0.f};
        cur = nxt; cA = nA; cB = nB; ++ui;
        if constexpr (ALIGN_EPI) { if (wr == 1) PG8_BAR; }
    }
    PG8_WAIT_V(0);
    if constexpr (!ALIGN_EPI) { if (wr == 0) PG8_BAR; }
    PG8_BAR;
    if constexpr (Epi::AFTER_DRAIN) { E.fused(acc, cur, wr, wc, fr, fq, lds, wid, lane); S.done(cur); }
#undef PG8_SA
#undef PG8_SB
#undef PG8_STAGE
#undef PG8_LDA
#undef PG8_LDB
#undef PG8_MMA
#undef PG8_WAIT_V
#undef PG8_WAIT_L
#undef PG8_BAR
#undef PG8_SCHED
}
}

#define LAS __attribute__((address_space(3)))
typedef unsigned short bf16;
typedef unsigned v4u __attribute__((ext_vector_type(4)));
typedef unsigned v2u __attribute__((ext_vector_type(2)));
typedef float f4 __attribute__((ext_vector_type(4)));
constexpr int DM = 1024, NB = 16, SEQ = 2048, DEPTH = 2, NTOK = NB * SEQ;
constexpr int GW = 256, NH = 4, HD = 64;
constexpr int INC = 4104;
constexpr int PC = 4096;
constexpr int NT = 512, NWAVES = 8;
constexpr float EPS = 1e-6f;
constexpr int C_GQ = 0, C_GK = 256, C_GV = 512, C_GZ = 768;
constexpr int C_HQ = 1024, C_HF = 1280, C_HI = 1536, C_HZ = 1792;
constexpr int C_MQ = 2048, C_MK = 2304, C_MV = 2560, C_MZ = 2816;
constexpr int C_DQ = 3072, C_DK = 3328, C_DV = 3584, C_DZ = 3840;
constexpr int LDS_BYTES = 147456;

constexpr size_t MiB = 1u << 20;
constexpr size_t WS_CTL = 0;
constexpr size_t WS_PROJ = 1 * MiB;
constexpr size_t WS_XB = WS_PROJ + 256 * MiB;
constexpr size_t WS_Y = WS_XB + 64 * MiB;
constexpr size_t WS_WIN = WS_Y + 64 * MiB;
constexpr size_t WS_WOUT = WS_WIN + 16 * MiB;
constexpr size_t WS_RSTD = WS_WOUT + 4 * MiB;
constexpr size_t WS_AB = WS_RSTD + 1 * MiB;
constexpr size_t WS_KMEAN = WS_AB + 1 * MiB;
constexpr size_t WS_SCR = WS_KMEAN + 1 * MiB;
constexpr size_t WS_END = WS_SCR + 104 * MiB;

struct Params {
    const float* x; const float* pre_g; const float* post_g; const float* w_in; const float* conv_w;
    const float* a_log; const float* dt_bias; const float* gdn_g; const float* hgrn_lb; const float* hgrn_g;
    const float* lq1; const float* lk1; const float* lq2; const float* lk2; const float* diff_g; const float* w_out;
    float* out; unsigned char* ws;
};

__device__ __forceinline__ float wave_sum(float v) {
#pragma unroll
    for (int o = 32; o > 0; o >>= 1) v += __shfl_xor(v, o);
    return v;
}
__device__ __forceinline__ float sigmoidf_(float x) { return 1.0f / (1.0f + expf(-x)); }
__device__ __forceinline__ float siluf_(float x) { return x / (1.0f + expf(-x)); }
__device__ __forceinline__ float softplusf_(float x) { return fmaxf(x, 0.f) + log1pf(expf(-fabsf(x))); }
__device__ __forceinline__ float fexp(float x) { return __builtin_amdgcn_exp2f(x * 1.4426950408889634f); }
__device__ __forceinline__ float fsigmoid(float x) { return __builtin_amdgcn_rcpf(1.0f + fexp(-x)); }
__device__ __forceinline__ float fsilu(float x) { return x * fsigmoid(x); }
__device__ __forceinline__ float fsoftplus(float x) { return fmaxf(x, 0.f) + 0.6931471805599453f * __builtin_amdgcn_logf(1.0f + fexp(-fabsf(x))); }
__device__ __forceinline__ float dpp_row16_sum(float v) {
    v += __int_as_float(__builtin_amdgcn_update_dpp(0, __float_as_int(v), 0xB1, 0xF, 0xF, true));
    v += __int_as_float(__builtin_amdgcn_update_dpp(0, __float_as_int(v), 0x4E, 0xF, 0xF, true));
    v += __int_as_float(__builtin_amdgcn_update_dpp(0, __float_as_int(v), 0x141, 0xF, 0xF, true));
    v += __int_as_float(__builtin_amdgcn_update_dpp(0, __float_as_int(v), 0x140, 0xF, 0xF, true));
    return v;
}
__device__ __forceinline__ float xor32_sum(float v) { const auto rr = __builtin_amdgcn_permlane32_swap(__float_as_uint(v), __float_as_uint(v), false, false); return __uint_as_float(rr[0]) + __uint_as_float(rr[1]); }
__device__ __forceinline__ float fwave_sum(float v) { v = dpp_row16_sum(v);
    return (__int_as_float(__builtin_amdgcn_readlane(__float_as_int(v), 0)) + __int_as_float(__builtin_amdgcn_readlane(__float_as_int(v), 16))) + (__int_as_float(__builtin_amdgcn_readlane(__float_as_int(v), 32)) + __int_as_float(__builtin_amdgcn_readlane(__float_as_int(v), 48))); }
__device__ __forceinline__ float bf2f(bf16 v) { return __uint_as_float((unsigned)v << 16); }
__device__ __forceinline__ unsigned f2bf(float f) { unsigned u = __float_as_uint(f); return (u + 0x7fffu + ((u >> 16) & 1u)) >> 16; }
__device__ __forceinline__ unsigned pk2(float lo, float hi) { return f2bf(lo) | (f2bf(hi) << 16); }
__device__ __forceinline__ float rlane(float v, int l) { return __int_as_float(__builtin_amdgcn_readlane(__float_as_int(v), l)); }

__device__ __forceinline__ void transpose_item(const float* W, int ldw, int K, const float* gk, bf16* WT, int n_src0, int n_dst0, int k0, LAS float* scr, int lane) {
#pragma unroll 8
    for (int i = 0; i < 32; ++i) { const int kk = 2 * i + (lane >> 5); float v = W[(size_t)(k0 + kk) * ldw + n_src0 + (lane & 31)]; if (gk) v *= gk[k0 + kk]; scr[kk * 33 + (lane & 31)] = v; }
    asm volatile("s_waitcnt lgkmcnt(0)" ::: "memory");
    const int c = lane & 7;
#pragma unroll
    for (int j = 0; j < 4; ++j) { const int n = (lane >> 3) + 8 * j; const LAS float* s = scr + (8 * c) * 33 + n;
        v4u o; o.x = pk2(s[0 * 33], s[1 * 33]); o.y = pk2(s[2 * 33], s[3 * 33]); o.z = pk2(s[4 * 33], s[5 * 33]); o.w = pk2(s[6 * 33], s[7 * 33]);
        *(v4u*)(WT + (size_t)(n_dst0 + n) * K + k0 + 8 * c) = o; }
    asm volatile("s_waitcnt lgkmcnt(0)" ::: "memory");
}
__device__ __forceinline__ void load_wab(const Params& p, int l, LAS float* wab) {
    const float* W = p.w_in + (size_t)l * DM * INC; const float* g = p.pre_g + l * DM;
    for (int i = TIDX(); i < 8 * DM; i += NT) { const int k = i >> 3, j = i & 7; wab[j * DM + k] = W[(size_t)k * INC + 768 + j] * g[k]; }
}
__device__ __forceinline__ void row_prep(const float4 (&v)[4], int row, int lane, bf16* xb, float* rstd, float* ab, const LAS float* wab) {
    float ss = 0.f;
#pragma unroll
    for (int j = 0; j < 4; ++j) ss += v[j].x * v[j].x + v[j].y * v[j].y + v[j].z * v[j].z + v[j].w * v[j].w;
    ss = wave_sum(ss);
    const float rs = rsqrtf(ss * (1.0f / DM) + EPS);
    v2u* o8 = (v2u*)(xb + (size_t)row * DM) + lane;
#pragma unroll
    for (int j = 0; j < 4; ++j) { v2u w; w.x = pk2(v[j].x, v[j].y); w.y = pk2(v[j].z, v[j].w); o8[64 * j] = w; }
    float acc[8];
#pragma unroll
    for (int j8 = 0; j8 < 8; ++j8) { float a = 0.f;
#pragma unroll
        for (int j = 0; j < 4; ++j) { const f4 w = *(const LAS f4*)(wab + j8 * DM + 256 * j + 4 * lane); a += v[j].x * w.x + v[j].y * w.y + v[j].z * w.z + v[j].w * w.w; }
        acc[j8] = wave_sum(a); }
    if (lane == 0) { rstd[row] = rs;
        *(float4*)(ab + (size_t)row * 8) = make_float4(acc[0] * rs, acc[1] * rs, acc[2] * rs, acc[3] * rs);
        *(float4*)(ab + (size_t)row * 8 + 4) = make_float4(acc[4] * rs, acc[5] * rs, acc[6] * rs, acc[7] * rs); }
}

__device__ __forceinline__ void phase_prologue(const Params& p, LAS unsigned char* lds) {
    const int lane = TIDX() & 63, wave = TIDX() >> 6;
    LAS float* wab = (LAS float*)lds;
    load_wab(p, 0, wab);
    __syncthreads();
    LAS float* scr = (LAS float*)(lds + 32768 + wave * 12288);
    const int gw = BIDX() * NWAVES + wave, NGW = gridDim.x * NWAVES;
    bf16* win_t = (bf16*)(p.ws + WS_WIN); bf16* wout_t = (bf16*)(p.ws + WS_WOUT);
    constexpr int I_IN = (DM / 64) * (PC / 32), I_OUT = (DM / 64) * (DM / 32);
    for (int it = gw; it < DEPTH * (I_IN + I_OUT); it += NGW) {
        int r = it; const int l = r / (I_IN + I_OUT); r -= l * (I_IN + I_OUT);
        if (r < I_IN) { const int kb = r / (PC / 32), nb = r % (PC / 32), n0 = 32 * nb;
            transpose_item(p.w_in + (size_t)l * DM * INC, INC, DM, p.pre_g + l * DM, win_t + (size_t)l * PC * DM, n0 + (n0 >= 768 ? 8 : 0), n0, 64 * kb, scr, lane); }
        else { r -= I_IN; const int kb = r / (DM / 32), nb = r % (DM / 32);
            transpose_item(p.w_out + (size_t)l * DM * DM, DM, DM, nullptr, wout_t + (size_t)l * DM * DM, 32 * nb, 32 * nb, 64 * kb, scr, lane); }
    }
    bf16* xb = (bf16*)(p.ws + WS_XB); float* rstd = (float*)(p.ws + WS_RSTD); float* ab = (float*)(p.ws + WS_AB);
    for (int row = gw; row < NTOK; row += NGW) {
        const float4* xr = (const float4*)(p.x + (size_t)row * DM) + lane;
        float4 v[4];
#pragma unroll
        for (int j = 0; j < 4; ++j) v[j] = xr[64 * j];
        row_prep(v, row, lane, xb, rstd, ab, wab);
    }
}

__device__ __forceinline__ void phase_post(const Params& p, int l, LAS unsigned char* lds) {
    const int lane = TIDX() & 63, wave = TIDX() >> 6;
    LAS float* wab = (LAS float*)lds;
    const bool more = (l + 1 < DEPTH);
    if (more) load_wab(p, l + 1, wab);
    __syncthreads();
    const int gw = BIDX() * NWAVES + wave, NGW = gridDim.x * NWAVES;
    const float* xin = (l == 0) ? p.x : p.out;
    const float* g = p.post_g + l * DM;
    bf16* xb = (bf16*)(p.ws + WS_XB); float* rstd = (float*)(p.ws + WS_RSTD); float* ab = (float*)(p.ws + WS_AB);
    for (int row = gw; row < NTOK; row += NGW) {
        const v2u* yr = (const v2u*)((const bf16*)(p.ws + WS_PROJ) + (size_t)row * DM) + lane;
        const float4* xr = (const float4*)(xin + (size_t)row * DM) + lane;
        float4 v[4], xx[4]; float ss = 0.f;
#pragma unroll
        for (int j = 0; j < 4; ++j) { const v2u w = yr[64 * j]; xx[j] = xr[64 * j];
            v[j] = make_float4(__uint_as_float(w.x << 16), __uint_as_float(w.x & 0xffff0000u), __uint_as_float(w.y << 16), __uint_as_float(w.y & 0xffff0000u));
            ss += v[j].x * v[j].x + v[j].y * v[j].y + v[j].z * v[j].z + v[j].w * v[j].w; }
        ss = wave_sum(ss);
        const float rs = rsqrtf(ss * (1.0f / DM) + EPS);
        float4* orow = (float4*)(p.out + (size_t)row * DM) + lane;
#pragma unroll
        for (int j = 0; j < 4; ++j) { const float4 gg = ((const float4*)g)[lane + 64 * j];
            v[j] = make_float4(xx[j].x + v[j].x * rs * gg.x, xx[j].y + v[j].y * rs * gg.y, xx[j].z + v[j].z * rs * gg.z, xx[j].w + v[j].w * rs * gg.w);
            orow[64 * j] = v[j]; }
        if (more) row_prep(v, row, lane, xb, rstd, ab, wab);
    }
}

#define XB_TMO      128
#define XB_XCNT(j)  (256  + 64 * (j))
#define XB_XSUB(j)  (1280 + 64 * (j))
#define XB_XGEN(j)  (2304 + 64 * (j))
#define XB_TOP      3328
#define XB_TOPGEN   3392
#define XCD_BAR_WORDS 3456
#define XB_SPIN_CAP (1u << 18)

__device__ __forceinline__ unsigned xb_ld(unsigned* p)              { return __hip_atomic_load(p, __ATOMIC_RELAXED, __HIP_MEMORY_SCOPE_AGENT); }
__device__ __forceinline__ unsigned xb_add(unsigned* p, unsigned v) { return __hip_atomic_fetch_add(p, v, __ATOMIC_RELAXED, __HIP_MEMORY_SCOPE_AGENT); }
__device__ __forceinline__ unsigned xb_xcc_id() { return (unsigned)__builtin_amdgcn_s_getreg((3 << 11) | 20) & 0xFu; }
#define XB_SPIN(cond, bar) do { unsigned _sp = 0; while (cond) { __builtin_amdgcn_s_sleep(1); \
    if ((++_sp & 255u) == 0u) { if (xb_ld(&(bar)[XB_TMO])) break; if (_sp > XB_SPIN_CAP) { atomicAdd(&(bar)[XB_TMO], 1u); break; } } } } while (0)

struct XcdBarrier {
    unsigned* bar; unsigned x;
    volatile LAS unsigned* st;
};

__device__ __forceinline__ XcdBarrier xcd_barrier_post(unsigned* bar, volatile LAS unsigned* st) {
    XcdBarrier b; b.bar = bar; b.x = xb_xcc_id(); b.st = st;
    if (TIDX() == 0) (void)xb_add(&bar[XB_XCNT(b.x)], 1u);
    return b;
}
__device__ __forceinline__ void xcd_barrier_complete(unsigned* bar, unsigned x, unsigned& nloc, unsigned& nx) {
    const unsigned G = gridDim.x * gridDim.y * gridDim.z;
    unsigned sum, cnt, mine, sp = 0u;
    for (;;) {
        sum = 0u; cnt = 0u; mine = 0u;
#pragma unroll
        for (unsigned j = 0; j < 16; ++j) { const unsigned c = xb_ld(&bar[XB_XCNT(j)]); sum += c; cnt += (c > 0u) ? 1u : 0u; mine = (j == x) ? c : mine; }
        if (sum == G) break;
        __builtin_amdgcn_s_sleep(1);
        if ((++sp & 255u) == 0u) { if (xb_ld(&bar[XB_TMO])) break; if (sp > XB_SPIN_CAP) { atomicAdd(&bar[XB_TMO], 1u); break; } }
    }
    nloc = mine > 0u ? mine : 1u; nx = cnt > 0u ? cnt : 1u;
}

__device__ __forceinline__ void xcd_barrier(const XcdBarrier& b) {
    asm volatile("s_waitcnt vmcnt(0)" ::: "memory");
    __syncthreads();
    if (TIDX() == 0) {
        unsigned* bar = b.bar;
        __builtin_amdgcn_s_waitcnt(0);
        unsigned nloc = b.st[0], nx = b.st[1];
        if (nloc == 0u) { xcd_barrier_complete(bar, b.x, nloc, nx); b.st[0] = nloc; b.st[1] = nx; }
        const unsigned old = xb_add(&bar[XB_XSUB(b.x)], 1u);
        const unsigned gen = old / nloc;
        if (old + 1u == (gen + 1u) * nloc) {
            __builtin_amdgcn_fence(__ATOMIC_RELEASE, "agent");
            asm volatile("s_waitcnt vmcnt(0)" ::: "memory");
            const unsigned og = xb_add(&bar[XB_TOP], 1u);
            const unsigned tg = og / nx;
            if (og + 1u == (tg + 1u) * nx) xb_add(&bar[XB_TOPGEN], 1u);
            else XB_SPIN(xb_ld(&bar[XB_TOPGEN]) == tg, bar);
            __builtin_amdgcn_fence(__ATOMIC_ACQUIRE, "agent");
            xb_add(&bar[XB_XGEN(b.x)], 1u);
            asm volatile("s_waitcnt vmcnt(0)" ::: "memory");
        } else {
            XB_SPIN(xb_ld(&bar[XB_XGEN(b.x)]) == gen, bar);
            __builtin_amdgcn_fence(__ATOMIC_ACQUIRE, "agent");
            asm volatile("s_waitcnt vmcnt(0)" ::: "memory");
        }
    }
    __syncthreads();
}

namespace att {
typedef short bf16x8 __attribute__((ext_vector_type(8)));
typedef short s16x4 __attribute__((ext_vector_type(4)));
typedef float f32x16 __attribute__((ext_vector_type(16)));
constexpr int KCH = 1024, VOFF = 8192, BUFB = 16384, NSLOT = 4;
constexpr float NEG = -1e30f, LOG2E = 1.4426950408889634f;
__device__ __forceinline__ void glds16(const void* gsrc, unsigned lds_dst) { unsigned keep;
    asm volatile("s_mov_b32 %0, m0\n\ts_mov_b32 m0, %2\n\ts_nop 0\n\tglobal_load_lds_dwordx4 %1, off\n\ts_mov_b32 m0, %0" : "=&s"(keep) : "v"(gsrc), "s"(lds_dst) : "memory"); }
__device__ __forceinline__ unsigned cvtpk(float lo, float hi) { typedef float f2 __attribute__((ext_vector_type(2))); typedef __bf16 b2 __attribute__((ext_vector_type(2))); f2 v = {lo, hi}; b2 b = __builtin_convertvector(v, b2); return __builtin_bit_cast(unsigned, b); }
__device__ __forceinline__ s16x4 vtr(const LAS unsigned char* p) { return __builtin_bit_cast(s16x4, __builtin_amdgcn_ds_read_tr16_b64_v4i16((LAS s16x4*)p)); }
__device__ __forceinline__ unsigned scale_pk(unsigned w, float c) { return cvtpk(__uint_as_float(w << 16) * c, __uint_as_float(w & 0xffff0000u) * c); }
__device__ __forceinline__ float max16(const f32x16& a) {
    float m0 = fmaxf(fmaxf(a[0], a[1]), fmaxf(a[2], a[3])), m1 = fmaxf(fmaxf(a[4], a[5]), fmaxf(a[6], a[7]));
    float m2 = fmaxf(fmaxf(a[8], a[9]), fmaxf(a[10], a[11])), m3 = fmaxf(fmaxf(a[12], a[13]), fmaxf(a[14], a[15]));
    return fmaxf(fmaxf(m0, m1), fmaxf(m2, m3));
}

template <int MODE>
__device__ __forceinline__ void attn_unit(const Params& p, int l, int b, int h, int qb, LAS unsigned char* lds) {
    constexpr int NMAP = MODE == 0 ? 2 : 1, NKS = MODE == 0 ? 2 : 4;
    const int tid = TIDX(), lane = tid & 63, wid = __builtin_amdgcn_readfirstlane(tid >> 6), r32 = lane & 31, hi = lane >> 5;
    const bf16* P = (const bf16*)(p.ws + WS_PROJ) + (size_t)b * SEQ * PC;
    const int QC = (MODE == 0 ? C_DQ : C_MQ) + h * 64, KC = (MODE == 0 ? C_DK : C_MK) + h * 64, VC = (MODE == 0 ? C_DV : C_MV) + h * 64, ZC = (MODE == 0 ? C_DZ : C_MZ) + h * 64;
    const float slope = exp2f(-(float)(MODE == 0 ? 2 * h + 1 : 2 * h + 2));
    const float sl2 = slope * LOG2E;
    const float c1 = (MODE == 0 ? 0.17677669529663687f : 0.125f) * LOG2E;
    const int q0 = qb * 256 + wid * 32, qpos = q0 + r32;
    bf16x8 qf[NMAP][NKS];
#pragma unroll
    for (int mp = 0; mp < NMAP; ++mp)
#pragma unroll
        for (int ks = 0; ks < NKS; ++ks) { const v4u raw = *(const v4u*)(P + (size_t)qpos * PC + QC + mp * 32 + ks * 16 + hi * 8);
            v4u s; s.x = scale_pk(raw.x, c1); s.y = scale_pk(raw.y, c1); s.z = scale_pk(raw.z, c1); s.w = scale_pk(raw.w, c1); qf[mp][ks] = __builtin_bit_cast(bf16x8, s); }
    unsigned sel = 0;
    if (MODE == 1) {
        const float* km = (const float*)(p.ws + WS_KMEAN) + (size_t)((b * NH + h) * 8) * 256;
        LAS float* kml = (LAS float*)(lds + NSLOT * BUFB + 64);
        __syncthreads();
        if (tid < qb * 64) { const int jj = tid >> 6, dd = tid & 63; kml[tid] = (km[jj * 256 + dd] + km[jj * 256 + 64 + dd]) + (km[jj * 256 + 128 + dd] + km[jj * 256 + 192 + dd]); }
        __syncthreads();
        float g[7];
#pragma unroll
        for (int j = 0; j < 7; ++j) { g[j] = -INFINITY;
            if (j < qb) { float s = 0.f;
#pragma unroll
                for (int ks = 0; ks < NKS; ++ks) { const v4u qq = __builtin_bit_cast(v4u, qf[0][ks]); const f4 k0 = *(const LAS f4*)(kml + j * 64 + ks * 16 + hi * 8), k1 = *(const LAS f4*)(kml + j * 64 + ks * 16 + hi * 8 + 4);
                    s += __uint_as_float(qq.x << 16) * k0.x + __uint_as_float(qq.x & 0xffff0000u) * k0.y + __uint_as_float(qq.y << 16) * k0.z + __uint_as_float(qq.y & 0xffff0000u) * k0.w
                       + __uint_as_float(qq.z << 16) * k1.x + __uint_as_float(qq.z & 0xffff0000u) * k1.y + __uint_as_float(qq.w << 16) * k1.z + __uint_as_float(qq.w & 0xffff0000u) * k1.w; }
                g[j] = s + __shfl_xor(s, 32); } }
#pragma unroll
        for (int r = 0; r < 3; ++r) { float best = -INFINITY; int bi = -1;
#pragma unroll
            for (int j = 0; j < 7; ++j) if (j < qb && !((sel >> j) & 1u) && g[j] > best) { best = g[j]; bi = j; }
            if (bi >= 0) sel |= 1u << bi; }
    }
    f32x16 cr;
#pragma unroll
    for (int r = 0; r < 16; ++r) cr[r] = sl2 * (float)((r & 3) + 8 * (r >> 2) + 4 * hi);
    const bf16* ksrc = P + (size_t)lane * PC + KC + wid * 8;
    const bf16* vsrc = P + (size_t)(16 * (wid & 3) + (lane >> 2)) * PC + VC + (wid >> 2) * 32 + (lane & 3) * 8;
    const int kdst = wid * 1024, vdst = VOFF + wid * 1024;
    const unsigned lds0 = (unsigned)(uintptr_t)lds;
#define ATT_DMA(T_) do { const unsigned sl_ = lds0 + (unsigned)(((T_) & (NSLOT - 1)) * BUFB); \
        glds16(ksrc + (size_t)(T_) * 64 * PC, (unsigned)__builtin_amdgcn_readfirstlane(sl_ + kdst)); \
        glds16(vsrc + (size_t)(T_) * 64 * PC, (unsigned)__builtin_amdgcn_readfirstlane(sl_ + vdst)); } while (0)
    const int koff = hi * KCH + r32 * 16;
    const int voff = VOFF + ((lane >> 4) & 1) * 32 + (lane & 3) * 8 + (4 * hi + ((lane & 15) >> 2)) * 64;
    f32x16 O[NMAP][2];
    float m[NMAP], lsum[NMAP];
#pragma unroll
    for (int mp = 0; mp < NMAP; ++mp) { m[mp] = NEG; lsum[mp] = 0.f;
#pragma unroll
        for (int d = 0; d < 2; ++d)
#pragma unroll
            for (int r = 0; r < 16; ++r) O[mp][d][r] = 0.f; }
    const int Tlast = 4 * qb + 3;
    __syncthreads();
    ATT_DMA(Tlast); ATT_DMA(Tlast - 1); ATT_DMA(Tlast - 2);
    for (int T = Tlast; T >= 0; --T) {
        if (T >= 2) asm volatile("s_waitcnt vmcnt(4)" ::: "memory"); else if (T == 1) asm volatile("s_waitcnt vmcnt(2)" ::: "memory"); else asm volatile("s_waitcnt vmcnt(0)" ::: "memory");
        __builtin_amdgcn_s_barrier();
        asm volatile("" ::: "memory");
        if (T >= 3) ATT_DMA(T - 3);
        const LAS unsigned char* kb = lds + (T & (NSLOT - 1)) * BUFB;
        bool selq = true; bool work = (64 * T <= q0 + 31);
        if (MODE == 1) { const int j = T >> 2; if (j < qb) { selq = (sel >> j) & 1u; work = work && __any(selq); } }
        if (work) {
            const bool diag = (64 * T + 63 > q0);
            const float tb0 = sl2 * (float)(64 * T - qb * 256), tb1 = tb0 + 32.f * sl2;
            unsigned pk[NMAP][2][2][4];
#pragma unroll
            for (int mp = 0; mp < NMAP; ++mp) {
                f32x16 u0 = cr, u1 = cr;
#pragma unroll
                for (int ks = 0; ks < NKS; ++ks) { const int cb = ((MODE == 0 ? 4 * mp : 0) + 2 * ks) * KCH;
                    const bf16x8 k0 = *(const LAS bf16x8*)(kb + koff + cb), k1 = *(const LAS bf16x8*)(kb + koff + cb + 512);
                    u0 = __builtin_amdgcn_mfma_f32_32x32x16_bf16(k0, qf[mp][ks], u0, 0, 0, 0);
                    u1 = __builtin_amdgcn_mfma_f32_32x32x16_bf16(k1, qf[mp][ks], u1, 0, 0, 0); }
                if (diag) { const int thr = qpos - 64 * T - 4 * hi;
#pragma unroll
                    for (int r = 0; r < 16; ++r) { const int c = (r & 3) + 8 * (r >> 2); if (c > thr) u0[r] = NEG; if (c + 32 > thr) u1[r] = NEG; } }
                float mu = fmaxf(max16(u0) + tb0, max16(u1) + tb1);
                if (MODE == 1) { if (!selq) mu = NEG; }
                mu = fmaxf(mu, __shfl_xor(mu, 32));
                const float mn = fmaxf(m[mp], mu);
                if (!__all(mn == m[mp])) { const float al = __builtin_amdgcn_exp2f(m[mp] - mn); lsum[mp] *= al;
#pragma unroll
                    for (int d = 0; d < 2; ++d)
#pragma unroll
                        for (int r = 0; r < 16; ++r) O[mp][d][r] *= al;
                    m[mp] = mn; }
                float ms0 = mn - tb0, ms1 = mn - tb1;
                if (MODE == 1) { if (!selq) { ms0 = 1e30f; ms1 = 1e30f; } }
                float ls = 0.f;
#pragma unroll
                for (int r = 0; r < 16; ++r) { u0[r] = __builtin_amdgcn_exp2f(u0[r] - ms0); u1[r] = __builtin_amdgcn_exp2f(u1[r] - ms1); ls += u0[r] + u1[r]; }
                lsum[mp] += ls;
#pragma unroll
                for (int s = 0; s < 2; ++s)
#pragma unroll
                    for (int i = 0; i < 4; ++i) { pk[mp][0][s][i] = cvtpk(u0[8 * s + 2 * i], u0[8 * s + 2 * i + 1]); pk[mp][1][s][i] = cvtpk(u1[8 * s + 2 * i], u1[8 * s + 2 * i + 1]); }
            }
#pragma unroll
            for (int d = 0; d < 2; ++d)
#pragma unroll
                for (int kh = 0; kh < 2; ++kh)
#pragma unroll
                    for (int s = 0; s < 2; ++s) {
                        const s16x4 lo = vtr(kb + voff + d * 4096 + kh * 2048 + s * 1024), hh = vtr(kb + voff + d * 4096 + kh * 2048 + s * 1024 + 512);
                        const bf16x8 vf = (bf16x8){lo[0], lo[1], lo[2], lo[3], hh[0], hh[1], hh[2], hh[3]};
#pragma unroll
                        for (int mp = 0; mp < NMAP; ++mp) { const v4u pw = {pk[mp][kh][s][0], pk[mp][kh][s][1], pk[mp][kh][s][2], pk[mp][kh][s][3]};
                            O[mp][d] = __builtin_amdgcn_mfma_f32_32x32x16_bf16(vf, __builtin_bit_cast(bf16x8, pw), O[mp][d], 0, 0, 0); }
                    }
        }
        asm volatile("s_waitcnt lgkmcnt(0)" ::: "memory");
    }
#undef ATT_DMA
    bf16* yrow = (bf16*)(p.ws + WS_Y) + ((size_t)b * SEQ + qpos) * DM + (MODE == 0 ? 768 : 512) + h * 64;
    const bf16* zrow = P + (size_t)qpos * PC + ZC;
    if (MODE == 0) {
        float pr = 0.f;
        if (lane < 32) pr = p.lq1[l * 32 + lane] * p.lk1[l * 32 + lane]; else pr = -(p.lq2[l * 32 + lane - 32] * p.lk2[l * 32 + lane - 32]);
        float d1 = pr;
#pragma unroll
        for (int o = 16; o > 0; o >>= 1) d1 += __shfl_xor(d1, o);
        const float e_mine = expf(lane < 32 ? d1 : -d1), e_other = __shfl_xor(e_mine, 32);
        const float lam_init = 0.8f - 0.6f * expf(-0.3f * (float)l);
        const float lam = (lane < 32 ? e_mine - e_other : e_other - e_mine) + lam_init;
        const float l0 = lsum[0] + __shfl_xor(lsum[0], 32), l1 = lsum[NMAP - 1] + __shfl_xor(lsum[NMAP - 1], 32);
        const float i0 = 1.0f / l0, i1 = lam / l1;
        float ss = 0.f;
#pragma unroll
        for (int d = 0; d < 2; ++d)
#pragma unroll
            for (int r = 0; r < 16; ++r) { const float o = O[0][d][r] * i0 - O[NMAP - 1][d][r] * i1; O[0][d][r] = o; ss += o * o; }
        ss += __shfl_xor(ss, 32);
        const float rs = rsqrtf(ss * (1.0f / 64.0f) + EPS) * (1.0f - lam_init);
        const float* ng = p.diff_g + l * HD;
#pragma unroll
        for (int d = 0; d < 2; ++d)
#pragma unroll
            for (int g4 = 0; g4 < 4; ++g4) { const int dd = d * 32 + 8 * g4 + 4 * hi;
                const float4 gn = *(const float4*)(ng + dd); const v2u z = *(const v2u*)(zrow + dd);
                const float z0 = __uint_as_float(z.x << 16), z1 = __uint_as_float(z.x & 0xffff0000u), z2 = __uint_as_float(z.y << 16), z3 = __uint_as_float(z.y & 0xffff0000u);
                v2u w; w.x = pk2(O[0][d][4 * g4] * rs * gn.x * siluf_(z0), O[0][d][4 * g4 + 1] * rs * gn.y * siluf_(z1));
                w.y = pk2(O[0][d][4 * g4 + 2] * rs * gn.z * siluf_(z2), O[0][d][4 * g4 + 3] * rs * gn.w * siluf_(z3));
                *(v2u*)(yrow + dd) = w; }
    } else {
        const float l0 = lsum[0] + __shfl_xor(lsum[0], 32);
        const float i0 = 1.0f / l0;
#pragma unroll
        for (int d = 0; d < 2; ++d)
#pragma unroll
            for (int g4 = 0; g4 < 4; ++g4) { const int dd = d * 32 + 8 * g4 + 4 * hi;
                const v2u z = *(const v2u*)(zrow + dd);
                const float z0 = __uint_as_float(z.x << 16), z1 = __uint_as_float(z.x & 0xffff0000u), z2 = __uint_as_float(z.y << 16), z3 = __uint_as_float(z.y & 0xffff0000u);
                v2u w; w.x = pk2(O[0][d][4 * g4] * i0 * siluf_(z0), O[0][d][4 * g4 + 1] * i0 * siluf_(z1));
                w.y = pk2(O[0][d][4 * g4 + 2] * i0 * siluf_(z2), O[0][d][4 * g4 + 3] * i0 * siluf_(z3));
                *(v2u*)(yrow + dd) = w; }
    }
}
}

__device__ __forceinline__ void phase_attn_mfma(const Params& p, int l, LAS unsigned char* lds) {
    for (int c = BIDX(); c < NB * NH * 4; c += gridDim.x) {
        const int bh = c >> 2, s = c & 3, b = bh >> 2, h = bh & 3;
        att::attn_unit<0>(p, l, b, h, 7 - s, lds);
        att::attn_unit<1>(p, l, b, h, 7 - s, lds);
        att::attn_unit<0>(p, l, b, h, s, lds);
        att::attn_unit<1>(p, l, b, h, s, lds);
    }
}

namespace scn {
typedef short bf16x8 __attribute__((ext_vector_type(8)));
typedef float f32x4 __attribute__((ext_vector_type(4)));
constexpr size_t CH_QT = 64 * 64 * 2, CH_OI = 64 * 64 * 2, CH_SL = 64 * 64 * 4, CH_M = 64 * 64 * 2, CH_DL = 64 * 4;
constexpr int NCH = NB * NH * 32;
constexpr size_t A_GST = 0, A_HST = 16 * MiB, A_GQT = 32 * MiB, A_HQT = 48 * MiB;
constexpr size_t B_GSL = 0, B_HSL = 32 * MiB, B_GMF = 64 * MiB, B_HDL = 96 * MiB;

__device__ __forceinline__ f32x4 mfma16(bf16x8 a, bf16x8 b, f32x4 c) { f32x4 r = __builtin_amdgcn_mfma_f32_16x16x32_bf16(a, b, c, 0, 0, 0); asm volatile("" : "+v"(r) : "v"(a), "v"(b)); return r; }
__device__ __forceinline__ float f_hi(float x) { return __uint_as_float(f2bf(x) << 16); }

template <int PART>
__device__ __forceinline__ void gdn_pre(const Params& p, int l, int item, LAS float* wl) {
    const int lane = TIDX() & 63, half = lane >> 5, j = lane & 31;
    const int ci = item >> 1, cb = (item & 1) * 32;
    const int b = ci >> 7, h = (ci >> 5) & 3, n = ci & 31, t0 = n * 64;
    const bf16* P = (const bf16*)(p.ws + WS_PROJ) + (size_t)b * SEQ * PC;
    const float* AB = (const float*)(p.ws + WS_AB) + (size_t)b * SEQ * 8;
    const float* cw = p.conv_w + (size_t)l * 4 * 768;
    const int cq_ = C_GQ + h * 64 + lane, ck_ = C_GK + h * 64 + lane, cv_ = C_GV + h * 64 + cb + j;
    float wq[4], wk[4], wv[4];
#pragma unroll
    for (int i = 0; i < 4; ++i) { wq[i] = cw[i * 768 + 0 + h * 64 + lane]; wk[i] = cw[i * 768 + 256 + h * 64 + lane]; wv[i] = cw[i * 768 + 512 + h * 64 + cb + j]; }
    const float Aexp = expf(p.a_log[l * NH + h]), dtb = p.dt_bias[l * NH + h];
    float xq[3] = {0.f, 0.f, 0.f}, xk[3] = {0.f, 0.f, 0.f}, xv[3] = {0.f, 0.f, 0.f};
    if (t0 > 0) {
#pragma unroll
        for (int i = 0; i < 3; ++i) { const bf16* pr = P + (size_t)(t0 - 3 + i) * PC; xq[i] = bf2f(pr[cq_]); xk[i] = bf2f(pr[ck_]); if (PART == 0) xv[i] = bf2f(pr[cv_]); }
    }
    float S[32];
#pragma unroll
    for (int i = 0; i < 32; ++i) S[i] = (PART == 1 && (32 * half + i) == (cb + j)) ? 1.f : 0.f;
    bf16* OI = (bf16*)(p.ws + WS_Y) + ((size_t)b * SEQ + t0) * DM + 0 + h * 64;
    bf16* QT = (bf16*)(p.ws + WS_XB + A_GQT + (size_t)ci * CH_QT);
    const LAS float* wk_ = wl + 32 * half; const LAS float* wq_ = wl + 64 + 32 * half;
    float nq, nk, nv = 0.f, na, nb;
    { const bf16* pr = P + (size_t)t0 * PC; nq = bf2f(pr[cq_]); nk = bf2f(pr[ck_]); if (PART == 0) nv = bf2f(pr[cv_]); na = AB[t0 * 8 + h]; nb = AB[t0 * 8 + 4 + h]; }
#pragma unroll 1
    for (int t = 0; t < 64; ++t) {
        const float cq = nq, ck = nk, cv = nv, ca = na, cb2 = nb;
        if (t + 1 < 64) { const bf16* pr = P + (size_t)(t0 + t + 1) * PC; nq = bf2f(pr[cq_]); nk = bf2f(pr[ck_]); if (PART == 0) nv = bf2f(pr[cv_]); na = AB[(t0 + t + 1) * 8 + h]; nb = AB[(t0 + t + 1) * 8 + 4 + h]; }
        float qc = wq[0] * xq[0] + wq[1] * xq[1] + wq[2] * xq[2] + wq[3] * cq;
        float kc = wk[0] * xk[0] + wk[1] * xk[1] + wk[2] * xk[2] + wk[3] * ck;
        xq[0] = xq[1]; xq[1] = xq[2]; xq[2] = cq; xk[0] = xk[1]; xk[1] = xk[2]; xk[2] = ck;
        float vc = 0.f;
        if (PART == 0) { vc = wv[0] * xv[0] + wv[1] * xv[1] + wv[2] * xv[2] + wv[3] * cv; xv[0] = xv[1]; xv[1] = xv[2]; xv[2] = cv; vc = fsilu(vc); }
        qc = fsilu(qc); kc = fsilu(kc);
        const float qss = fwave_sum(qc * qc), kss = fwave_sum(kc * kc);
        const float qn = qc * __builtin_amdgcn_rsqf(qss + EPS) * 0.125f, kn = kc * __builtin_amdgcn_rsqf(kss + EPS);
        const float g = -Aexp * fsoftplus(ca + dtb), beta = fsigmoid(cb2), eg = fexp(g);
        asm volatile("s_waitcnt lgkmcnt(0)" ::: "memory");
        wl[lane] = kn; wl[64 + lane] = qn;
        asm volatile("s_waitcnt lgkmcnt(0)" ::: "memory");
        float ks0 = 0.f, ks1 = 0.f, ks2 = 0.f, ks3 = 0.f;
#pragma unroll
        for (int i = 0; i < 32; i += 4) { const f4 k4 = *(const LAS f4*)(wk_ + i);
            S[i] *= eg; S[i + 1] *= eg; S[i + 2] *= eg; S[i + 3] *= eg;
            ks0 += k4.x * S[i]; ks1 += k4.y * S[i + 1]; ks2 += k4.z * S[i + 2]; ks3 += k4.w * S[i + 3]; }
        const float kS = xor32_sum((ks0 + ks1) + (ks2 + ks3));
        const float vn = beta * (vc - kS);
        float o0 = 0.f, o1 = 0.f, o2 = 0.f, o3 = 0.f;
#pragma unroll
        for (int i = 0; i < 32; i += 4) { const f4 k4 = *(const LAS f4*)(wk_ + i); const f4 q4 = *(const LAS f4*)(wq_ + i);
            S[i] += k4.x * vn; S[i + 1] += k4.y * vn; S[i + 2] += k4.z * vn; S[i + 3] += k4.w * vn;
            o0 += q4.x * S[i]; o1 += q4.y * S[i + 1]; o2 += q4.z * S[i + 2]; o3 += q4.w * S[i + 3]; }
        const float o = xor32_sum((o0 + o1) + (o2 + o3));
        if (half == 0) { if (PART == 1) QT[t * 64 + cb + j] = (bf16)f2bf(o); else OI[(size_t)t * DM + cb + j] = (bf16)f2bf(o); }
    }
    if (PART == 0) {
        float* SL = (float*)(p.ws + WS_SCR + B_GSL + (size_t)ci * CH_SL) + (cb + j) * 64 + 32 * half;
#pragma unroll
        for (int i = 0; i < 32; i += 4) *(float4*)(SL + i) = make_float4(S[i], S[i + 1], S[i + 2], S[i + 3]);
    } else {
        float* MF = (float*)(p.ws + WS_SCR + B_GMF + (size_t)ci * CH_SL) + (32 * half) * 64 + cb + j;
#pragma unroll
        for (int i = 0; i < 32; ++i) { MF[i * 64] = S[i]; if ((i & 7) == 7) asm volatile("" ::: "memory"); }
    }
}

__device__ __forceinline__ void hgrn_pre(const Params& p, int l, int ci, LAS float* wl) {
    const int lane = TIDX() & 63;
    const int b = ci >> 7, h = (ci >> 5) & 3, n = ci & 31, t0 = n * 64;
    const bf16* P = (const bf16*)(p.ws + WS_PROJ) + (size_t)b * SEQ * PC;
    float lb = 0.f;
    if (l == 1) { const float a0 = p.hgrn_lb[h * 64 + lane], a1 = p.hgrn_lb[GW + h * 64 + lane]; lb = 1.0f / (1.0f + expf(a0 - a1)); }
    float S[64];
#pragma unroll
    for (int d = 0; d < 64; ++d) S[d] = 0.f;
    float gam = 1.f;
    bf16* OI = (bf16*)(p.ws + WS_Y) + ((size_t)b * SEQ + t0) * DM + 256 + h * 64;
    bf16* QT = (bf16*)(p.ws + WS_XB + A_HQT + (size_t)ci * CH_QT);
    float nq, nf, nv;
    { const bf16* pr = P + (size_t)t0 * PC; nq = bf2f(pr[C_HQ + h * 64 + lane]); nf = bf2f(pr[C_HF + h * 64 + lane]); nv = bf2f(pr[C_HI + h * 64 + lane]); }
#pragma unroll 1
    for (int t = 0; t < 64; ++t) {
        const float cq = nq, cf = nf, vi = nv;
        if (t + 1 < 64) { const bf16* pr = P + (size_t)(t0 + t + 1) * PC; nq = bf2f(pr[C_HQ + h * 64 + lane]); nf = bf2f(pr[C_HF + h * 64 + lane]); nv = bf2f(pr[C_HI + h * 64 + lane]); }
        const float sg = fsigmoid(cf);
        const float fg = lb + (1.0f - lb) * sg;
        const float kk = (1.0f - lb) * (1.0f - sg);
        const float qq = fsilu(cq);
        gam *= fg;
        QT[t * 64 + lane] = (bf16)f2bf(qq * gam);
        asm volatile("s_waitcnt lgkmcnt(0)" ::: "memory");
        wl[lane] = fg; wl[64 + lane] = kk; wl[128 + lane] = qq;
        asm volatile("s_waitcnt lgkmcnt(0)" ::: "memory");
        float o0 = 0.f, o1 = 0.f, o2 = 0.f, o3 = 0.f;
#pragma unroll
        for (int d = 0; d < 64; d += 4) { const f4 f4_ = *(const LAS f4*)(wl + d); const f4 k4 = *(const LAS f4*)(wl + 64 + d); const f4 q4 = *(const LAS f4*)(wl + 128 + d);
            S[d] = f4_.x * S[d] + k4.x * vi; S[d + 1] = f4_.y * S[d + 1] + k4.y * vi; S[d + 2] = f4_.z * S[d + 2] + k4.z * vi; S[d + 3] = f4_.w * S[d + 3] + k4.w * vi;
            o0 += q4.x * S[d]; o1 += q4.y * S[d + 1]; o2 += q4.z * S[d + 2]; o3 += q4.w * S[d + 3]; }
        const float o = (o0 + o1) + (o2 + o3);
        OI[(size_t)t * DM + lane] = (bf16)f2bf(o);
    }
    float* SL = (float*)(p.ws + WS_SCR + B_HSL + (size_t)ci * CH_SL) + lane * 64;
#pragma unroll
    for (int d = 0; d < 64; d += 4) *(float4*)(SL + d) = make_float4(S[d], S[d + 1], S[d + 2], S[d + 3]);
    ((float*)(p.ws + WS_SCR + B_HDL + (size_t)ci * CH_DL))[lane] = gam;
}

__device__ __forceinline__ void kmean_item(const Params& p, int it) {
    const int lane = TIDX() & 63;
    const bf16* proj = (const bf16*)(p.ws + WS_PROJ); float* kmean = (float*)(p.ws + WS_KMEAN);
    const int sub = it & 3, j = (it >> 2) & 7, h = (it >> 5) & 3, b = it >> 7;
    const bf16* base = proj + ((size_t)b * SEQ + j * 256 + sub * 64) * PC + C_MK + h * 64 + lane;
    float acc[4] = {0.f, 0.f, 0.f, 0.f};
#pragma unroll
    for (int r0 = 0; r0 < 64; r0 += 16) { bf16 v[16];
#pragma unroll
        for (int i = 0; i < 16; ++i) v[i] = base[(size_t)(r0 + i) * PC];
#pragma unroll
        for (int i = 0; i < 16; ++i) acc[i & 3] += bf2f(v[i]); }
    kmean[(size_t)it * 64 + lane] = ((acc[0] + acc[1]) + (acc[2] + acc[3])) * (1.0f / 256.0f);
}

__device__ __forceinline__ void phase_pre(const Params& p, int l, LAS unsigned char* lds) {
    const int wave = TIDX() >> 6;
    LAS float* wl = (LAS float*)(lds + wave * 1024);
    const int gw = BIDX() * NWAVES + wave, NGW = gridDim.x * NWAVES;
    constexpr int N_G = 2 * NCH, N_H = NCH, N_K = NB * NH * 8;
    for (int it = gw; it < 2 * NCH; it += NGW) gdn_pre<1>(p, l, it, wl);
    for (int it = gw; it < 2 * NCH; it += NGW) gdn_pre<0>(p, l, it, wl);
    for (int it = gw; it < NCH; it += NGW) hgrn_pre(p, l, it, wl);
    for (int it = gw; it < N_K; it += NGW) kmean_item(p, it);
}

template <int KIND>
__device__ __forceinline__ void scan_unit(const Params& p, int l, int sp) {
    const int tid = TIDX(), lane = tid & 63, wid = __builtin_amdgcn_readfirstlane(tid >> 6), seq = wid >> 2, sl = wid & 3, c15 = lane & 15, g = lane >> 4;
    const int bh = sp * 2 + seq, dv = 16 * sl + c15;
    f32x4 S[4];
#pragma unroll
    for (int rb = 0; rb < 4; ++rb) S[rb] = (f32x4){0.f, 0.f, 0.f, 0.f};
    const unsigned char* SLb = p.ws + WS_SCR + (KIND == 0 ? B_GSL : B_HSL) + (size_t)bh * 32 * CH_SL;
    const unsigned char* MFb = p.ws + WS_SCR + B_GMF + (size_t)bh * 32 * CH_SL;
    const unsigned char* DLb = p.ws + WS_SCR + B_HDL + (size_t)bh * 32 * CH_DL;
    unsigned char* STb = p.ws + WS_XB + (KIND == 0 ? A_GST : A_HST) + (size_t)bh * 32 * CH_QT;
    float4 nsl[4], nm[KIND == 0 ? 16 : 4];
#define SCN_LOAD(n_) do { const float* SL_ = (const float*)(SLb + (size_t)(n_) * CH_SL); \
        _Pragma("unroll") for (int rb = 0; rb < 4; ++rb) nsl[rb] = *(const float4*)(SL_ + dv * 64 + 16 * rb + 4 * g); \
        if (KIND == 0) { const float* MF_ = (const float*)(MFb + (size_t)(n_) * CH_SL); \
            _Pragma("unroll") for (int rb = 0; rb < 4; ++rb) _Pragma("unroll") for (int ks = 0; ks < 2; ++ks) { const int off = (16 * rb + c15) * 64 + 32 * ks + 4 * g; \
                nm[(rb * 2 + ks) * 2] = *(const float4*)(MF_ + off); nm[(rb * 2 + ks) * 2 + 1] = *(const float4*)(MF_ + off + 16); } } \
        else { const float* DL_ = (const float*)(DLb + (size_t)(n_) * CH_DL); _Pragma("unroll") for (int rb = 0; rb < 4; ++rb) nm[rb] = *(const float4*)(DL_ + 16 * rb + 4 * g); } } while (0)
    SCN_LOAD(0);
#pragma unroll 1
    for (int n = 0; n < 32; ++n) {
        float4 csl[4], cm[KIND == 0 ? 16 : 4];
#pragma unroll
        for (int i = 0; i < 4; ++i) csl[i] = nsl[i];
#pragma unroll
        for (int i = 0; i < (KIND == 0 ? 16 : 4); ++i) cm[i] = nm[i];
        if (n + 1 < 32) SCN_LOAD(n + 1);
        bf16* ST = (bf16*)(STb + (size_t)n * CH_QT) + dv * 64 + 4 * g;
#pragma unroll
        for (int rb = 0; rb < 4; ++rb) { v2u w; w.x = pk2(S[rb][0], S[rb][1]); w.y = pk2(S[rb][2], S[rb][3]); *(v2u*)(ST + 16 * rb) = w; }
        if (KIND == 0) {
            bf16x8 Bh[2], Bl[2];
#pragma unroll
            for (int ks = 0; ks < 2; ++ks) { const f32x4 a = S[2 * ks], c = S[2 * ks + 1];
                v4u w; w.x = pk2(a[0], a[1]); w.y = pk2(a[2], a[3]); w.z = pk2(c[0], c[1]); w.w = pk2(c[2], c[3]); Bh[ks] = __builtin_bit_cast(bf16x8, w);
                v4u x; x.x = pk2(a[0] - f_hi(a[0]), a[1] - f_hi(a[1])); x.y = pk2(a[2] - f_hi(a[2]), a[3] - f_hi(a[3])); x.z = pk2(c[0] - f_hi(c[0]), c[1] - f_hi(c[1])); x.w = pk2(c[2] - f_hi(c[2]), c[3] - f_hi(c[3])); Bl[ks] = __builtin_bit_cast(bf16x8, x); }
#pragma unroll
            for (int rb = 0; rb < 4; ++rb) { f32x4 acc = (f32x4){csl[rb].x, csl[rb].y, csl[rb].z, csl[rb].w};
#pragma unroll
                for (int ks = 0; ks < 2; ++ks) { const float4 m0 = cm[(rb * 2 + ks) * 2], m1 = cm[(rb * 2 + ks) * 2 + 1];
                    v4u hw, lw;
                    hw.x = pk2(m0.x, m0.y); hw.y = pk2(m0.z, m0.w); hw.z = pk2(m1.x, m1.y); hw.w = pk2(m1.z, m1.w);
                    lw.x = pk2(m0.x - f_hi(m0.x), m0.y - f_hi(m0.y)); lw.y = pk2(m0.z - f_hi(m0.z), m0.w - f_hi(m0.w)); lw.z = pk2(m1.x - f_hi(m1.x), m1.y - f_hi(m1.y)); lw.w = pk2(m1.z - f_hi(m1.z), m1.w - f_hi(m1.w));
                    acc = mfma16(__builtin_bit_cast(bf16x8, lw), Bh[ks], acc);
                    acc = mfma16(__builtin_bit_cast(bf16x8, hw), Bl[ks], acc);
                    acc = mfma16(__builtin_bit_cast(bf16x8, hw), Bh[ks], acc); }
                csl[rb] = make_float4(acc[0], acc[1], acc[2], acc[3]); }
#pragma unroll
            for (int rb = 0; rb < 4; ++rb) S[rb] = (f32x4){csl[rb].x, csl[rb].y, csl[rb].z, csl[rb].w};
        } else {
#pragma unroll
            for (int rb = 0; rb < 4; ++rb) S[rb] = (f32x4){cm[rb].x * S[rb][0] + csl[rb].x, cm[rb].y * S[rb][1] + csl[rb].y, cm[rb].z * S[rb][2] + csl[rb].z, cm[rb].w * S[rb][3] + csl[rb].w};
        }
    }
#undef SCN_LOAD
}

__device__ __forceinline__ float row16_sum(float v) {
    v += __int_as_float(__builtin_amdgcn_update_dpp(0, __float_as_int(v), 0xB1, 0xF, 0xF, true));
    v += __int_as_float(__builtin_amdgcn_update_dpp(0, __float_as_int(v), 0x4E, 0xF, 0xF, true));
    v += __int_as_float(__builtin_amdgcn_update_dpp(0, __float_as_int(v), 0x141, 0xF, 0xF, true));
    v += __int_as_float(__builtin_amdgcn_update_dpp(0, __float_as_int(v), 0x140, 0xF, 0xF, true));
    return v;
}

template <int KIND>
__device__ __forceinline__ void out_item(const Params& p, int l, int ci, bool dry) {
    const int lane = TIDX() & 63, c15 = lane & 15, g = lane >> 4;
    const int b = ci >> 7, h = (ci >> 5) & 3, n = ci & 31, t0 = n * 64;
    const bf16* P = (const bf16*)(p.ws + WS_PROJ) + ((size_t)b * SEQ + t0) * PC + (KIND == 0 ? C_GZ : C_HZ) + h * 64;
    bf16* Y = (bf16*)(p.ws + WS_Y) + ((size_t)b * SEQ + t0) * DM + (KIND == 0 ? 0 : 256) + h * 64;
    const bf16* QT = (const bf16*)(p.ws + WS_XB + (KIND == 0 ? A_GQT : A_HQT) + (size_t)ci * CH_QT);
    const bf16* ST = (const bf16*)(p.ws + WS_XB + (KIND == 0 ? A_GST : A_HST) + (size_t)ci * CH_QT);
    const float* ngp = (KIND == 0 ? p.gdn_g : p.hgrn_g) + l * HD;
    bf16x8 Bf[4][2];
#pragma unroll
    for (int cbk = 0; cbk < 4; ++cbk)
#pragma unroll
        for (int ks = 0; ks < 2; ++ks) Bf[cbk][ks] = *(const bf16x8*)(ST + (16 * cbk + c15) * 64 + 32 * ks + 8 * g);
    float ng[4];
#pragma unroll
    for (int cbk = 0; cbk < 4; ++cbk) ng[cbk] = ngp[16 * cbk + c15];
#pragma unroll 1
    for (int rb = 0; rb < 4; ++rb) {
        bf16x8 Af[2];
#pragma unroll
        for (int ks = 0; ks < 2; ++ks) Af[ks] = *(const bf16x8*)(QT + (16 * rb + c15) * 64 + 32 * ks + 8 * g);
        f32x4 o[4]; float zz[4][4];
#pragma unroll
        for (int cbk = 0; cbk < 4; ++cbk) {
            const bf16* yi = Y + (size_t)(16 * rb + 4 * g) * DM + 16 * cbk + c15; const bf16* zi = P + (size_t)(16 * rb + 4 * g) * PC + 16 * cbk + c15;
            o[cbk] = (f32x4){bf2f(yi[0]), bf2f(yi[DM]), bf2f(yi[2 * DM]), bf2f(yi[3 * DM])};
#pragma unroll
            for (int r = 0; r < 4; ++r) zz[cbk][r] = bf2f(zi[(size_t)r * PC]);
        }
#pragma unroll
        for (int cbk = 0; cbk < 4; ++cbk)
#pragma unroll
            for (int ks = 0; ks < 2; ++ks) o[cbk] = mfma16(Af[ks], Bf[cbk][ks], o[cbk]);
#pragma unroll
        for (int r = 0; r < 4; ++r) {
            float ss = o[0][r] * o[0][r] + o[1][r] * o[1][r] + o[2][r] * o[2][r] + o[3][r] * o[3][r];
            ss = row16_sum(ss);
            const float rs = rsqrtf(ss * (1.0f / 64.0f) + EPS);
#pragma unroll
            for (int cbk = 0; cbk < 4; ++cbk) { const bf16 ov = (bf16)f2bf(o[cbk][r] * rs * ng[cbk] * siluf_(zz[cbk][r])); if (dry) asm volatile("" :: "v"(ov)); else Y[(size_t)(16 * rb + 4 * g + r) * DM + 16 * cbk + c15] = ov; }
        }
    }
}
__device__ __forceinline__ void phase_out(const Params& p, int l, bool dry = false) {
    const int wave = TIDX() >> 6;
    const int gw = BIDX() * NWAVES + wave, NGW = gridDim.x * NWAVES;
    for (int it = gw; it < 2 * NCH; it += NGW) { if (it < NCH) out_item<0>(p, l, it, dry); else out_item<1>(p, l, it - NCH, dry); }
}
}

#ifndef REP_SCAN
#define REP_SCAN 1
#endif
#ifndef REP_ATT
#define REP_ATT 1
#endif
#ifndef REP_ATT_KIND
#define REP_ATT_KIND 2
#endif
#ifndef REP_ATT_QB
#define REP_ATT_QB 0
#endif
#ifndef REP_ATT_DRY
#define REP_ATT_DRY 0
#endif
__device__ __forceinline__ void phase_mix(const Params& p, int l, LAS unsigned char* lds) {
    const int c = BIDX();
    for (int rep = 0; rep < REP_SCAN; ++rep)
    for (int u = c; u < 64; u += gridDim.x) { if (u < 32) scn::scan_unit<0>(p, l, u); else scn::scan_unit<1>(p, l, u - 32); }
    LAS unsigned* bc = (LAS unsigned*)(lds + att::NSLOT * att::BUFB);
    for (int rep = 0; rep < REP_ATT; ++rep) {
    unsigned* ctr = (unsigned*)(p.ws + WS_CTL) + 64 * (1 + l + 2 * rep);
    for (;;) {
        __syncthreads();
        if (TIDX() == 0) bc[0] = atomicAdd(ctr, 1u);
        __syncthreads();
        const unsigned u = bc[0];
        if (u >= 1024u) break;
        const int qb = 7 - (int)(u >> 7), rest = u & 127, kind = rest & 1, bh = rest >> 1, b = bh >> 2, h = bh & 3;
        if (kind == 0) att::attn_unit<0>(p, l, b, h, qb, lds); else att::attn_unit<1>(p, l, b, h, qb, lds);
    }
    }
}

#ifndef GREP_S1A
#define GREP_S1A 1
#endif
#ifndef GREP_S1B
#define GREP_S1B 1
#endif
#ifndef GREP_S2A
#define GREP_S2A 1
#endif
#ifndef GREP_S2B
#define GREP_S2B 1
#endif
#ifndef GREP_S4
#define GREP_S4 1
#endif
#ifndef WY_OUTMASK
#define WY_OUTMASK 15
#endif
namespace wy {
typedef short bf16x8 __attribute__((ext_vector_type(8)));
typedef short bf16x4 __attribute__((ext_vector_type(4)));
typedef float f32x4 __attribute__((ext_vector_type(4)));
constexpr int LP = 72, ROWB = LP * 2;
__device__ __forceinline__ f32x4 mm32(const LAS unsigned char* X, int xr, const LAS unsigned char* Y, int yr, int k0, f32x4 acc, int c15, int g) {
    const bf16x8 a = *(const LAS bf16x8*)(X + (xr + c15) * ROWB + (k0 + 8 * g) * 2);
    const bf16x8 b = *(const LAS bf16x8*)(Y + (yr + c15) * ROWB + (k0 + 8 * g) * 2);
    f32x4 r = __builtin_amdgcn_mfma_f32_16x16x32_bf16(a, b, acc, 0, 0, 0);
    asm volatile("" : "+v"(r) : "v"(a), "v"(b));
    return r;
}
__device__ __forceinline__ f32x4 mm16(const LAS unsigned char* X, int xr, const LAS unsigned char* Y, int yr, int k0, f32x4 acc, int c15, int g) {
    const bf16x4 a = *(const LAS bf16x4*)(X + (xr + c15) * ROWB + (k0 + 4 * g) * 2);
    const bf16x4 b = *(const LAS bf16x4*)(Y + (yr + c15) * ROWB + (k0 + 4 * g) * 2);
    f32x4 r = __builtin_amdgcn_mfma_f32_16x16x16bf16_1k(a, b, acc, 0, 0, 0);
    asm volatile("" : "+v"(r) : "v"(a), "v"(b));
    return r;
}
__device__ __forceinline__ f32x4 zacc() { f32x4 z = (f32x4){0.f, 0.f, 0.f, 0.f}; asm volatile("" : "+v"(z)); return z; }
template <int KLEN>
__device__ __forceinline__ f32x4 mmk(const LAS unsigned char* X, int xr, const LAS unsigned char* Y, int yr, f32x4 acc, int c15, int g) {
#pragma unroll
    for (int k = 0; k + 32 <= KLEN; k += 32) acc = mm32(X, xr, Y, yr, k, acc, c15, g);
    if (KLEN % 32) acc = mm16(X, xr, Y, yr, KLEN - 16, acc, c15, g);
    return acc;
}
__device__ __forceinline__ float sum8_dpp(float v) {
    v += __int_as_float(__builtin_amdgcn_update_dpp(0, __float_as_int(v), 0xB1, 0xF, 0xF, true));
    v += __int_as_float(__builtin_amdgcn_update_dpp(0, __float_as_int(v), 0x4E, 0xF, 0xF, true));
    v += __int_as_float(__builtin_amdgcn_update_dpp(0, __float_as_int(v), 0x141, 0xF, 0xF, true));
    return v;
}
__device__ __forceinline__ void unpack8(const v4u w, float (&f)[8]) {
    f[0] = __uint_as_float(w.x << 16); f[1] = __uint_as_float(w.x & 0xffff0000u); f[2] = __uint_as_float(w.y << 16); f[3] = __uint_as_float(w.y & 0xffff0000u);
    f[4] = __uint_as_float(w.z << 16); f[5] = __uint_as_float(w.z & 0xffff0000u); f[6] = __uint_as_float(w.w << 16); f[7] = __uint_as_float(w.w & 0xffff0000u);
}
__device__ __forceinline__ v4u pack8(const float (&f)[8]) { v4u w; w.x = pk2(f[0], f[1]); w.y = pk2(f[2], f[3]); w.z = pk2(f[4], f[5]); w.w = pk2(f[6], f[7]); return w; }

constexpr int G_KH = 0, G_QH = 9216, G_VH = 18432, G_KTD = 27648, G_XT = 36864, G_AKK = 55296, G_AQK = 64512, G_TB = 73728, G_AD = 76800, G_SC = 80896;
constexpr int TBP = 24;
constexpr int G_ST_MF = 83968, G_ST_SL = 101376, G_ST_QT = 118784, G_ST_Y = 0;
__device__ __forceinline__ void gdn_chunk(const Params& p, int l, int ci, LAS unsigned char* lds) {
    const int tid = TIDX(), lane = tid & 63, wid = __builtin_amdgcn_readfirstlane(tid >> 6), c15 = lane & 15, g = lane >> 4;
    const int b = ci >> 7, h = (ci >> 5) & 3, n = ci & 31, t0 = n * 64;
    const bf16* P = (const bf16*)(p.ws + WS_PROJ) + (size_t)b * SEQ * PC;
    LAS float* sc_g = (LAS float*)(lds + G_SC); LAS float* sc_b = sc_g + 64; LAS float* sc_gc = sc_g + 128; LAS float* sc_eg = sc_g + 192; LAS float* sc_dl = sc_g + 256;
    __syncthreads();
    for (int rp_ = 0; rp_ < GREP_S1A; ++rp_) {
        const int tok = tid >> 3, c8 = tid & 7;
        const float* cw = p.conv_w + (size_t)l * 4 * 768 + h * 64 + 8 * c8;
        float aq[8], ak[8], av[8];
#pragma unroll
        for (int i = 0; i < 8; ++i) { aq[i] = 0.f; ak[i] = 0.f; av[i] = 0.f; }
        v4u lq[4], lk[4], lv[4]; float4 wgt[4][6];
#pragma unroll
        for (int r = 0; r < 4; ++r) {
            const int row = t0 + tok - 3 + r, rowc = row < 0 ? 0 : row;
            const bf16* pr = P + (size_t)rowc * PC + h * 64 + 8 * c8;
            lq[r] = *(const v4u*)(pr + C_GQ); lk[r] = *(const v4u*)(pr + C_GK); lv[r] = *(const v4u*)(pr + C_GV);
            wgt[r][0] = *(const float4*)(cw + r * 768); wgt[r][1] = *(const float4*)(cw + r * 768 + 4); wgt[r][2] = *(const float4*)(cw + r * 768 + 256); wgt[r][3] = *(const float4*)(cw + r * 768 + 260);
            wgt[r][4] = *(const float4*)(cw + r * 768 + 512); wgt[r][5] = *(const float4*)(cw + r * 768 + 516);
        }
#pragma unroll
        for (int r = 0; r < 4; ++r) {
            const float m = (t0 + tok - 3 + r) < 0 ? 0.f : 1.f;
            float xq[8], xk[8], xv[8];
            unpack8(lq[r], xq); unpack8(lk[r], xk); unpack8(lv[r], xv);
            const float wq[8] = {wgt[r][0].x, wgt[r][0].y, wgt[r][0].z, wgt[r][0].w, wgt[r][1].x, wgt[r][1].y, wgt[r][1].z, wgt[r][1].w};
            const float wk[8] = {wgt[r][2].x, wgt[r][2].y, wgt[r][2].z, wgt[r][2].w, wgt[r][3].x, wgt[r][3].y, wgt[r][3].z, wgt[r][3].w};
            const float wv[8] = {wgt[r][4].x, wgt[r][4].y, wgt[r][4].z, wgt[r][4].w, wgt[r][5].x, wgt[r][5].y, wgt[r][5].z, wgt[r][5].w};
#pragma unroll
            for (int i = 0; i < 8; ++i) { aq[i] += m * wq[i] * xq[i]; ak[i] += m * wk[i] * xk[i]; av[i] += m * wv[i] * xv[i]; }
        }
        float sq = 0.f, sk = 0.f;
#pragma unroll
        for (int i = 0; i < 8; ++i) { aq[i] = fsilu(aq[i]); ak[i] = fsilu(ak[i]); av[i] = fsilu(av[i]); sq += aq[i] * aq[i]; sk += ak[i] * ak[i]; }
        sq = sum8_dpp(sq); sk = sum8_dpp(sk);
        const float rq = __builtin_amdgcn_rsqf(sq + EPS) * 0.125f, rk = __builtin_amdgcn_rsqf(sk + EPS);
#pragma unroll
        for (int i = 0; i < 8; ++i) { aq[i] *= rq; ak[i] *= rk; }
        *(LAS v4u*)(lds + G_QH + tok * ROWB + 16 * c8) = pack8(aq);
        *(LAS v4u*)(lds + G_KH + tok * ROWB + 16 * c8) = pack8(ak);
        *(LAS v4u*)(lds + G_VH + tok * ROWB + 16 * c8) = pack8(av);
        if (c8 == 0) { const float* AB = (const float*)(p.ws + WS_AB) + ((size_t)b * SEQ + t0 + tok) * 8;
            sc_g[tok] = -expf(p.a_log[l * NH + h]) * fsoftplus(AB[h] + p.dt_bias[l * NH + h]); sc_b[tok] = fsigmoid(AB[4 + h]); }
    }
    __syncthreads();
    for (int rp_ = 0; rp_ < GREP_S1B; ++rp_) {
        const int d = tid & 63, tq = tid >> 6;
        float pre = 0.f, tot = 0.f;
#pragma unroll
        for (int j = 0; j < 64; j += 4) { const f4 g4 = *(const LAS f4*)(sc_g + j); const float s4 = (g4.x + g4.y) + (g4.z + g4.w); tot += s4; if (j < 8 * tq) pre += s4; }
        float gc[8], bt[8];
        { const f4 a = *(const LAS f4*)(sc_g + 8 * tq), c = *(const LAS f4*)(sc_g + 8 * tq + 4), b0 = *(const LAS f4*)(sc_b + 8 * tq), b1 = *(const LAS f4*)(sc_b + 8 * tq + 4);
          gc[0] = pre + a.x; gc[1] = gc[0] + a.y; gc[2] = gc[1] + a.z; gc[3] = gc[2] + a.w; gc[4] = gc[3] + c.x; gc[5] = gc[4] + c.y; gc[6] = gc[5] + c.z; gc[7] = gc[6] + c.w;
          bt[0] = b0.x; bt[1] = b0.y; bt[2] = b0.z; bt[3] = b0.w; bt[4] = b1.x; bt[5] = b1.y; bt[6] = b1.z; bt[7] = b1.w; }
        float xv[8], xw[8], xk[8];
#pragma unroll
        for (int i = 0; i < 8; ++i) { const float eg = fexp(gc[i]), ed = fexp(tot - gc[i]);
            const float kv = bf2f(*(const LAS bf16*)(lds + G_KH + (8 * tq + i) * ROWB + 2 * d)), vv = bf2f(*(const LAS bf16*)(lds + G_VH + (8 * tq + i) * ROWB + 2 * d));
            xv[i] = vv * bt[i]; xw[i] = kv * bt[i] * eg; xk[i] = kv * ed;
            if (d == 0) { sc_gc[8 * tq + i] = gc[i]; sc_eg[8 * tq + i] = eg; } }
        if (tid == 0) sc_dl[0] = fexp(tot);
        *(LAS v4u*)(lds + G_XT + d * ROWB + 16 * tq) = pack8(xv);
        *(LAS v4u*)(lds + G_XT + (64 + d) * ROWB + 16 * tq) = pack8(xw);
        *(LAS v4u*)(lds + G_KTD + d * ROWB + 16 * tq) = pack8(xk);
    }
    __syncthreads();
    for (int rp_ = 0; rp_ < GREP_S2A; ++rp_) {
#pragma unroll 1
        for (int step = 0; step < 2; ++step) {
            if (step == 1) __syncthreads();
            const bool isq = step == 1;
            if (isq && wid == 0) {
                const int blk = lane >> 4, c = lane & 15;
                const LAS float* Ad = (const LAS float*)(lds + G_AD) + blk * 256;
                float t[16];
#pragma unroll
                for (int i = 0; i < 16; ++i) { float s = (i == c) ? 1.f : 0.f;
#pragma unroll
                    for (int j = 0; j < i; ++j) s -= Ad[i * 16 + j] * t[j];
                    t[i] = s; *(LAS bf16*)(lds + G_TB + ((blk * 16 + i) * TBP + c) * 2) = (bf16)f2bf(s); }
            } else {
                for (int tt = isq ? wid - 1 : wid; tt < 10; tt += (isq ? 7 : 8)) {
                    const int I = (tt >= 6) ? 3 : (tt >= 3) ? 2 : (tt >= 1) ? 1 : 0, J = tt - (I * (I + 1)) / 2;
                    f32x4 acc = zacc();
                    acc = mmk<64>(lds + (isq ? G_QH : G_KH), 16 * I, lds + G_KH, 16 * J, acc, c15, g);
                    const int jj = 16 * J + c15; const float gj = sc_gc[jj];
#pragma unroll
                    for (int r = 0; r < 4; ++r) { const int ii = 16 * I + 4 * g + r; const float dec = fexp(sc_gc[ii] - gj);
                        if (isq) { const float v = (jj <= ii) ? acc[r] * dec : 0.f; *(LAS bf16*)(lds + G_AQK + ii * ROWB + 2 * jj) = (bf16)f2bf(v); }
                        else { const float v = (jj < ii) ? acc[r] * dec * sc_b[ii] : 0.f; *(LAS bf16*)(lds + G_AKK + ii * ROWB + 2 * jj) = (bf16)f2bf(-v);
                            if (I == J) ((LAS float*)(lds + G_AD))[I * 256 + (4 * g + r) * 16 + c15] = v; } }
                }
            }
        }
    }
    __syncthreads();
    {
        const int cb = 16 * wid;
#pragma unroll
        for (int I = 0; I < 4; ++I) {
            LAS unsigned char* xp = lds + G_XT + (cb + c15) * ROWB + (16 * I + 4 * g) * 2;
            const v2u rr = *(const LAS v2u*)xp;
            f32x4 acc = (f32x4){__uint_as_float(rr.x << 16), __uint_as_float(rr.x & 0xffff0000u), __uint_as_float(rr.y << 16), __uint_as_float(rr.y & 0xffff0000u)};
            if (I == 1) acc = mmk<16>(lds + G_AKK, 16, lds + G_XT, cb, acc, c15, g);
            if (I == 2) acc = mmk<32>(lds + G_AKK, 32, lds + G_XT, cb, acc, c15, g);
            if (I == 3) acc = mmk<48>(lds + G_AKK, 48, lds + G_XT, cb, acc, c15, g);
            const bf16x4 ta = *(const LAS bf16x4*)(lds + G_TB + ((I * 16 + c15) * TBP + 4 * g) * 2);
            v2u bw; bw.x = pk2(acc[0], acc[1]); bw.y = pk2(acc[2], acc[3]);
            const bf16x4 tb = __builtin_bit_cast(bf16x4, bw);
            f32x4 x = __builtin_amdgcn_mfma_f32_16x16x16bf16_1k(ta, tb, zacc(), 0, 0, 0);
            asm volatile("" : "+v"(x) : "v"(ta), "v"(tb));
            v2u xw; xw.x = pk2(x[0], x[1]); xw.y = pk2(x[2], x[3]);
            *(LAS v2u*)xp = xw;
            asm volatile("s_waitcnt lgkmcnt(0)" ::: "memory");
        }
    }
    __syncthreads();
    for (int rp_ = 0; rp_ < GREP_S4; ++rp_) {
        const int type = wid >> 1, hf = wid & 1;
        const float dlast = sc_dl[0];
#pragma unroll
        for (int rb = 0; rb < 4; ++rb)
#pragma unroll
            for (int cc = 0; cc < 2; ++cc) {
                const int cbk = 2 * hf + cc;
                f32x4 acc = zacc();
                const int col = 16 * cbk + c15;
                if (type == 0) { acc = mmk<64>(lds + G_KTD, 16 * rb, lds + G_XT, 64 + 16 * cbk, acc, c15, g);
#pragma unroll
                    for (int r = 0; r < 4; ++r) { const int row = 16 * rb + 4 * g + r; *(LAS float*)(lds + G_ST_MF + row * 272 + col * 4) = ((row == col) ? dlast : 0.f) - acc[r]; } }
                else if (type == 1) { acc = mmk<64>(lds + G_XT, 16 * rb, lds + G_KTD, 16 * cbk, acc, c15, g);
#pragma unroll
                    for (int r = 0; r < 4; ++r) *(LAS float*)(lds + G_ST_SL + (16 * rb + 4 * g + r) * 272 + col * 4) = acc[r]; }
                else {
                    const int yr = (type == 2 ? 64 : 0) + 16 * cbk;
                    if (rb == 0) acc = mmk<16>(lds + G_AQK, 0, lds + G_XT, yr, acc, c15, g);
                    if (rb == 1) acc = mmk<32>(lds + G_AQK, 16, lds + G_XT, yr, acc, c15, g);
                    if (rb == 2) acc = mmk<48>(lds + G_AQK, 32, lds + G_XT, yr, acc, c15, g);
                    if (rb == 3) acc = mmk<64>(lds + G_AQK, 48, lds + G_XT, yr, acc, c15, g);
#pragma unroll
                    for (int r = 0; r < 4; ++r) { const int row = 16 * rb + 4 * g + r;
                        if (type == 2) *(LAS bf16*)(lds + G_ST_QT + row * ROWB + 2 * col) = (bf16)f2bf(sc_eg[row] * bf2f(*(const LAS bf16*)(lds + G_QH + row * ROWB + 2 * col)) - acc[r]);
                        else *(LAS bf16*)(lds + G_ST_Y + row * ROWB + 2 * col) = (bf16)f2bf(acc[r]); } }
            }
    }
    __syncthreads();
    {
        float* MF = (float*)(p.ws + WS_SCR + scn::B_GMF + (size_t)ci * scn::CH_SL);
        float* SL = (float*)(p.ws + WS_SCR + scn::B_GSL + (size_t)ci * scn::CH_SL);
        bf16* QT = (bf16*)(p.ws + WS_XB + scn::A_GQT + (size_t)ci * scn::CH_QT);
        bf16* Y = (bf16*)(p.ws + WS_Y) + ((size_t)b * SEQ + t0) * DM + 0 + h * 64;
#pragma unroll
        for (int i = 0; i < 2; ++i) { const int pz = tid + 512 * i, row = pz >> 4, c4 = pz & 15;
            *(v4u*)(MF + row * 64 + c4 * 4) = *(const LAS v4u*)(lds + G_ST_MF + row * 272 + c4 * 16);
            *(v4u*)(SL + row * 64 + c4 * 4) = *(const LAS v4u*)(lds + G_ST_SL + row * 272 + c4 * 16); }
        { const int row = tid >> 3, c8 = tid & 7;
            *(v4u*)(QT + row * 64 + c8 * 8) = *(const LAS v4u*)(lds + G_ST_QT + row * ROWB + c8 * 16);
            *(v4u*)(Y + (size_t)row * DM + c8 * 8) = *(const LAS v4u*)(lds + G_ST_Y + row * ROWB + c8 * 16); }
    }
}

constexpr int H_QD = 0, H_KD = 9216, H_QO = 18432, H_KO1 = 27648  , H_KO2 = 29952  , H_KO3 = 34560  , H_KTD = 41472, H_VT = 50688, H_A = 59904, H_SC = 69120  , H_ST_SL = 73728, H_ST_Y = 91136;
__device__ __forceinline__ void hgrn_chunk(const Params& p, int l, int ci, LAS unsigned char* lds) {
    const int tid = TIDX(), lane = tid & 63, wid = __builtin_amdgcn_readfirstlane(tid >> 6), c15 = lane & 15, g = lane >> 4;
    const int b = ci >> 7, h = (ci >> 5) & 3, n = ci & 31, t0 = n * 64;
    const bf16* P = (const bf16*)(p.ws + WS_PROJ) + ((size_t)b * SEQ + t0) * PC + h * 64;
    LAS float* s_tot = (LAS float*)(lds + H_SC); LAS float* s_gm = s_tot + 512; LAS float* s_gr = s_tot + 768;
    const int ch = tid & 63, tq = tid >> 6;
    float lb = 0.f;
    if (l == 1) { const float a0 = p.hgrn_lb[h * 64 + ch], a1 = p.hgrn_lb[GW + h * 64 + ch]; lb = __builtin_amdgcn_rcpf(1.0f + fexp(a0 - a1)); }
    float qv[8], kv[8], vv[8], G[8];
    {
        float run = 0.f;
#pragma unroll
        for (int i = 0; i < 8; ++i) { const bf16* pr = P + (size_t)(8 * tq + i) * PC + ch;
            const float qr = bf2f(pr[C_HQ]), fr = bf2f(pr[C_HF]); vv[i] = bf2f(pr[C_HI]);
            const float sg = fsigmoid(fr), fg = lb + (1.0f - lb) * sg;
            kv[i] = (1.0f - lb) * (1.0f - sg); qv[i] = fsilu(qr);
            run += 0.6931471805599453f * __builtin_amdgcn_logf(fg); G[i] = run; }
        __syncthreads();
        s_tot[tq * 64 + ch] = run;
    }
    __syncthreads();
    float Glast;
    {
        float pre = 0.f, tot = 0.f;
#pragma unroll
        for (int j = 0; j < 8; ++j) { const float tj = s_tot[j * 64 + ch]; tot += tj; if (j < tq) pre += tj; }
#pragma unroll
        for (int i = 0; i < 8; ++i) G[i] += pre;
        Glast = tot;
        if (tq & 1) s_gm[(tq >> 1) * 64 + ch] = G[0];
        else if (tq > 0) s_gr[(tq >> 1) * 64 + ch] = pre;
    }
    __syncthreads();
    {
        const int I = tq >> 1;
        const float gm = s_gm[I * 64 + ch], gr = (I > 0) ? s_gr[I * 64 + ch] : 0.f;
        const float gr1 = s_gr[64 + ch], gr2 = s_gr[128 + ch], gr3 = s_gr[192 + ch];
        bf16* QT = (bf16*)(p.ws + WS_XB + scn::A_HQT + (size_t)ci * scn::CH_QT);
        float kt[8];
#pragma unroll
        for (int i = 0; i < 8; ++i) { const int tok = 8 * tq + i;
            QT[tok * 64 + ch] = (bf16)f2bf(qv[i] * fexp(G[i]));
            *(LAS bf16*)(lds + H_QD + tok * ROWB + 2 * ch) = (bf16)f2bf(qv[i] * fexp(G[i] - gm));
            *(LAS bf16*)(lds + H_KD + tok * ROWB + 2 * ch) = (bf16)f2bf(kv[i] * fexp(gm - G[i]));
            if (I > 0) *(LAS bf16*)(lds + H_QO + tok * ROWB + 2 * ch) = (bf16)f2bf(qv[i] * fexp(G[i] - gr));
            if (I < 1) *(LAS bf16*)(lds + H_KO1 + tok * ROWB + 2 * ch) = (bf16)f2bf(kv[i] * fexp(gr1 - G[i]));
            if (I < 2) *(LAS bf16*)(lds + H_KO2 + tok * ROWB + 2 * ch) = (bf16)f2bf(kv[i] * fexp(gr2 - G[i]));
            if (I < 3) *(LAS bf16*)(lds + H_KO3 + tok * ROWB + 2 * ch) = (bf16)f2bf(kv[i] * fexp(gr3 - G[i]));
            kt[i] = kv[i] * fexp(Glast - G[i]); }
        *(LAS v4u*)(lds + H_KTD + ch * ROWB + 16 * tq) = pack8(kt);
        *(LAS v4u*)(lds + H_VT + ch * ROWB + 16 * tq) = pack8(vv);
        if (tq == 0) ((float*)(p.ws + WS_SCR + scn::B_HDL + (size_t)ci * scn::CH_DL))[ch] = fexp(Glast);
    }
    __syncthreads();
    {
        for (int t = wid; t < 26; t += 8) {
            f32x4 acc = zacc();
            if (t < 10) {
                const int I = (t >= 6) ? 3 : (t >= 3) ? 2 : (t >= 1) ? 1 : 0, J = t - (I * (I + 1)) / 2;
                if (I == J) acc = mmk<64>(lds + H_QD, 16 * I, lds + H_KD, 16 * I, acc, c15, g);
                else acc = mmk<64>(lds + H_QO, 16 * I, lds + (I == 1 ? H_KO1 : I == 2 ? H_KO2 : H_KO3), 16 * J, acc, c15, g);
#pragma unroll
                for (int r = 0; r < 4; ++r) { const int ii = 16 * I + 4 * g + r, jj = 16 * J + c15; *(LAS bf16*)(lds + H_A + ii * ROWB + 2 * jj) = (bf16)f2bf((jj <= ii) ? acc[r] : 0.f); }
            } else {
                const int u = t - 10, rb = u >> 2, cbk = u & 3;
                acc = mmk<64>(lds + H_VT, 16 * rb, lds + H_KTD, 16 * cbk, acc, c15, g);
#pragma unroll
                for (int r = 0; r < 4; ++r) *(LAS float*)(lds + H_ST_SL + (16 * rb + 4 * g + r) * 272 + (16 * cbk + c15) * 4) = acc[r];
            }
        }
    }
    __syncthreads();
    {
        bf16* Y = (bf16*)(p.ws + WS_Y) + ((size_t)b * SEQ + t0) * DM + 256 + h * 64;
#pragma unroll
        for (int q2 = 0; q2 < 2; ++q2) {
            const int u = wid * 2 + q2, rb = u >> 2, cbk = u & 3;
            f32x4 acc = zacc();
            if (rb == 0) acc = mmk<16>(lds + H_A, 0, lds + H_VT, 16 * cbk, acc, c15, g);
            else if (rb == 1) acc = mmk<32>(lds + H_A, 16, lds + H_VT, 16 * cbk, acc, c15, g);
            else if (rb == 2) acc = mmk<48>(lds + H_A, 32, lds + H_VT, 16 * cbk, acc, c15, g);
            else acc = mmk<64>(lds + H_A, 48, lds + H_VT, 16 * cbk, acc, c15, g);
#pragma unroll
            for (int r = 0; r < 4; ++r) *(LAS bf16*)(lds + H_ST_Y + (16 * rb + 4 * g + r) * ROWB + 2 * (16 * cbk + c15)) = (bf16)f2bf(acc[r]);
        }
        __syncthreads();
        float* SL = (float*)(p.ws + WS_SCR + scn::B_HSL + (size_t)ci * scn::CH_SL);
#pragma unroll
        for (int i = 0; i < 2; ++i) { const int pz = tid + 512 * i, row = pz >> 4, c4 = pz & 15; *(v4u*)(SL + row * 64 + c4 * 4) = *(const LAS v4u*)(lds + H_ST_SL + row * 272 + c4 * 16); }
        { const int row = tid >> 3, c8 = tid & 7; *(v4u*)(Y + (size_t)row * DM + c8 * 8) = *(const LAS v4u*)(lds + H_ST_Y + row * ROWB + c8 * 16); }
    }
}

#ifndef WY_GDN
#define WY_GDN 1
#endif
#ifndef WY_REP_G
#define WY_REP_G 1
#endif
#ifndef WY_REP_H
#define WY_REP_H 1
#endif
#ifndef WY_HGRN
#define WY_HGRN 1
#endif
__device__ __forceinline__ void phase_pre_mfma(const Params& p, int l, LAS unsigned char* lds) {
    const int wave = TIDX() >> 6;
    LAS float* wl = (LAS float*)(lds + 100 * 1024 + wave * 1024);
    const int gw = BIDX() * NWAVES + wave, NGW = gridDim.x * NWAVES;
    if (WY_GDN && WY_OUTMASK == 15) { for (int rep = 0; rep < WY_REP_G; ++rep) for (int ci = BIDX(); ci < scn::NCH; ci += gridDim.x) gdn_chunk(p, l, ci, lds); }
    else { for (int it = gw; it < 2 * scn::NCH; it += NGW) scn::gdn_pre<1>(p, l, it, wl); for (int it = gw; it < 2 * scn::NCH; it += NGW) scn::gdn_pre<0>(p, l, it, wl); }
    if (WY_HGRN) { for (int rep = 0; rep < WY_REP_H; ++rep) for (int ci = BIDX(); ci < scn::NCH; ci += gridDim.x) hgrn_chunk(p, l, ci, lds); }
    else { __syncthreads(); for (int it = gw; it < scn::NCH; it += NGW) scn::hgrn_pre(p, l, it, wl); }
    __syncthreads();
    for (int it = gw; it < NB * NH * 8 * 4; it += NGW) scn::kmean_item(p, it);
}
__device__ __forceinline__ void phase_gdn_probe(const Params& p, int l, LAS unsigned char* lds) { for (int ci = BIDX(); ci < scn::NCH; ci += gridDim.x) gdn_chunk(p, l, ci, lds); }
}
#ifndef GIN_ALIGN
#define GIN_ALIGN true
#endif
#ifndef GIN_SP2
#define GIN_SP2 true
#endif
#ifndef REP_PRE
#define REP_PRE 1
#endif
#ifndef REP_POST0
#define REP_POST0 1
#endif
#ifndef REP_PROLOGUE
#define REP_PROLOGUE 1
#endif
#ifndef REP_BAR
#define REP_BAR 1
#endif
#ifndef REP_GIN
#define REP_GIN 1
#endif
#ifndef REP_GOUT
#define REP_GOUT 1
#endif
#ifndef REP_OUT
#define REP_OUT 1
#endif
#ifndef REP_MIX
#define REP_MIX 1
#endif

__device__ __forceinline__ Params load_params() {
    const __attribute__((address_space(4))) Params* q = (const __attribute__((address_space(4))) Params*)__builtin_amdgcn_kernarg_segment_ptr();
    asm volatile("" : "+s"(q));
    return *(const Params*)q;
}
__device__ __forceinline__ void grid_barrier(LAS unsigned char* lds) {
    const Params p = load_params();
    XcdBarrier bar; bar.bar = (unsigned*)(p.ws + WS_CTL) + 4096; bar.x = xb_xcc_id(); bar.st = (volatile LAS unsigned*)(lds + 131072 + 64);
    xcd_barrier(bar);
}
__global__ void __launch_bounds__(NT, 2) fwd_megakernel(Params p_unused) {
    extern __shared__ __attribute__((aligned(16))) unsigned char lds_raw[];
    LAS unsigned char* lds = (LAS unsigned char*)lds_raw;
    {
        const Params p = load_params();
        volatile LAS unsigned* st = (volatile LAS unsigned*)(lds + 131072 + 64);
        if (TIDX() < 2) st[TIDX()] = 0u;
        __syncthreads();
        (void)xcd_barrier_post((unsigned*)(p.ws + WS_CTL) + 4096, st);
        for (int rep = 0; rep < REP_PROLOGUE; ++rep) phase_prologue(p, lds);
    }
    grid_barrier(lds);
#pragma unroll 1
    for (int l = 0; l < DEPTH; ++l) {
        for (int rep = 0; rep < REP_GIN; ++rep) {
            const Params p = load_params();
            pg8::Gemm g{(const bf16*)(p.ws + WS_XB), (const bf16*)(p.ws + WS_WIN) + (size_t)l * PC * DM, NTOK, PC, DM}; pg8::StaticOrder S; S.init(NTOK, PC, (int)gridDim.x, BIDX());
            pg8::EpiProj E{(bf16*)(p.ws + WS_PROJ), PC, (const float*)(p.ws + WS_RSTD)};
            pg8::gemm_phase<pg8::EpiProj, pg8::StaticOrder, GIN_ALIGN, GIN_SP2>(lds, g, S, E);
        }
        grid_barrier(lds);
        for (int rep = 0; rep < REP_PRE; ++rep) { const Params p = load_params(); wy::phase_pre_mfma(p, l, lds); }
#if WY_OUTMASK != 15
        grid_barrier(lds);
        { const Params p = load_params(); wy::phase_gdn_probe(p, l, lds); }
#endif
        grid_barrier(lds);
        { const Params p = load_params(); phase_mix(p, l, lds); }
        for (int rep = 0; rep < REP_BAR; ++rep) grid_barrier(lds);
        for (int rep = 0; rep < REP_OUT; ++rep) { const Params p = load_params(); scn::phase_out(p, l, rep + 1 < REP_OUT); }
        grid_barrier(lds);
        for (int rep = 0; rep < REP_GOUT; ++rep) {
            const Params p = load_params();
            pg8::Gemm g{(const bf16*)(p.ws + WS_Y), (const bf16*)(p.ws + WS_WOUT) + (size_t)l * DM * DM, NTOK, DM, DM}; pg8::StaticOrder S; S.init(NTOK, DM, (int)gridDim.x, BIDX());
            pg8::EpiBf16Plain E{(bf16*)(p.ws + WS_PROJ), DM};
            pg8::gemm_phase<pg8::EpiBf16Plain, pg8::StaticOrder, true, true>(lds, g, S, E);
        }
        grid_barrier(lds);
        for (int rep = 0; rep < ((l == 0) ? REP_POST0 : 1); ++rep) { const Params p = load_params(); phase_post(p, l, lds); }
        grid_barrier(lds);
    }
}

extern "C" void kernel_launch(void* const* d_in, const int* in_sizes, int n_in, void* d_out, int out_size, void* d_ws, size_t ws_size, hipStream_t stream) {
    static int grid_blocks = 0;
    if (!grid_blocks) {
        if (ws_size < WS_END) { fprintf(stderr, "workspace too small: %zu < %zu\n", ws_size, (size_t)WS_END); grid_blocks = -1; return; }
        int dev = 0, cus = 0, per_cu = 0;
        (void)hipGetDevice(&dev);
        (void)hipDeviceGetAttribute(&cus, hipDeviceAttributeMultiprocessorCount, dev);
        (void)hipFuncSetAttribute((const void*)fwd_megakernel, hipFuncAttributeMaxDynamicSharedMemorySize, LDS_BYTES);
        (void)hipOccupancyMaxActiveBlocksPerMultiprocessor(&per_cu, (const void*)fwd_megakernel, NT, LDS_BYTES);
        if (per_cu < 1) { fprintf(stderr, "occupancy query says %d blocks/CU\n", per_cu); per_cu = 1; }
        grid_blocks = cus * 1;
    }
    if (grid_blocks < 0) return;
    (void)hipMemsetAsync((char*)d_ws + WS_CTL, 0, 65536, stream);
    Params p{};
    p.x = (const float*)d_in[0]; p.pre_g = (const float*)d_in[1]; p.post_g = (const float*)d_in[2]; p.w_in = (const float*)d_in[3];
    p.conv_w = (const float*)d_in[4]; p.a_log = (const float*)d_in[5]; p.dt_bias = (const float*)d_in[6]; p.gdn_g = (const float*)d_in[7];
    p.hgrn_lb = (const float*)d_in[8]; p.hgrn_g = (const float*)d_in[9]; p.lq1 = (const float*)d_in[10]; p.lk1 = (const float*)d_in[11];
    p.lq2 = (const float*)d_in[12]; p.lk2 = (const float*)d_in[13]; p.diff_g = (const float*)d_in[14]; p.w_out = (const float*)d_in[15];
    p.out = (float*)d_out; p.ws = (unsigned char*)d_ws;
    void* args[] = {&p};
    hipError_t e = hipLaunchCooperativeKernel((void*)fwd_megakernel, dim3(grid_blocks), dim3(NT), args, LDS_BYTES, stream);
    if (e != hipSuccess) fprintf(stderr, "cooperative launch failed: %s (grid %d)\n", hipGetErrorString(e), grid_blocks);
}
```

```cpp
#include <hip/hip_runtime.h>
#include <hip/hip_cooperative_groups.h>
#include <cstdio>
#include <cstdint>
#include <cmath>
namespace cg = cooperative_groups;
__device__ __forceinline__ int TIDX() { int t = threadIdx.x; asm volatile("" : "+v"(t)); return t; }
__device__ __forceinline__ int BIDX() { int b = blockIdx.x; asm volatile("" : "+s"(b)); return b; }
namespace pg8 {
#define PG8_LAS __attribute__((address_space(3)))
typedef unsigned short bf16_t;
typedef short bf16x8 __attribute__((ext_vector_type(8)));
typedef float f32x4 __attribute__((ext_vector_type(4)));
typedef unsigned u32x4 __attribute__((ext_vector_type(4)));
constexpr int BM = 256, BK = 64, HALF = 128, HTB = HALF * BK * 2  , STAGE_BYTES = 8 * HTB, NXCD = 8, WGM = 8;

__host__ __device__ __forceinline__ int lds_byte(int r, int c) { const int st = (r >> 4) * 2 + (c >> 5), rr = r & 15, cc = c & 31, ob = rr * 64 + cc * 2; return st * 1024 + (ob ^ (((ob >> 9) & 1) << 5)); }
__host__ __device__ __forceinline__ void stage_rc(int b, int& R, int& C) { const int st = b / 1024, sb = b % 1024, swz = sb ^ (((sb >> 9) & 1) << 5); R = (st >> 1) * 16 + swz / 64; C = (st & 1) * 32 + (swz % 64) / 2; }
__host__ __device__ __forceinline__ int perm32(int rho) { const int n = rho >> 4, i = rho & 15; return 8 * (i >> 2) + 4 * n + (i & 3); }

struct Unit { int pm, pn; };
struct Gemm { const bf16_t* A; const bf16_t* Bt; int M, N, K; };

struct StaticOrder {
    int nM, nN, nwg, G, c;
    __host__ __device__ void init(int M, int N, int G_, int c_) { nM = M / BM; nN = N / BM; nwg = nM * nN; G = G_; c = c_; }
    __host__ __device__ bool next(int i, Unit& u) const {
        const long L = (long)i * G + c; if (L >= nwg) return false;
        int wgid = (int)L; { const int q = nwg / NXCD, r = nwg % NXCD, xcd = wgid % NXCD, off = wgid / NXCD; wgid = (xcd < r ? xcd * (q + 1) : r * (q + 1) + (xcd - r) * q) + off; }
        const int nig = WGM * nN, gid = wgid / nig, fm = gid * WGM, gsz = (nM - fm) < WGM ? (nM - fm) : WGM;
        u.pm = fm + ((wgid % nig) % gsz); u.pn = (wgid % nig) / gsz; return true;
    }
    __device__ __forceinline__ void a_ready(const Unit&) const {}
    __device__ __forceinline__ void done(const Unit&) const {}
};
__device__ __forceinline__ unsigned cvt_pk_bf16(float lo, float hi) { unsigned r; asm volatile("v_cvt_pk_bf16_f32 %0, %1, %2" : "=v"(r) : "v"(lo), "v"(hi)); return r; }
struct EpiProj {
    static constexpr bool PERM = true, AFTER_DRAIN = false;
    bf16_t* O; int ldc; const float* rstd;
    __device__ __forceinline__ void operator()(const f32x4 (&acc)[2][2][4][2], const Unit& u, int wr, int wc, int fr, int fq) const {
        const int row0 = u.pm * BM + wr * 64 + fr, col0 = u.pn * BM + wc * 32 + 8 * fq;
#pragma unroll
        for (int ai = 0; ai < 2; ++ai)
#pragma unroll
            for (int m = 0; m < 4; ++m) { const int row = row0 + ai * HALF + m * 16; const float s = rstd[row]; bf16_t* rowp = O + (size_t)row * ldc + col0;
#pragma unroll
                for (int bj = 0; bj < 2; ++bj) { const f32x4 v0 = acc[ai][bj][m][0] * s, v1 = acc[ai][bj][m][1] * s;
                    u32x4 w; w.x = cvt_pk_bf16(v0[0], v0[1]); w.y = cvt_pk_bf16(v0[2], v0[3]); w.z = cvt_pk_bf16(v1[0], v1[1]); w.w = cvt_pk_bf16(v1[2], v1[3]);
                    *(u32x4*)(rowp + bj * HALF) = w; } }
    }
};
struct EpiF32 {
    static constexpr bool PERM = false, AFTER_DRAIN = false;
    float* O; int ldc;
    __device__ __forceinline__ void operator()(const f32x4 (&acc)[2][2][4][2], const Unit& u, int wr, int wc, int fr, int fq) const {
        const int row0 = u.pm * BM + wr * 64 + fr, col0 = u.pn * BM + wc * 32 + 4 * fq;
#pragma unroll
        for (int ai = 0; ai < 2; ++ai)
#pragma unroll
            for (int m = 0; m < 4; ++m) { float* rowp = O + (size_t)(row0 + ai * HALF + m * 16) * ldc + col0;
#pragma unroll
                for (int bj = 0; bj < 2; ++bj)
#pragma unroll
                    for (int n = 0; n < 2; ++n) *(f32x4*)(rowp + bj * HALF + n * 16) = acc[ai][bj][m][n]; }
    }
};
struct EpiBf16Plain {
    static constexpr bool PERM = true, AFTER_DRAIN = false;
    bf16_t* O; int ldc;
    __device__ __forceinline__ void operator()(const f32x4 (&acc)[2][2][4][2], const Unit& u, int wr, int wc, int fr, int fq) const {
        const int row0 = u.pm * BM + wr * 64 + fr, col0 = u.pn * BM + wc * 32 + 8 * fq;
#pragma unroll
        for (int ai = 0; ai < 2; ++ai)
#pragma unroll
            for (int m = 0; m < 4; ++m) { bf16_t* rowp = O + (size_t)(row0 + ai * HALF + m * 16) * ldc + col0;
#pragma unroll
                for (int bj = 0; bj < 2; ++bj) { const f32x4 v0 = acc[ai][bj][m][0], v1 = acc[ai][bj][m][1];
                    u32x4 w; w.x = cvt_pk_bf16(v0[0], v0[1]); w.y = cvt_pk_bf16(v0[2], v0[3]); w.z = cvt_pk_bf16(v1[0], v1[1]); w.w = cvt_pk_bf16(v1[2], v1[3]);
                    *(u32x4*)(rowp + bj * HALF) = w; } }
    }
};
template <class Epi, class Sched, bool ALIGN_EPI = false, bool SP2 = false>
__device__ __forceinline__ void gemm_phase(PG8_LAS unsigned char* lds, const Gemm g, const Sched& S, const Epi& E) {
    const int tid = TIDX(), wid = __builtin_amdgcn_readfirstlane(tid >> 6), lane = tid & 63, wr = wid >> 2, wc = wid & 3, fr = lane & 15, fq = lane >> 4;
    const int K = g.K, nt = K / BK;
    unsigned voffA[2], voffB[2];
#pragma unroll
    for (int i = 0; i < 2; ++i) { int R, C; stage_rc(tid * 16 + i * 8192, R, C); const int Rb = Epi::PERM ? ((R & ~31) + perm32(R & 31)) : R;
        voffA[i] = (unsigned)(R * K + C) * 2u; voffB[i] = (unsigned)(Rb * K + C) * 2u; }
    const size_t kstep = (size_t)(BK * 2);
    const size_t hstep = (size_t)HALF * K * 2;
    const size_t tstep = 2 * hstep;
    const unsigned ldsw = (unsigned)wid * 1024u;
    const int aoff = lds_byte(wr * 64 + fr, fq * 8), boff = lds_byte(wc * 32 + fr, fq * 8);
#define PG8_SA(b, h) (((b) * 2 + (h)) * HTB)
#define PG8_SB(b, h) ((4 + (b) * 2 + (h)) * HTB)
#define PG8_STAGE(bufoff, gbase, voff) do { _Pragma("unroll") for (int _i = 0; _i < 2; ++_i) \
        __builtin_amdgcn_global_load_lds((const unsigned*)((const char*)(gbase) + (voff)[_i]), (PG8_LAS unsigned*)(lds + (bufoff) + ldsw + _i * 8192), 16, 0, 0); } while (0)
#define PG8_LDA(dst, b, h) do { _Pragma("unroll") for (int m = 0; m < 4; ++m) _Pragma("unroll") for (int k = 0; k < 2; ++k) dst[m][k] = *(const PG8_LAS bf16x8*)(lds + PG8_SA(b, h) + aoff + m * 2048 + k * 1024); } while (0)
#define PG8_LDB(dst, b, h) do { _Pragma("unroll") for (int n = 0; n < 2; ++n) _Pragma("unroll") for (int k = 0; k < 2; ++k) dst[n][k] = *(const PG8_LAS bf16x8*)(lds + PG8_SB(b, h) + boff + n * 2048 + k * 1024); } while (0)
#define PG8_MMA(ai, bj, At, Bt) do { __builtin_amdgcn_s_setprio(1); _Pragma("unroll") for (int m = 0; m < 4; ++m) _Pragma("unroll") for (int n = 0; n < 2; ++n) _Pragma("unroll") for (int k = 0; k < 2; ++k) \
        acc[ai][bj][m][n] = __builtin_amdgcn_mfma_f32_16x16x32_bf16(Bt[n][k], At[m][k], acc[ai][bj][m][n], 0, 0, 0); __builtin_amdgcn_s_setprio(0); } while (0)
#define PG8_WAIT_V(n) asm volatile("s_waitcnt vmcnt(" #n ")" ::: "memory")
#define PG8_WAIT_L(n) asm volatile("s_waitcnt lgkmcnt(" #n ")" ::: "memory")
#define PG8_BAR __builtin_amdgcn_s_barrier()
#define PG8_SCHED __builtin_amdgcn_sched_barrier(0)
    Unit cur, nxt; int ui = 0;
    if (!S.next(0, cur)) return;
    f32x4 acc[2][2][4][2];
#pragma unroll
    for (int a = 0; a < 2; ++a)
#pragma unroll
        for (int b = 0; b < 2; ++b)
#pragma unroll
            for (int m = 0; m < 4; ++m)
#pragma unroll
                for (int n = 0; n < 2; ++n) acc[a][b][m][n] = (f32x4){0.f, 0.f, 0.f, 0.f};
    bf16x8 At[4][2], B0[2][2], B1[2][2];
    const char* cA = (const char*)g.A + (size_t)cur.pm * tstep; const char* cB = (const char*)g.Bt + (size_t)cur.pn * tstep;
    S.a_ready(cur);
    if constexpr (SP2) {
        PG8_STAGE(PG8_SB(0, 0), cB, voffB); PG8_STAGE(PG8_SB(0, 1), cB + hstep, voffB); PG8_STAGE(PG8_SA(0, 0), cA, voffA); PG8_STAGE(PG8_SA(0, 1), cA + hstep, voffA);
        if (wr == 1) PG8_BAR;
        PG8_WAIT_V(2); PG8_BAR;
        PG8_STAGE(PG8_SB(1, 0), cB + kstep, voffB); PG8_STAGE(PG8_SA(1, 0), cA + kstep, voffA); PG8_STAGE(PG8_SB(1, 1), cB + hstep + kstep, voffB);
        PG8_WAIT_V(6); PG8_BAR;
    } else {
        PG8_STAGE(PG8_SB(0, 0), cB, voffB); PG8_STAGE(PG8_SA(0, 0), cA, voffA); PG8_STAGE(PG8_SB(0, 1), cB + hstep, voffB); PG8_STAGE(PG8_SA(0, 1), cA + hstep, voffA);
        if (wr == 1) PG8_BAR;
        PG8_WAIT_V(4); PG8_BAR;
        PG8_STAGE(PG8_SB(1, 0), cB + kstep, voffB); PG8_STAGE(PG8_SA(1, 0), cA + kstep, voffA); PG8_STAGE(PG8_SB(1, 1), cB + hstep + kstep, voffB);
        PG8_WAIT_V(6); PG8_BAR;
    }
    for (;;) {
        const bool has_next = S.next(ui + 1, nxt);
        const char* nA = has_next ? (const char*)g.A + (size_t)nxt.pm * tstep : cA; const char* nB = has_next ? (const char*)g.Bt + (size_t)nxt.pn * tstep : cB;
        for (int t = 0; t < nt; t += 2) {
            const bool last = (t == nt - 2);
            const char* a1 = cA + (size_t)(t + 1) * kstep;
            const char* a2 = last ? nA : cA + (size_t)(t + 2) * kstep; const char* b2 = last ? nB : cB + (size_t)(t + 2) * kstep;
            const char* a3 = a2 + kstep; const char* b3 = b2 + kstep;
            if (last && has_next) S.a_ready(nxt);
            if constexpr (SP2) {
            PG8_LDB(B0, 0, 0); PG8_LDB(B1, 0, 1); PG8_SCHED; PG8_LDA(At, 0, 0); PG8_STAGE(PG8_SA(1, 1), a1 + hstep, voffA);
            PG8_WAIT_V(8); PG8_WAIT_L(0); PG8_BAR; PG8_MMA(0, 0, At, B0); PG8_MMA(0, 1, At, B1); PG8_BAR; PG8_SCHED;
            PG8_LDA(At, 0, 1); PG8_STAGE(PG8_SB(0, 0), b2, voffB); PG8_STAGE(PG8_SB(0, 1), b2 + hstep, voffB); PG8_STAGE(PG8_SA(0, 0), a2, voffA);
            PG8_WAIT_V(8); PG8_WAIT_L(0); PG8_BAR; PG8_MMA(1, 0, At, B0); PG8_MMA(1, 1, At, B1); PG8_BAR; PG8_SCHED;
            PG8_LDB(B0, 1, 0); PG8_LDB(B1, 1, 1); PG8_SCHED; PG8_LDA(At, 1, 0); PG8_STAGE(PG8_SA(0, 1), a2 + hstep, voffA);
            PG8_WAIT_V(8); PG8_WAIT_L(0); PG8_BAR; PG8_MMA(0, 0, At, B0); PG8_MMA(0, 1, At, B1); PG8_BAR; PG8_SCHED;
            PG8_LDA(At, 1, 1); PG8_STAGE(PG8_SB(1, 0), b3, voffB); PG8_STAGE(PG8_SB(1, 1), b3 + hstep, voffB); PG8_STAGE(PG8_SA(1, 0), a3, voffA);
            PG8_WAIT_V(8); PG8_WAIT_L(0); PG8_BAR; PG8_MMA(1, 0, At, B0); PG8_MMA(1, 1, At, B1); PG8_BAR; PG8_SCHED;
            } else {
            PG8_LDB(B0, 0, 0); PG8_SCHED; PG8_LDA(At, 0, 0); PG8_STAGE(PG8_SA(1, 1), a1 + hstep, voffA);
            PG8_WAIT_L(8); PG8_BAR; PG8_WAIT_L(0); PG8_MMA(0, 0, At, B0); PG8_BAR; PG8_SCHED;
            PG8_LDB(B1, 0, 1); PG8_STAGE(PG8_SB(0, 0), b2, voffB);
            PG8_BAR; PG8_WAIT_L(0); PG8_MMA(0, 1, At, B1); PG8_BAR;
            PG8_LDA(At, 0, 1); PG8_STAGE(PG8_SA(0, 0), a2, voffA);
            PG8_BAR; PG8_WAIT_L(0); PG8_MMA(1, 0, At, B0); PG8_BAR; PG8_SCHED;
            PG8_STAGE(PG8_SB(0, 1), b2 + hstep, voffB);
            PG8_WAIT_V(6); PG8_BAR; PG8_MMA(1, 1, At, B1); PG8_BAR;
            PG8_LDB(B0, 1, 0); PG8_SCHED; PG8_LDA(At, 1, 0); PG8_STAGE(PG8_SA(0, 1), a2 + hstep, voffA);
            PG8_WAIT_L(8); PG8_BAR; PG8_WAIT_L(0); PG8_MMA(0, 0, At, B0); PG8_BAR; PG8_SCHED;
            PG8_LDB(B1, 1, 1); PG8_STAGE(PG8_SB(1, 0), b3, voffB);
            PG8_BAR; PG8_WAIT_L(0); PG8_MMA(0, 1, At, B1); PG8_BAR;
            PG8_LDA(At, 1, 1); PG8_STAGE(PG8_SA(1, 0), a3, voffA);
            PG8_BAR; PG8_WAIT_L(0); PG8_MMA(1, 0, At, B0); PG8_BAR; PG8_SCHED;
            PG8_STAGE(PG8_SB(1, 1), b3 + hstep, voffB);
            PG8_WAIT_V(6); PG8_BAR; PG8_MMA(1, 1, At, B1); PG8_BAR;
            }
        }
        if constexpr (ALIGN_EPI) { if (wr == 0) PG8_BAR; }
        if constexpr (!Epi::AFTER_DRAIN) { E(acc, cur, wr, wc, fr, fq); S.done(cur); }
        if (!has_next) break;
#pragma unroll
        for (int a = 0; a < 2; ++a)
#pragma unroll
            for (int b = 0; b < 2; ++b)
#pragma unroll
                for (int m = 0; m < 4; ++m)
#pragma unroll
                    for (int n = 0; n < 2; ++n) acc[a][b][m][n] = (f32x4){0.f, 0.f, 0.f, 0.f};
        cur = nxt; cA = nA; cB = nB; ++ui;
        if constexpr (ALIGN_EPI) { if (wr == 1) PG8_BAR; }
    }
    PG8_WAIT_V(0);
    if constexpr (!ALIGN_EPI) { if (wr == 0) PG8_BAR; }
    PG8_BAR;
    if constexpr (Epi::AFTER_DRAIN) { E.fused(acc, cur, wr, wc, fr, fq, lds, wid, lane); S.done(cur); }
#undef PG8_SA
#undef PG8_SB
#undef PG8_STAGE
#undef PG8_LDA
#undef PG8_LDB
#undef PG8_MMA
#undef PG8_WAIT_V
#undef PG8_WAIT_L
#undef PG8_BAR
#undef PG8_SCHED
}
}

#define LAS __attribute__((address_space(3)))
typedef unsigned short bf16;
typedef unsigned v4u __attribute__((ext_vector_type(4)));
typedef unsigned v2u __attribute__((ext_vector_type(2)));
typedef float f4 __attribute__((ext_vector_type(4)));
constexpr int DM = 1024, NB = 16, SEQ = 2048, DEPTH = 2, NTOK = NB * SEQ;
constexpr int GW = 256, NH = 4, HD = 64;
constexpr int INC = 4104;
constexpr int PC = 4096;
constexpr int NT = 512, NWAVES = 8;
constexpr float EPS = 1e-6f;
constexpr int C_GQ = 0, C_GK = 256, C_GV = 512, C_GZ = 768;
constexpr int C_HQ = 1024, C_HF = 1280, C_HI = 1536, C_HZ = 1792;
constexpr int C_MQ = 2048, C_MK = 2304, C_MV = 2560, C_MZ = 2816;
constexpr int C_DQ = 3072, C_DK = 3328, C_DV = 3584, C_DZ = 3840;
constexpr int LDS_BYTES = 147456;

constexpr size_t MiB = 1u << 20;
constexpr size_t WS_CTL = 0;
constexpr size_t WS_PROJ = 1 * MiB;
constexpr size_t WS_XB = WS_PROJ + 256 * MiB;
constexpr size_t WS_Y = WS_XB + 64 * MiB;
constexpr size_t WS_WIN = WS_Y + 64 * MiB;
constexpr size_t WS_WOUT = WS_WIN + 16 * MiB;
constexpr size_t WS_RSTD = WS_WOUT + 4 * MiB;
constexpr size_t WS_AB = WS_RSTD + 1 * MiB;
constexpr size_t WS_KMEAN = WS_AB + 1 * MiB;
constexpr size_t WS_SCR = WS_KMEAN + 1 * MiB;
constexpr size_t WS_END = WS_SCR + 104 * MiB;

struct Params {
    const float* x; const float* pre_g; const float* post_g; const float* w_in; const float* conv_w;
    const float* a_log; const float* dt_bias; const float* gdn_g; const float* hgrn_lb; const float* hgrn_g;
    const float* lq1; const float* lk1; const float* lq2; const float* lk2; const float* diff_g; const float* w_out;
    float* out; unsigned char* ws;
};

__device__ __forceinline__ float wave_sum(float v) {
#pragma unroll
    for (int o = 32; o > 0; o >>= 1) v += __shfl_xor(v, o);
    return v;
}
__device__ __forceinline__ float sigmoidf_(float x) { return 1.0f / (1.0f + expf(-x)); }
__device__ __forceinline__ float siluf_(float x) { return x / (1.0f + expf(-x)); }
__device__ __forceinline__ float softplusf_(float x) { return fmaxf(x, 0.f) + log1pf(expf(-fabsf(x))); }
__device__ __forceinline__ float fexp(float x) { return __builtin_amdgcn_exp2f(x * 1.4426950408889634f); }
__device__ __forceinline__ float fsigmoid(float x) { return __builtin_amdgcn_rcpf(1.0f + fexp(-x)); }
__device__ __forceinline__ float fsilu(float x) { return x * fsigmoid(x); }
__device__ __forceinline__ float fsoftplus(float x) { return fmaxf(x, 0.f) + 0.6931471805599453f * __builtin_amdgcn_logf(1.0f + fexp(-fabsf(x))); }
__device__ __forceinline__ float dpp_row16_sum(float v) {
    v += __int_as_float(__builtin_amdgcn_update_dpp(0, __float_as_int(v), 0xB1, 0xF, 0xF, true));
    v += __int_as_float(__builtin_amdgcn_update_dpp(0, __float_as_int(v), 0x4E, 0xF, 0xF, true));
    v += __int_as_float(__builtin_amdgcn_update_dpp(0, __float_as_int(v), 0x141, 0xF, 0xF, true));
    v += __int_as_float(__builtin_amdgcn_update_dpp(0, __float_as_int(v), 0x140, 0xF, 0xF, true));
    return v;
}
__device__ __forceinline__ float xor32_sum(float v) { const auto rr = __builtin_amdgcn_permlane32_swap(__float_as_uint(v), __float_as_uint(v), false, false); return __uint_as_float(rr[0]) + __uint_as_float(rr[1]); }
__device__ __forceinline__ float fwave_sum(float v) { v = dpp_row16_sum(v);
    return (__int_as_float(__builtin_amdgcn_readlane(__float_as_int(v), 0)) + __int_as_float(__builtin_amdgcn_readlane(__float_as_int(v), 16))) + (__int_as_float(__builtin_amdgcn_readlane(__float_as_int(v), 32)) + __int_as_float(__builtin_amdgcn_readlane(__float_as_int(v), 48))); }
__device__ __forceinline__ float bf2f(bf16 v) { return __uint_as_float((unsigned)v << 16); }
__device__ __forceinline__ unsigned f2bf(float f) { unsigned u = __float_as_uint(f); return (u + 0x7fffu + ((u >> 16) & 1u)) >> 16; }
__device__ __forceinline__ unsigned pk2(float lo, float hi) { return f2bf(lo) | (f2bf(hi) << 16); }
__device__ __forceinline__ float rlane(float v, int l) { return __int_as_float(__builtin_amdgcn_readlane(__float_as_int(v), l)); }

__device__ __forceinline__ void transpose_item(const float* W, int ldw, int K, const float* gk, bf16* WT, int n_src0, int n_dst0, int k0, LAS float* scr, int lane) {
#pragma unroll 8
    for (int i = 0; i < 32; ++i) { const int kk = 2 * i + (lane >> 5); float v = W[(size_t)(k0 + kk) * ldw + n_src0 + (lane & 31)]; if (gk) v *= gk[k0 + kk]; scr[kk * 33 + (lane & 31)] = v; }
    asm volatile("s_waitcnt lgkmcnt(0)" ::: "memory");
    const int c = lane & 7;
#pragma unroll
    for (int j = 0; j < 4; ++j) { const int n = (lane >> 3) + 8 * j; const LAS float* s = scr + (8 * c) * 33 + n;
        v4u o; o.x = pk2(s[0 * 33], s[1 * 33]); o.y = pk2(s[2 * 33], s[3 * 33]); o.z = pk2(s[4 * 33], s[5 * 33]); o.w = pk2(s[6 * 33], s[7 * 33]);
        *(v4u*)(WT + (size_t)(n_dst0 + n) * K + k0 + 8 * c) = o; }
    asm volatile("s_waitcnt lgkmcnt(0)" ::: "memory");
}
__device__ __forceinline__ void load_wab(const Params& p, int l, LAS float* wab) {
    const float* W = p.w_in + (size_t)l * DM * INC; const float* g = p.pre_g + l * DM;
    for (int i = TIDX(); i < 8 * DM; i += NT) { const int k = i >> 3, j = i & 7; wab[j * DM + k] = W[(size_t)k * INC + 768 + j] * g[k]; }
}
__device__ __forceinline__ void row_prep(const float4 (&v)[4], int row, int lane, bf16* xb, float* rstd, float* ab, const LAS float* wab) {
    float ss = 0.f;
#pragma unroll
    for (int j = 0; j < 4; ++j) ss += v[j].x * v[j].x + v[j].y * v[j].y + v[j].z * v[j].z + v[j].w * v[j].w;
    ss = wave_sum(ss);
    const float rs = rsqrtf(ss * (1.0f / DM) + EPS);
    v2u* o8 = (v2u*)(xb + (size_t)row * DM) + lane;
#pragma unroll
    for (int j = 0; j < 4; ++j) { v2u w; w.x = pk2(v[j].x, v[j].y); w.y = pk2(v[j].z, v[j].w); o8[64 * j] = w; }
    float acc[8];
#pragma unroll
    for (int j8 = 0; j8 < 8; ++j8) { float a = 0.f;
#pragma unroll
        for (int j = 0; j < 4; ++j) { const f4 w = *(const LAS f4*)(wab + j8 * DM + 256 * j + 4 * lane); a += v[j].x * w.x + v[j].y * w.y + v[j].z * w.z + v[j].w * w.w; }
        acc[j8] = wave_sum(a); }
    if (lane == 0) { rstd[row] = rs;
        *(float4*)(ab + (size_t)row * 8) = make_float4(acc[0] * rs, acc[1] * rs, acc[2] * rs, acc[3] * rs);
        *(float4*)(ab + (size_t)row * 8 + 4) = make_float4(acc[4] * rs, acc[5] * rs, acc[6] * rs, acc[7] * rs); }
}

__device__ __forceinline__ void phase_prologue(const Params& p, LAS unsigned char* lds) {
    const int lane = TIDX() & 63, wave = TIDX() >> 6;
    LAS float* wab = (LAS float*)lds;
    load_wab(p, 0, wab);
    __syncthreads();
    LAS float* scr = (LAS float*)(lds + 32768 + wave * 12288);
    const int gw = BIDX() * NWAVES + wave, NGW = gridDim.x * NWAVES;
    bf16* win_t = (bf16*)(p.ws + WS_WIN); bf16* wout_t = (bf16*)(p.ws + WS_WOUT);
    constexpr int I_IN = (DM / 64) * (PC / 32), I_OUT = (DM / 64) * (DM / 32);
    for (int it = gw; it < DEPTH * (I_IN + I_OUT); it += NGW) {
        int r = it; const int l = r / (I_IN + I_OUT); r -= l * (I_IN + I_OUT);
        if (r < I_IN) { const int kb = r / (PC / 32), nb = r % (PC / 32), n0 = 32 * nb;
            transpose_item(p.w_in + (size_t)l * DM * INC, INC, DM, p.pre_g + l * DM, win_t + (size_t)l * PC * DM, n0 + (n0 >= 768 ? 8 : 0), n0, 64 * kb, scr, lane); }
        else { r -= I_IN; const int kb = r / (DM / 32), nb = r % (DM / 32);
            transpose_item(p.w_out + (size_t)l * DM * DM, DM, DM, nullptr, wout_t + (size_t)l * DM * DM, 32 * nb, 32 * nb, 64 * kb, scr, lane); }
    }
    bf16* xb = (bf16*)(p.ws + WS_XB); float* rstd = (float*)(p.ws + WS_RSTD); float* ab = (float*)(p.ws + WS_AB);
    for (int row = gw; row < NTOK; row += NGW) {
        const float4* xr = (const float4*)(p.x + (size_t)row * DM) + lane;
        float4 v[4];
#pragma unroll
        for (int j = 0; j < 4; ++j) v[j] = xr[64 * j];
        row_prep(v, row, lane, xb, rstd, ab, wab);
    }
}

__device__ __forceinline__ void phase_post(const Params& p, int l, LAS unsigned char* lds) {
    const int lane = TIDX() & 63, wave = TIDX() >> 6;
    LAS float* wab = (LAS float*)lds;
    const bool more = (l + 1 < DEPTH);
    if (more) load_wab(p, l + 1, wab);
    __syncthreads();
    const int gw = BIDX() * NWAVES + wave, NGW = gridDim.x * NWAVES;
    const float* xin = (l == 0) ? p.x : p.out;
    const float* g = p.post_g + l * DM;
    bf16* xb = (bf16*)(p.ws + WS_XB); float* rstd = (float*)(p.ws + WS_RSTD); float* ab = (float*)(p.ws + WS_AB);
    for (int row = gw; row < NTOK; row += NGW) {
        const v2u* yr = (const v2u*)((const bf16*)(p.ws + WS_PROJ) + (size_t)row * DM) + lane;
        const float4* xr = (const float4*)(xin + (size_t)row * DM) + lane;
        float4 v[4], xx[4]; float ss = 0.f;
#pragma unroll
        for (int j = 0; j < 4; ++j) { const v2u w = yr[64 * j]; xx[j] = xr[64 * j];
            v[j] = make_float4(__uint_as_float(w.x << 16), __uint_as_float(w.x & 0xffff0000u), __uint_as_float(w.y << 16), __uint_as_float(w.y & 0xffff0000u));
            ss += v[j].x * v[j].x + v[j].y * v[j].y + v[j].z * v[j].z + v[j].w * v[j].w; }
        ss = wave_sum(ss);
        const float rs = rsqrtf(ss * (1.0f / DM) + EPS);
        float4* orow = (float4*)(p.out + (size_t)row * DM) + lane;
#pragma unroll
        for (int j = 0; j < 4; ++j) { const float4 gg = ((const float4*)g)[lane + 64 * j];
            v[j] = make_float4(xx[j].x + v[j].x * rs * gg.x, xx[j].y + v[j].y * rs * gg.y, xx[j].z + v[j].z * rs * gg.z, xx[j].w + v[j].w * rs * gg.w);
            orow[64 * j] = v[j]; }
        if (more) row_prep(v, row, lane, xb, rstd, ab, wab);
    }
}

#define XB_TMO      128
#define XB_XCNT(j)  (256  + 64 * (j))
#define XB_XSUB(j)  (1280 + 64 * (j))
#define XB_XGEN(j)  (2304 + 64 * (j))
#define XB_TOP      3328
#define XB_TOPGEN   3392
#define XCD_BAR_WORDS 3456
#define XB_SPIN_CAP (1u << 18)

__device__ __forceinline__ unsigned xb_ld(unsigned* p)              { return __hip_atomic_load(p, __ATOMIC_RELAXED, __HIP_MEMORY_SCOPE_AGENT); }
__device__ __forceinline__ unsigned xb_add(unsigned* p, unsigned v) { return __hip_atomic_fetch_add(p, v, __ATOMIC_RELAXED, __HIP_MEMORY_SCOPE_AGENT); }
__device__ __forceinline__ unsigned xb_xcc_id() { return (unsigned)__builtin_amdgcn_s_getreg((3 << 11) | 20) & 0xFu; }
#define XB_SPIN(cond, bar) do { unsigned _sp = 0; while (cond) { __builtin_amdgcn_s_sleep(1); \
    if ((++_sp & 255u) == 0u) { if (xb_ld(&(bar)[XB_TMO])) break; if (_sp > XB_SPIN_CAP) { atomicAdd(&(bar)[XB_TMO], 1u); break; } } } } while (0)

struct XcdBarrier {
    unsigned* bar; unsigned x;
    volatile LAS unsigned* st;
};

__device__ __forceinline__ XcdBarrier xcd_barrier_post(unsigned* bar, volatile LAS unsigned* st) {
    XcdBarrier b; b.bar = bar; b.x = xb_xcc_id(); b.st = st;
    if (TIDX() == 0) (void)xb_add(&bar[XB_XCNT(b.x)], 1u);
    return b;
}
__device__ __forceinline__ void xcd_barrier_complete(unsigned* bar, unsigned x, unsigned& nloc, unsigned& nx) {
    const unsigned G = gridDim.x * gridDim.y * gridDim.z;
    unsigned sum, cnt, mine, sp = 0u;
    for (;;) {
        sum = 0u; cnt = 0u; mine = 0u;
#pragma unroll
        for (unsigned j = 0; j < 16; ++j) { const unsigned c = xb_ld(&bar[XB_XCNT(j)]); sum += c; cnt += (c > 0u) ? 1u : 0u; mine = (j == x) ? c : mine; }
        if (sum == G) break;
        __builtin_amdgcn_s_sleep(1);
        if ((++sp & 255u) == 0u) { if (xb_ld(&bar[XB_TMO])) break; if (sp > XB_SPIN_CAP) { atomicAdd(&bar[XB_TMO], 1u); break; } }
    }
    nloc = mine > 0u ? mine : 1u; nx = cnt > 0u ? cnt : 1u;
}

__device__ __forceinline__ void xcd_barrier(const XcdBarrier& b) {
    asm volatile("s_waitcnt vmcnt(0)" ::: "memory");
    __syncthreads();
    if (TIDX() == 0) {
        unsigned* bar = b.bar;
        __builtin_amdgcn_s_waitcnt(0);
        unsigned nloc = b.st[0], nx = b.st[1];
        if (nloc == 0u) { xcd_barrier_complete(bar, b.x, nloc, nx); b.st[0] = nloc; b.st[1] = nx; }
        const unsigned old = xb_add(&bar[XB_XSUB(b.x)], 1u);
        const unsigned gen = old / nloc;
        if (old + 1u == (gen + 1u) * nloc) {
            __builtin_amdgcn_fence(__ATOMIC_RELEASE, "agent");
            asm volatile("s_waitcnt vmcnt(0)" ::: "memory");
            const unsigned og = xb_add(&bar[XB_TOP], 1u);
            const unsigned tg = og / nx;
            if (og + 1u == (tg + 1u) * nx) xb_add(&bar[XB_TOPGEN], 1u);
            else XB_SPIN(xb_ld(&bar[XB_TOPGEN]) == tg, bar);
            __builtin_amdgcn_fence(__ATOMIC_ACQUIRE, "agent");
            xb_add(&bar[XB_XGEN(b.x)], 1u);
            asm volatile("s_waitcnt vmcnt(0)" ::: "memory");
        } else {
            XB_SPIN(xb_ld(&bar[XB_XGEN(b.x)]) == gen, bar);
            __builtin_amdgcn_fence(__ATOMIC_ACQUIRE, "agent");
            asm volatile("s_waitcnt vmcnt(0)" ::: "memory");
        }
    }
    __syncthreads();
}

namespace att {
typedef short bf16x8 __attribute__((ext_vector_type(8)));
typedef short s16x4 __attribute__((ext_vector_type(4)));
typedef float f32x16 __attribute__((ext_vector_type(16)));
constexpr int KCH = 1024, VOFF = 8192, BUFB = 16384, NSLOT = 4;
constexpr float NEG = -1e30f, LOG2E = 1.4426950408889634f;
__device__ __forceinline__ void glds16(const void* gsrc, unsigned lds_dst) { unsigned keep;
    asm volatile("s_mov_b32 %0, m0\n\ts_mov_b32 m0, %2\n\ts_nop 0\n\tglobal_load_lds_dwordx4 %1, off\n\ts_mov_b32 m0, %0" : "=&s"(keep) : "v"(gsrc), "s"(lds_dst) : "memory"); }
__device__ __forceinline__ unsigned cvtpk(float lo, float hi) { typedef float f2 __attribute__((ext_vector_type(2))); typedef __bf16 b2 __attribute__((ext_vector_type(2))); f2 v = {lo, hi}; b2 b = __builtin_convertvector(v, b2); return __builtin_bit_cast(unsigned, b); }
__device__ __forceinline__ s16x4 vtr(const LAS unsigned char* p) { return __builtin_bit_cast(s16x4, __builtin_amdgcn_ds_read_tr16_b64_v4i16((LAS s16x4*)p)); }
__device__ __forceinline__ unsigned scale_pk(unsigned w, float c) { return cvtpk(__uint_as_float(w << 16) * c, __uint_as_float(w & 0xffff0000u) * c); }
__device__ __forceinline__ float max16(const f32x16& a) {
    float m0 = fmaxf(fmaxf(a[0], a[1]), fmaxf(a[2], a[3])), m1 = fmaxf(fmaxf(a[4], a[5]), fmaxf(a[6], a[7]));
    float m2 = fmaxf(fmaxf(a[8], a[9]), fmaxf(a[10], a[11])), m3 = fmaxf(fmaxf(a[12], a[13]), fmaxf(a[14], a[15]));
    return fmaxf(fmaxf(m0, m1), fmaxf(m2, m3));
}

template <int MODE>
__device__ __forceinline__ void attn_unit(const Params& p, int l, int b, int h, int qb, LAS unsigned char* lds) {
    constexpr int NMAP = MODE == 0 ? 2 : 1, NKS = MODE == 0 ? 2 : 4;
    const int tid = TIDX(), lane = tid & 63, wid = __builtin_amdgcn_readfirstlane(tid >> 6), r32 = lane & 31, hi = lane >> 5;
    const bf16* P = (const bf16*)(p.ws + WS_PROJ) + (size_t)b * SEQ * PC;
    const int QC = (MODE == 0 ? C_DQ : C_MQ) + h * 64, KC = (MODE == 0 ? C_DK : C_MK) + h * 64, VC = (MODE == 0 ? C_DV : C_MV) + h * 64, ZC = (MODE == 0 ? C_DZ : C_MZ) + h * 64;
    const float slope = exp2f(-(float)(MODE == 0 ? 2 * h + 1 : 2 * h + 2));
    const float sl2 = slope * LOG2E;
    const float c1 = (MODE == 0 ? 0.17677669529663687f : 0.125f) * LOG2E;
    const int q0 = qb * 256 + wid * 32, qpos = q0 + r32;
    bf16x8 qf[NMAP][NKS];
#pragma unroll
    for (int mp = 0; mp < NMAP; ++mp)
#pragma unroll
        for (int ks = 0; ks < NKS; ++ks) { const v4u raw = *(const v4u*)(P + (size_t)qpos * PC + QC + mp * 32 + ks * 16 + hi * 8);
            v4u s; s.x = scale_pk(raw.x, c1); s.y = scale_pk(raw.y, c1); s.z = scale_pk(raw.z, c1); s.w = scale_pk(raw.w, c1); qf[mp][ks] = __builtin_bit_cast(bf16x8, s); }
    unsigned sel = 0;
    if (MODE == 1) {
        const float* km = (const float*)(p.ws + WS_KMEAN) + (size_t)((b * NH + h) * 8) * 256;
        LAS float* kml = (LAS float*)(lds + NSLOT * BUFB + 64);
        __syncthreads();
        if (tid < qb * 64) { const int jj = tid >> 6, dd = tid & 63; kml[tid] = (km[jj * 256 + dd] + km[jj * 256 + 64 + dd]) + (km[jj * 256 + 128 + dd] + km[jj * 256 + 192 + dd]); }
        __syncthreads();
        float g[7];
#pragma unroll
        for (int j = 0; j < 7; ++j) { g[j] = -INFINITY;
            if (j < qb) { float s = 0.f;
#pragma unroll
                for (int ks = 0; ks < NKS; ++ks) { const v4u qq = __builtin_bit_cast(v4u, qf[0][ks]); const f4 k0 = *(const LAS f4*)(kml + j * 64 + ks * 16 + hi * 8), k1 = *(const LAS f4*)(kml + j * 64 + ks * 16 + hi * 8 + 4);
                    s += __uint_as_float(qq.x << 16) * k0.x + __uint_as_float(qq.x & 0xffff0000u) * k0.y + __uint_as_float(qq.y << 16) * k0.z + __uint_as_float(qq.y & 0xffff0000u) * k0.w
                       + __uint_as_float(qq.z << 16) * k1.x + __uint_as_float(qq.z & 0xffff0000u) * k1.y + __uint_as_float(qq.w << 16) * k1.z + __uint_as_float(qq.w & 0xffff0000u) * k1.w; }
                g[j] = s + __shfl_xor(s, 32); } }
#pragma unroll
        for (int r = 0; r < 3; ++r) { float best = -INFINITY; int bi = -1;
#pragma unroll
            for (int j = 0; j < 7; ++j) if (j < qb && !((sel >> j) & 1u) && g[j] > best) { best = g[j]; bi = j; }
            if (bi >= 0) sel |= 1u << bi; }
    }
    f32x16 cr;
#pragma unroll
    for (int r = 0; r < 16; ++r) cr[r] = sl2 * (float)((r & 3) + 8 * (r >> 2) + 4 * hi);
    const bf16* ksrc = P + (size_t)lane * PC + KC + wid * 8;
    const bf16* vsrc = P + (size_t)(16 * (wid & 3) + (lane >> 2)) * PC + VC + (wid >> 2) * 32 + (lane & 3) * 8;
    const int kdst = wid * 1024, vdst = VOFF + wid * 1024;
    const unsigned lds0 = (unsigned)(uintptr_t)lds;
#define ATT_DMA(T_) do { const unsigned sl_ = lds0 + (unsigned)(((T_) & (NSLOT - 1)) * BUFB); \
        glds16(ksrc + (size_t)(T_) * 64 * PC, (unsigned)__builtin_amdgcn_readfirstlane(sl_ + kdst)); \
        glds16(vsrc + (size_t)(T_) * 64 * PC, (unsigned)__builtin_amdgcn_readfirstlane(sl_ + vdst)); } while (0)
    const int koff = hi * KCH + r32 * 16;
    const int voff = VOFF + ((lane >> 4) & 1) * 32 + (lane & 3) * 8 + (4 * hi + ((lane & 15) >> 2)) * 64;
    f32x16 O[NMAP][2];
    float m[NMAP], lsum[NMAP];
#pragma unroll
    for (int mp = 0; mp < NMAP; ++mp) { m[mp] = NEG; lsum[mp] = 0.f;
#pragma unroll
        for (int d = 0; d < 2; ++d)
#pragma unroll
            for (int r = 0; r < 16; ++r) O[mp][d][r] = 0.f; }
    const int Tlast = 4 * qb + 3;
    __syncthreads();
    ATT_DMA(Tlast); ATT_DMA(Tlast - 1); ATT_DMA(Tlast - 2);
    for (int T = Tlast; T >= 0; --T) {
        if (T >= 2) asm volatile("s_waitcnt vmcnt(4)" ::: "memory"); else if (T == 1) asm volatile("s_waitcnt vmcnt(2)" ::: "memory"); else asm volatile("s_waitcnt vmcnt(0)" ::: "memory");
        __builtin_amdgcn_s_barrier();
        asm volatile("" ::: "memory");
        if (T >= 3) ATT_DMA(T - 3);
        const LAS unsigned char* kb = lds + (T & (NSLOT - 1)) * BUFB;
        bool selq = true; bool work = (64 * T <= q0 + 31);
        if (MODE == 1) { const int j = T >> 2; if (j < qb) { selq = (sel >> j) & 1u; work = work && __any(selq); } }
        if (work) {
            const bool diag = (64 * T + 63 > q0);
            const float tb0 = sl2 * (float)(64 * T - qb * 256), tb1 = tb0 + 32.f * sl2;
            unsigned pk[NMAP][2][2][4];
#pragma unroll
            for (int mp = 0; mp < NMAP; ++mp) {
                f32x16 u0 = cr, u1 = cr;
#pragma unroll
                for (int ks = 0; ks < NKS; ++ks) { const int cb = ((MODE == 0 ? 4 * mp : 0) + 2 * ks) * KCH;
                    const bf16x8 k0 = *(const LAS bf16x8*)(kb + koff + cb), k1 = *(const LAS bf16x8*)(kb + koff + cb + 512);
                    u0 = __builtin_amdgcn_mfma_f32_32x32x16_bf16(k0, qf[mp][ks], u0, 0, 0, 0);
                    u1 = __builtin_amdgcn_mfma_f32_32x32x16_bf16(k1, qf[mp][ks], u1, 0, 0, 0); }
                if (diag) { const int thr = qpos - 64 * T - 4 * hi;
#pragma unroll
                    for (int r = 0; r < 16; ++r) { const int c = (r & 3) + 8 * (r >> 2); if (c > thr) u0[r] = NEG; if (c + 32 > thr) u1[r] = NEG; } }
                float mu = fmaxf(max16(u0) + tb0, max16(u1) + tb1);
                if (MODE == 1) { if (!selq) mu = NEG; }
                mu = fmaxf(mu, __shfl_xor(mu, 32));
                const float mn = fmaxf(m[mp], mu);
                if (!__all(mn == m[mp])) { const float al = __builtin_amdgcn_exp2f(m[mp] - mn); lsum[mp] *= al;
#pragma unroll
                    for (int d = 0; d < 2; ++d)
#pragma unroll
                        for (int r = 0; r < 16; ++r) O[mp][d][r] *= al;
                    m[mp] = mn; }
                float ms0 = mn - tb0, ms1 = mn - tb1;
                if (MODE == 1) { if (!selq) { ms0 = 1e30f; ms1 = 1e30f; } }
                float ls = 0.f;
#pragma unroll
                for (int r = 0; r < 16; ++r) { u0[r] = __builtin_amdgcn_exp2f(u0[r] - ms0); u1[r] = __builtin_amdgcn_exp2f(u1[r] - ms1); ls += u0[r] + u1[r]; }
                lsum[mp] += ls;
#pragma unroll
                for (int s = 0; s < 2; ++s)
#pragma unroll
                    for (int i = 0; i < 4; ++i) { pk[mp][0][s][i] = cvtpk(u0[8 * s + 2 * i], u0[8 * s + 2 * i + 1]); pk[mp][1][s][i] = cvtpk(u1[8 * s + 2 * i], u1[8 * s + 2 * i + 1]); }
            }
#pragma unroll
            for (int d = 0; d < 2; ++d)
#pragma unroll
                for (int kh = 0; kh < 2; ++kh)
#pragma unroll
                    for (int s = 0; s < 2; ++s) {
                        const s16x4 lo = vtr(kb + voff + d * 4096 + kh * 2048 + s * 1024), hh = vtr(kb + voff + d * 4096 + kh * 2048 + s * 1024 + 512);
                        const bf16x8 vf = (bf16x8){lo[0], lo[1], lo[2], lo[3], hh[0], hh[1], hh[2], hh[3]};
#pragma unroll
                        for (int mp = 0; mp < NMAP; ++mp) { const v4u pw = {pk[mp][kh][s][0], pk[mp][kh][s][1], pk[mp][kh][s][2], pk[mp][kh][s][3]};
                            O[mp][d] = __builtin_amdgcn_mfma_f32_32x32x16_bf16(vf, __builtin_bit_cast(bf16x8, pw), O[mp][d], 0, 0, 0); }
                    }
        }
        asm volatile("s_waitcnt lgkmcnt(0)" ::: "memory");
    }
#undef ATT_DMA
    bf16* yrow = (bf16*)(p.ws + WS_Y) + ((size_t)b * SEQ + qpos) * DM + (MODE == 0 ? 768 : 512) + h * 64;
    const bf16* zrow = P + (size_t)qpos * PC + ZC;
    if (MODE == 0) {
        float pr = 0.f;
        if (lane < 32) pr = p.lq1[l * 32 + lane] * p.lk1[l * 32 + lane]; else pr = -(p.lq2[l * 32 + lane - 32] * p.lk2[l * 32 + lane - 32]);
        float d1 = pr;
#pragma unroll
        for (int o = 16; o > 0; o >>= 1) d1 += __shfl_xor(d1, o);
        const float e_mine = expf(lane < 32 ? d1 : -d1), e_other = __shfl_xor(e_mine, 32);
        const float lam_init = 0.8f - 0.6f * expf(-0.3f * (float)l);
        const float lam = (lane < 32 ? e_mine - e_other : e_other - e_mine) + lam_init;
        const float l0 = lsum[0] + __shfl_xor(lsum[0], 32), l1 = lsum[NMAP - 1] + __shfl_xor(lsum[NMAP - 1], 32);
        const float i0 = 1.0f / l0, i1 = lam / l1;
        float ss = 0.f;
#pragma unroll
        for (int d = 0; d < 2; ++d)
#pragma unroll
            for (int r = 0; r < 16; ++r) { const float o = O[0][d][r] * i0 - O[NMAP - 1][d][r] * i1; O[0][d][r] = o; ss += o * o; }
        ss += __shfl_xor(ss, 32);
        const float rs = rsqrtf(ss * (1.0f / 64.0f) + EPS) * (1.0f - lam_init);
        const float* ng = p.diff_g + l * HD;
#pragma unroll
        for (int d = 0; d < 2; ++d)
#pragma unroll
            for (int g4 = 0; g4 < 4; ++g4) { const int dd = d * 32 + 8 * g4 + 4 * hi;
                const float4 gn = *(const float4*)(ng + dd); const v2u z = *(const v2u*)(zrow + dd);
                const float z0 = __uint_as_float(z.x << 16), z1 = __uint_as_float(z.x & 0xffff0000u), z2 = __uint_as_float(z.y << 16), z3 = __uint_as_float(z.y & 0xffff0000u);
                v2u w; w.x = pk2(O[0][d][4 * g4] * rs * gn.x * siluf_(z0), O[0][d][4 * g4 + 1] * rs * gn.y * siluf_(z1));
                w.y = pk2(O[0][d][4 * g4 + 2] * rs * gn.z * siluf_(z2), O[0][d][4 * g4 + 3] * rs * gn.w * siluf_(z3));
                *(v2u*)(yrow + dd) = w; }
    } else {
        const float l0 = lsum[0] + __shfl_xor(lsum[0], 32);
        const float i0 = 1.0f / l0;
#pragma unroll
        for (int d = 0; d < 2; ++d)
#pragma unroll
            for (int g4 = 0; g4 < 4; ++g4) { const int dd = d * 32 + 8 * g4 + 4 * hi;
                const v2u z = *(const v2u*)(zrow + dd);
                const float z0 = __uint_as_float(z.x << 16), z1 = __uint_as_float(z.x & 0xffff0000u), z2 = __uint_as_float(z.y << 16), z3 = __uint_as_float(z.y & 0xffff0000u);
                v2u w; w.x = pk2(O[0][d][4 * g4] * i0 * siluf_(z0), O[0][d][4 * g4 + 1] * i0 * siluf_(z1));
                w.y = pk2(O[0][d][4 * g4 + 2] * i0 * siluf_(z2), O[0][d][4 * g4 + 3] * i0 * siluf_(z3));
                *(v2u*)(yrow + dd) = w; }
    }
}
}

__device__ __forceinline__ void phase_attn_mfma(const Params& p, int l, LAS unsigned char* lds) {
    for (int c = BIDX(); c < NB * NH * 4; c += gridDim.x) {
        const int bh = c >> 2, s = c & 3, b = bh >> 2, h = bh & 3;
        att::attn_unit<0>(p, l, b, h, 7 - s, lds);
        att::attn_unit<1>(p, l, b, h, 7 - s, lds);
        att::attn_unit<0>(p, l, b, h, s, lds);
        att::attn_unit<1>(p, l, b, h, s, lds);
    }
}

namespace scn {
typedef short bf16x8 __attribute__((ext_vector_type(8)));
typedef float f32x4 __attribute__((ext_vector_type(4)));
constexpr size_t CH_QT = 64 * 64 * 2, CH_OI = 64 * 64 * 2, CH_SL = 64 * 64 * 4, CH_M = 64 * 64 * 2, CH_DL = 64 * 4;
constexpr int NCH = NB * NH * 32;
constexpr size_t A_GST = 0, A_HST = 16 * MiB, A_GQT = 32 * MiB, A_HQT = 48 * MiB;
constexpr size_t B_GSL = 0, B_HSL = 32 * MiB, B_GMF = 64 * MiB, B_HDL = 96 * MiB;

__device__ __forceinline__ f32x4 mfma16(bf16x8 a, bf16x8 b, f32x4 c) { f32x4 r = __builtin_amdgcn_mfma_f32_16x16x32_bf16(a, b, c, 0, 0, 0); asm volatile("" : "+v"(r) : "v"(a), "v"(b)); return r; }
__device__ __forceinline__ float f_hi(float x) { return __uint_as_float(f2bf(x) << 16); }

template <int PART>
__device__ __forceinline__ void gdn_pre(const Params& p, int l, int item, LAS float* wl) {
    const int lane = TIDX() & 63, half = lane >> 5, j = lane & 31;
    const int ci = item >> 1, cb = (item & 1) * 32;
    const int b = ci >> 7, h = (ci >> 5) & 3, n = ci & 31, t0 = n * 64;
    const bf16* P = (const bf16*)(p.ws + WS_PROJ) + (size_t)b * SEQ * PC;
    const float* AB = (const float*)(p.ws + WS_AB) + (size_t)b * SEQ * 8;
    const float* cw = p.conv_w + (size_t)l * 4 * 768;
    const int cq_ = C_GQ + h * 64 + lane, ck_ = C_GK + h * 64 + lane, cv_ = C_GV + h * 64 + cb + j;
    float wq[4], wk[4], wv[4];
#pragma unroll
    for (int i = 0; i < 4; ++i) { wq[i] = cw[i * 768 + 0 + h * 64 + lane]; wk[i] = cw[i * 768 + 256 + h * 64 + lane]; wv[i] = cw[i * 768 + 512 + h * 64 + cb + j]; }
    const float Aexp = expf(p.a_log[l * NH + h]), dtb = p.dt_bias[l * NH + h];
    float xq[3] = {0.f, 0.f, 0.f}, xk[3] = {0.f, 0.f, 0.f}, xv[3] = {0.f, 0.f, 0.f};
    if (t0 > 0) {
#pragma unroll
        for (int i = 0; i < 3; ++i) { const bf16* pr = P + (size_t)(t0 - 3 + i) * PC; xq[i] = bf2f(pr[cq_]); xk[i] = bf2f(pr[ck_]); if (PART == 0) xv[i] = bf2f(pr[cv_]); }
    }
    float S[32];
#pragma unroll
    for (int i = 0; i < 32; ++i) S[i] = (PART == 1 && (32 * half + i) == (cb + j)) ? 1.f : 0.f;
    bf16* OI = (bf16*)(p.ws + WS_Y) + ((size_t)b * SEQ + t0) * DM + 0 + h * 64;
    bf16* QT = (bf16*)(p.ws + WS_XB + A_GQT + (size_t)ci * CH_QT);
    const LAS float* wk_ = wl + 32 * half; const LAS float* wq_ = wl + 64 + 32 * half;
    float nq, nk, nv = 0.f, na, nb;
    { const bf16* pr = P + (size_t)t0 * PC; nq = bf2f(pr[cq_]); nk = bf2f(pr[ck_]); if (PART == 0) nv = bf2f(pr[cv_]); na = AB[t0 * 8 + h]; nb = AB[t0 * 8 + 4 + h]; }
#pragma unroll 1
    for (int t = 0; t < 64; ++t) {
        const float cq = nq, ck = nk, cv = nv, ca = na, cb2 = nb;
        if (t + 1 < 64) { const bf16* pr = P + (size_t)(t0 + t + 1) * PC; nq = bf2f(pr[cq_]); nk = bf2f(pr[ck_]); if (PART == 0) nv = bf2f(pr[cv_]); na = AB[(t0 + t + 1) * 8 + h]; nb = AB[(t0 + t + 1) * 8 + 4 + h]; }
        float qc = wq[0] * xq[0] + wq[1] * xq[1] + wq[2] * xq[2] + wq[3] * cq;
        float kc = wk[0] * xk[0] + wk[1] * xk[1] + wk[2] * xk[2] + wk[3] * ck;
        xq[0] = xq[1]; xq[1] = xq[2]; xq[2] = cq; xk[0] = xk[1]; xk[1] = xk[2]; xk[2] = ck;
        float vc = 0.f;
        if (PART == 0) { vc = wv[0] * xv[0] + wv[1] * xv[1] + wv[2] * xv[2] + wv[3] * cv; xv[0] = xv[1]; xv[1] = xv[2]; xv[2] = cv; vc = fsilu(vc); }
        qc = fsilu(qc); kc = fsilu(kc);
        const float qss = fwave_sum(qc * qc), kss = fwave_sum(kc * kc);
        const float qn = qc * __builtin_amdgcn_rsqf(qss + EPS) * 0.125f, kn = kc * __builtin_amdgcn_rsqf(kss + EPS);
        const float g = -Aexp * fsoftplus(ca + dtb), beta = fsigmoid(cb2), eg = fexp(g);
        asm volatile("s_waitcnt lgkmcnt(0)" ::: "memory");
        wl[lane] = kn; wl[64 + lane] = qn;
        asm volatile("s_waitcnt lgkmcnt(0)" ::: "memory");
        float ks0 = 0.f, ks1 = 0.f, ks2 = 0.f, ks3 = 0.f;
#pragma unroll
        for (int i = 0; i < 32; i += 4) { const f4 k4 = *(const LAS f4*)(wk_ + i);
            S[i] *= eg; S[i + 1] *= eg; S[i + 2] *= eg; S[i + 3] *= eg;
            ks0 += k4.x * S[i]; ks1 += k4.y * S[i + 1]; ks2 += k4.z * S[i + 2]; ks3 += k4.w * S[i + 3]; }
        const float kS = xor32_sum((ks0 + ks1) + (ks2 + ks3));
        const float vn = beta * (vc - kS);
        float o0 = 0.f, o1 = 0.f, o2 = 0.f, o3 = 0.f;
#pragma unroll
        for (int i = 0; i < 32; i += 4) { const f4 k4 = *(const LAS f4*)(wk_ + i); const f4 q4 = *(const LAS f4*)(wq_ + i);
            S[i] += k4.x * vn; S[i + 1] += k4.y * vn; S[i + 2] += k4.z * vn; S[i + 3] += k4.w * vn;
            o0 += q4.x * S[i]; o1 += q4.y * S[i + 1]; o2 += q4.z * S[i + 2]; o3 += q4.w * S[i + 3]; }
        const float o = xor32_sum((o0 + o1) + (o2 + o3));
        if (half == 0) { if (PART == 1) QT[t * 64 + cb + j] = (bf16)f2bf(o); else OI[(size_t)t * DM + cb + j] = (bf16)f2bf(o); }
    }
    if (PART == 0) {
        float* SL = (float*)(p.ws + WS_SCR + B_GSL + (size_t)ci * CH_SL) + (cb + j) * 64 + 32 * half;
#pragma unroll
        for (int i = 0; i < 32; i += 4) *(float4*)(SL + i) = make_float4(S[i], S[i + 1], S[i + 2], S[i + 3]);
    } else {
        float* MF = (float*)(p.ws + WS_SCR + B_GMF + (size_t)ci * CH_SL) + (32 * half) * 64 + cb + j;
#pragma unroll
        for (int i = 0; i < 32; ++i) { MF[i * 64] = S[i]; if ((i & 7) == 7) asm volatile("" ::: "memory"); }
    }
}

__device__ __forceinline__ void hgrn_pre(const Params& p, int l, int ci, LAS float* wl) {
    const int lane = TIDX() & 63;
    const int b = ci >> 7, h = (ci >> 5) & 3, n = ci & 31, t0 = n * 64;
    const bf16* P = (const bf16*)(p.ws + WS_PROJ) + (size_t)b * SEQ * PC;
    float lb = 0.f;
    if (l == 1) { const float a0 = p.hgrn_lb[h * 64 + lane], a1 = p.hgrn_lb[GW + h * 64 + lane]; lb = 1.0f / (1.0f + expf(a0 - a1)); }
    float S[64];
#pragma unroll
    for (int d = 0; d < 64; ++d) S[d] = 0.f;
    float gam = 1.f;
    bf16* OI = (bf16*)(p.ws + WS_Y) + ((size_t)b * SEQ + t0) * DM + 256 + h * 64;
    bf16* QT = (bf16*)(p.ws + WS_XB + A_HQT + (size_t)ci * CH_QT);
    float nq, nf, nv;
    { const bf16* pr = P + (size_t)t0 * PC; nq = bf2f(pr[C_HQ + h * 64 + lane]); nf = bf2f(pr[C_HF + h * 64 + lane]); nv = bf2f(pr[C_HI + h * 64 + lane]); }
#pragma unroll 1
    for (int t = 0; t < 64; ++t) {
        const float cq = nq, cf = nf, vi = nv;
        if (t + 1 < 64) { const bf16* pr = P + (size_t)(t0 + t + 1) * PC; nq = bf2f(pr[C_HQ + h * 64 + lane]); nf = bf2f(pr[C_HF + h * 64 + lane]); nv = bf2f(pr[C_HI + h * 64 + lane]); }
        const float sg = fsigmoid(cf);
        const float fg = lb + (1.0f - lb) * sg;
        const float kk = (1.0f - lb) * (1.0f - sg);
        const float qq = fsilu(cq);
        gam *= fg;
        QT[t * 64 + lane] = (bf16)f2bf(qq * gam);
        asm volatile("s_waitcnt lgkmcnt(0)" ::: "memory");
        wl[lane] = fg; wl[64 + lane] = kk; wl[128 + lane] = qq;
        asm volatile("s_waitcnt lgkmcnt(0)" ::: "memory");
        float o0 = 0.f, o1 = 0.f, o2 = 0.f, o3 = 0.f;
#pragma unroll
        for (int d = 0; d < 64; d += 4) { const f4 f4_ = *(const LAS f4*)(wl + d); const f4 k4 = *(const LAS f4*)(wl + 64 + d); const f4 q4 = *(const LAS f4*)(wl + 128 + d);
            S[d] = f4_.x * S[d] + k4.x * vi; S[d + 1] = f4_.y * S[d + 1] + k4.y * vi; S[d + 2] = f4_.z * S[d + 2] + k4.z * vi; S[d + 3] = f4_.w * S[d + 3] + k4.w * vi;
            o0 += q4.x * S[d]; o1 += q4.y * S[d + 1]; o2 += q4.z * S[d + 2]; o3 += q4.w * S[d + 3]; }
        const float o = (o0 + o1) + (o2 + o3);
        OI[(size_t)t * DM + lane] = (bf16)f2bf(o);
    }
    float* SL = (float*)(p.ws + WS_SCR + B_HSL + (size_t)ci * CH_SL) + lane * 64;
#pragma unroll
    for (int d = 0; d < 64; d += 4) *(float4*)(SL + d) = make_float4(S[d], S[d + 1], S[d + 2], S[d + 3]);
    ((float*)(p.ws + WS_SCR + B_HDL + (size_t)ci * CH_DL))[lane] = gam;
}

__device__ __forceinline__ void kmean_item(const Params& p, int it) {
    const int lane = TIDX() & 63;
    const bf16* proj = (const bf16*)(p.ws + WS_PROJ); float* kmean = (float*)(p.ws + WS_KMEAN);
    const int sub = it & 3, j = (it >> 2) & 7, h = (it >> 5) & 3, b = it >> 7;
    const bf16* base = proj + ((size_t)b * SEQ + j * 256 + sub * 64) * PC + C_MK + h * 64 + lane;
    float acc[4] = {0.f, 0.f, 0.f, 0.f};
#pragma unroll
    for (int r0 = 0; r0 < 64; r0 += 16) { bf16 v[16];
#pragma unroll
        for (int i = 0; i < 16; ++i) v[i] = base[(size_t)(r0 + i) * PC];
#pragma unroll
        for (int i = 0; i < 16; ++i) acc[i & 3] += bf2f(v[i]); }
    kmean[(size_t)it * 64 + lane] = ((acc[0] + acc[1]) + (acc[2] + acc[3])) * (1.0f / 256.0f);
}

__device__ __forceinline__ void phase_pre(const Params& p, int l, LAS unsigned char* lds) {
    const int wave = TIDX() >> 6;
    LAS float* wl = (LAS float*)(lds + wave * 1024);
    const int gw = BIDX() * NWAVES + wave, NGW = gridDim.x * NWAVES;
    constexpr int N_G = 2 * NCH, N_H = NCH, N_K = NB * NH * 8;
    for (int it = gw; it < 2 * NCH; it += NGW) gdn_pre<1>(p, l, it, wl);
    for (int it = gw; it < 2 * NCH; it += NGW) gdn_pre<0>(p, l, it, wl);
    for (int it = gw; it < NCH; it += NGW) hgrn_pre(p, l, it, wl);
    for (int it = gw; it < N_K; it += NGW) kmean_item(p, it);
}

template <int KIND>
__device__ __forceinline__ void scan_unit(const Params& p, int l, int sp) {
    const int tid = TIDX(), lane = tid & 63, wid = __builtin_amdgcn_readfirstlane(tid >> 6), seq = wid >> 2, sl = wid & 3, c15 = lane & 15, g = lane >> 4;
    const int bh = sp * 2 + seq, dv = 16 * sl + c15;
    f32x4 S[4];
#pragma unroll
    for (int rb = 0; rb < 4; ++rb) S[rb] = (f32x4){0.f, 0.f, 0.f, 0.f};
    const unsigned char* SLb = p.ws + WS_SCR + (KIND == 0 ? B_GSL : B_HSL) + (size_t)bh * 32 * CH_SL;
    const unsigned char* MFb = p.ws + WS_SCR + B_GMF + (size_t)bh * 32 * CH_SL;
    const unsigned char* DLb = p.ws + WS_SCR + B_HDL + (size_t)bh * 32 * CH_DL;
    unsigned char* STb = p.ws + WS_XB + (KIND == 0 ? A_GST : A_HST) + (size_t)bh * 32 * CH_QT;
    float4 nsl[4], nm[KIND == 0 ? 16 : 4];
#define SCN_LOAD(n_) do { const float* SL_ = (const float*)(SLb + (size_t)(n_) * CH_SL); \
        _Pragma("unroll") for (int rb = 0; rb < 4; ++rb) nsl[rb] = *(const float4*)(SL_ + dv * 64 + 16 * rb + 4 * g); \
        if (KIND == 0) { const float* MF_ = (const float*)(MFb + (size_t)(n_) * CH_SL); \
            _Pragma("unroll") for (int rb = 0; rb < 4; ++rb) _Pragma("unroll") for (int ks = 0; ks < 2; ++ks) { const int off = (16 * rb + c15) * 64 + 32 * ks + 4 * g; \
                nm[(rb * 2 + ks) * 2] = *(const float4*)(MF_ + off); nm[(rb * 2 + ks) * 2 + 1] = *(const float4*)(MF_ + off + 16); } } \
        else { const float* DL_ = (const float*)(DLb + (size_t)(n_) * CH_DL); _Pragma("unroll") for (int rb = 0; rb < 4; ++rb) nm[rb] = *(const float4*)(DL_ + 16 * rb + 4 * g); } } while (0)
    SCN_LOAD(0);
#pragma unroll 1
    for (int n = 0; n < 32; ++n) {
        float4 csl[4], cm[KIND == 0 ? 16 : 4];
#pragma unroll
        for (int i = 0; i < 4; ++i) csl[i] = nsl[i];
#pragma unroll
        for (int i = 0; i < (KIND == 0 ? 16 : 4); ++i) cm[i] = nm[i];
        if (n + 1 < 32) SCN_LOAD(n + 1);
        bf16* ST = (bf16*)(STb + (size_t)n * CH_QT) + dv * 64 + 4 * g;
#pragma unroll
        for (int rb = 0; rb < 4; ++rb) { v2u w; w.x = pk2(S[rb][0], S[rb][1]); w.y = pk2(S[rb][2], S[rb][3]); *(v2u*)(ST + 16 * rb) = w; }
        if (KIND == 0) {
            bf16x8 Bh[2], Bl[2];
#pragma unroll
            for (int ks = 0; ks < 2; ++ks) { const f32x4 a = S[2 * ks], c = S[2 * ks + 1];
                v4u w; w.x = pk2(a[0], a[1]); w.y = pk2(a[2], a[3]); w.z = pk2(c[0], c[1]); w.w = pk2(c[2], c[3]); Bh[ks] = __builtin_bit_cast(bf16x8, w);
                v4u x; x.x = pk2(a[0] - f_hi(a[0]), a[1] - f_hi(a[1])); x.y = pk2(a[2] - f_hi(a[2]), a[3] - f_hi(a[3])); x.z = pk2(c[0] - f_hi(c[0]), c[1] - f_hi(c[1])); x.w = pk2(c[2] - f_hi(c[2]), c[3] - f_hi(c[3])); Bl[ks] = __builtin_bit_cast(bf16x8, x); }
#pragma unroll
            for (int rb = 0; rb < 4; ++rb) { f32x4 acc = (f32x4){csl[rb].x, csl[rb].y, csl[rb].z, csl[rb].w};
#pragma unroll
                for (int ks = 0; ks < 2; ++ks) { const float4 m0 = cm[(rb * 2 + ks) * 2], m1 = cm[(rb * 2 + ks) * 2 + 1];
                    v4u hw, lw;
                    hw.x = pk2(m0.x, m0.y); hw.y = pk2(m0.z, m0.w); hw.z = pk2(m1.x, m1.y); hw.w = pk2(m1.z, m1.w);
                    lw.x = pk2(m0.x - f_hi(m0.x), m0.y - f_hi(m0.y)); lw.y = pk2(m0.z - f_hi(m0.z), m0.w - f_hi(m0.w)); lw.z = pk2(m1.x - f_hi(m1.x), m1.y - f_hi(m1.y)); lw.w = pk2(m1.z - f_hi(m1.z), m1.w - f_hi(m1.w));
                    acc = mfma16(__builtin_bit_cast(bf16x8, lw), Bh[ks], acc);
                    acc = mfma16(__builtin_bit_cast(bf16x8, hw), Bl[ks], acc);
                    acc = mfma16(__builtin_bit_cast(bf16x8, hw), Bh[ks], acc); }
                csl[rb] = make_float4(acc[0], acc[1], acc[2], acc[3]); }
#pragma unroll
            for (int rb = 0; rb < 4; ++rb) S[rb] = (f32x4){csl[rb].x, csl[rb].y, csl[rb].z, csl[rb].w};
        } else {
#pragma unroll
            for (int rb = 0; rb < 4; ++rb) S[rb] = (f32x4){cm[rb].x * S[rb][0] + csl[rb].x, cm[rb].y * S[rb][1] + csl[rb].y, cm[rb].z * S[rb][2] + csl[rb].z, cm[rb].w * S[rb][3] + csl[rb].w};
        }
    }
#undef SCN_LOAD
}

__device__ __forceinline__ float row16_sum(float v) {
    v += __int_as_float(__builtin_amdgcn_update_dpp(0, __float_as_int(v), 0xB1, 0xF, 0xF, true));
    v += __int_as_float(__builtin_amdgcn_update_dpp(0, __float_as_int(v), 0x4E, 0xF, 0xF, true));
    v += __int_as_float(__builtin_amdgcn_update_dpp(0, __float_as_int(v), 0x141, 0xF, 0xF, true));
    v += __int_as_float(__builtin_amdgcn_update_dpp(0, __float_as_int(v), 0x140, 0xF, 0xF, true));
    return v;
}

template <int KIND>
__device__ __forceinline__ void out_item(const Params& p, int l, int ci, bool dry) {
    const int lane = TIDX() & 63, c15 = lane & 15, g = lane >> 4;
    const int b = ci >> 7, h = (ci >> 5) & 3, n = ci & 31, t0 = n * 64;
    const bf16* P = (const bf16*)(p.ws + WS_PROJ) + ((size_t)b * SEQ + t0) * PC + (KIND == 0 ? C_GZ : C_HZ) + h * 64;
    bf16* Y = (bf16*)(p.ws + WS_Y) + ((size_t)b * SEQ + t0) * DM + (KIND == 0 ? 0 : 256) + h * 64;
    const bf16* QT = (const bf16*)(p.ws + WS_XB + (KIND == 0 ? A_GQT : A_HQT) + (size_t)ci * CH_QT);
    const bf16* ST = (const bf16*)(p.ws + WS_XB + (KIND == 0 ? A_GST : A_HST) + (size_t)ci * CH_QT);
    const float* ngp = (KIND == 0 ? p.gdn_g : p.hgrn_g) + l * HD;
    bf16x8 Bf[4][2];
#pragma unroll
    for (int cbk = 0; cbk < 4; ++cbk)
#pragma unroll
        for (int ks = 0; ks < 2; ++ks) Bf[cbk][ks] = *(const bf16x8*)(ST + (16 * cbk + c15) * 64 + 32 * ks + 8 * g);
    float ng[4];
#pragma unroll
    for (int cbk = 0; cbk < 4; ++cbk) ng[cbk] = ngp[16 * cbk + c15];
#pragma unroll 1
    for (int rb = 0; rb < 4; ++rb) {
        bf16x8 Af[2];
#pragma unroll
        for (int ks = 0; ks < 2; ++ks) Af[ks] = *(const bf16x8*)(QT + (16 * rb + c15) * 64 + 32 * ks + 8 * g);
        f32x4 o[4]; float zz[4][4];
#pragma unroll
        for (int cbk = 0; cbk < 4; ++cbk) {
            const bf16* yi = Y + (size_t)(16 * rb + 4 * g) * DM + 16 * cbk + c15; const bf16* zi = P + (size_t)(16 * rb + 4 * g) * PC + 16 * cbk + c15;
            o[cbk] = (f32x4){bf2f(yi[0]), bf2f(yi[DM]), bf2f(yi[2 * DM]), bf2f(yi[3 * DM])};
#pragma unroll
            for (int r = 0; r < 4; ++r) zz[cbk][r] = bf2f(zi[(size_t)r * PC]);
        }
#pragma unroll
        for (int cbk = 0; cbk < 4; ++cbk)
#pragma unroll
            for (int ks = 0; ks < 2; ++ks) o[cbk] = mfma16(Af[ks], Bf[cbk][ks], o[cbk]);
#pragma unroll
        for (int r = 0; r < 4; ++r) {
            float ss = o[0][r] * o[0][r] + o[1][r] * o[1][r] + o[2][r] * o[2][r] + o[3][r] * o[3][r];
            ss = row16_sum(ss);
            const float rs = rsqrtf(ss * (1.0f / 64.0f) + EPS);
#pragma unroll
            for (int cbk = 0; cbk < 4; ++cbk) { const bf16 ov = (bf16)f2bf(o[cbk][r] * rs * ng[cbk] * siluf_(zz[cbk][r])); if (dry) asm volatile("" :: "v"(ov)); else Y[(size_t)(16 * rb + 4 * g + r) * DM + 16 * cbk + c15] = ov; }
        }
    }
}
__device__ __forceinline__ void phase_out(const Params& p, int l, bool dry = false) {
    const int wave = TIDX() >> 6;
    const int gw = BIDX() * NWAVES + wave, NGW = gridDim.x * NWAVES;
    for (int it = gw; it < 2 * NCH; it += NGW) { if (it < NCH) out_item<0>(p, l, it, dry); else out_item<1>(p, l, it - NCH, dry); }
}
}

#ifndef REP_SCAN
#define REP_SCAN 1
#endif
#ifndef REP_ATT
#define REP_ATT 1
#endif
#ifndef REP_ATT_KIND
#define REP_ATT_KIND 2
#endif
#ifndef REP_ATT_QB
#define REP_ATT_QB 0
#endif
#ifndef REP_ATT_DRY
#define REP_ATT_DRY 0
#endif
__device__ __forceinline__ void phase_mix(const Params& p, int l, LAS unsigned char* lds) {
    const int c = BIDX();
    for (int rep = 0; rep < REP_SCAN; ++rep)
    for (int u = c; u < 64; u += gridDim.x) { if (u < 32) scn::scan_unit<0>(p, l, u); else scn::scan_unit<1>(p, l, u - 32); }
    LAS unsigned* bc = (LAS unsigned*)(lds + att::NSLOT * att::BUFB);
    for (int rep = 0; rep < REP_ATT; ++rep) {
    unsigned* ctr = (unsigned*)(p.ws + WS_CTL) + 64 * (1 + l + 2 * rep);
    for (;;) {
        __syncthreads();
        if (TIDX() == 0) bc[0] = atomicAdd(ctr, 1u);
        __syncthreads();
        const unsigned u = bc[0];
        if (u >= 1024u) break;
        const int kind = (int)(u >> 9), qb = 7 - (int)((u >> 6) & 7), bh = u & 63, b = bh >> 2, h = bh & 3;
        if (kind == 0) att::attn_unit<0>(p, l, b, h, qb, lds); else att::attn_unit<1>(p, l, b, h, qb, lds);
    }
    }
}

#ifndef GREP_S1A
#define GREP_S1A 1
#endif
#ifndef GREP_S1B
#define GREP_S1B 1
#endif
#ifndef GREP_S2A
#define GREP_S2A 1
#endif
#ifndef GREP_S2B
#define GREP_S2B 1
#endif
#ifndef GREP_S4
#define GREP_S4 1
#endif
#ifndef WY_OUTMASK
#define WY_OUTMASK 15
#endif
namespace wy {
typedef short bf16x8 __attribute__((ext_vector_type(8)));
typedef short bf16x4 __attribute__((ext_vector_type(4)));
typedef float f32x4 __attribute__((ext_vector_type(4)));
constexpr int LP = 72, ROWB = LP * 2;
__device__ __forceinline__ f32x4 mm32(const LAS unsigned char* X, int xr, const LAS unsigned char* Y, int yr, int k0, f32x4 acc, int c15, int g) {
    const bf16x8 a = *(const LAS bf16x8*)(X + (xr + c15) * ROWB + (k0 + 8 * g) * 2);
    const bf16x8 b = *(const LAS bf16x8*)(Y + (yr + c15) * ROWB + (k0 + 8 * g) * 2);
    f32x4 r = __builtin_amdgcn_mfma_f32_16x16x32_bf16(a, b, acc, 0, 0, 0);
    asm volatile("" : "+v"(r) : "v"(a), "v"(b));
    return r;
}
__device__ __forceinline__ f32x4 mm16(const LAS unsigned char* X, int xr, const LAS unsigned char* Y, int yr, int k0, f32x4 acc, int c15, int g) {
    const bf16x4 a = *(const LAS bf16x4*)(X + (xr + c15) * ROWB + (k0 + 4 * g) * 2);
    const bf16x4 b = *(const LAS bf16x4*)(Y + (yr + c15) * ROWB + (k0 + 4 * g) * 2);
    f32x4 r = __builtin_amdgcn_mfma_f32_16x16x16bf16_1k(a, b, acc, 0, 0, 0);
    asm volatile("" : "+v"(r) : "v"(a), "v"(b));
    return r;
}
__device__ __forceinline__ f32x4 zacc() { f32x4 z = (f32x4){0.f, 0.f, 0.f, 0.f}; asm volatile("" : "+v"(z)); return z; }
template <int KLEN>
__device__ __forceinline__ f32x4 mmk(const LAS unsigned char* X, int xr, const LAS unsigned char* Y, int yr, f32x4 acc, int c15, int g) {
#pragma unroll
    for (int k = 0; k + 32 <= KLEN; k += 32) acc = mm32(X, xr, Y, yr, k, acc, c15, g);
    if (KLEN % 32) acc = mm16(X, xr, Y, yr, KLEN - 16, acc, c15, g);
    return acc;
}
template <int NTL, int KLEN>
__device__ __forceinline__ void mm_batch(const LAS unsigned char* X, const int (&xr)[NTL], const LAS unsigned char* Y, const int (&yr)[NTL], f32x4 (&acc)[NTL], int c15, int g) {
#pragma unroll
    for (int k = 0; k + 32 <= KLEN; k += 32) { bf16x8 a[NTL], b[NTL];
#pragma unroll
        for (int t = 0; t < NTL; ++t) { a[t] = *(const LAS bf16x8*)(X + (xr[t] + c15) * ROWB + (k + 8 * g) * 2); b[t] = *(const LAS bf16x8*)(Y + (yr[t] + c15) * ROWB + (k + 8 * g) * 2); }
#pragma unroll
        for (int t = 0; t < NTL; ++t) { acc[t] = __builtin_amdgcn_mfma_f32_16x16x32_bf16(a[t], b[t], acc[t], 0, 0, 0); asm volatile("" : "+v"(acc[t]) : "v"(a[t]), "v"(b[t])); } }
    if (KLEN % 32) { bf16x4 a[NTL], b[NTL];
#pragma unroll
        for (int t = 0; t < NTL; ++t) { a[t] = *(const LAS bf16x4*)(X + (xr[t] + c15) * ROWB + (KLEN - 16 + 4 * g) * 2); b[t] = *(const LAS bf16x4*)(Y + (yr[t] + c15) * ROWB + (KLEN - 16 + 4 * g) * 2); }
#pragma unroll
        for (int t = 0; t < NTL; ++t) { acc[t] = __builtin_amdgcn_mfma_f32_16x16x16bf16_1k(a[t], b[t], acc[t], 0, 0, 0); asm volatile("" : "+v"(acc[t]) : "v"(a[t]), "v"(b[t])); } }
}
__device__ __forceinline__ float sum8_dpp(float v) {
    v += __int_as_float(__builtin_amdgcn_update_dpp(0, __float_as_int(v), 0xB1, 0xF, 0xF, true));
    v += __int_as_float(__builtin_amdgcn_update_dpp(0, __float_as_int(v), 0x4E, 0xF, 0xF, true));
    v += __int_as_float(__builtin_amdgcn_update_dpp(0, __float_as_int(v), 0x141, 0xF, 0xF, true));
    return v;
}
__device__ __forceinline__ void unpack8(const v4u w, float (&f)[8]) {
    f[0] = __uint_as_float(w.x << 16); f[1] = __uint_as_float(w.x & 0xffff0000u); f[2] = __uint_as_float(w.y << 16); f[3] = __uint_as_float(w.y & 0xffff0000u);
    f[4] = __uint_as_float(w.z << 16); f[5] = __uint_as_float(w.z & 0xffff0000u); f[6] = __uint_as_float(w.w << 16); f[7] = __uint_as_float(w.w & 0xffff0000u);
}
__device__ __forceinline__ v4u pack8(const float (&f)[8]) { v4u w; w.x = pk2(f[0], f[1]); w.y = pk2(f[2], f[3]); w.z = pk2(f[4], f[5]); w.w = pk2(f[6], f[7]); return w; }

struct GdnRaw { v4u q[4], k[4], v[4]; float ga, gb; };
__device__ __forceinline__ void gdn_load_raw(const Params& p, int ci, GdnRaw& R) {
    const int tid = TIDX(), tok = tid >> 3, c8 = tid & 7;
    const int b = ci >> 7, h = (ci >> 5) & 3, n = ci & 31, t0 = n * 64;
    const bf16* P = (const bf16*)(p.ws + WS_PROJ) + (size_t)b * SEQ * PC;
#pragma unroll
    for (int r = 0; r < 4; ++r) { const int row = t0 + tok - 3 + r, rowc = row < 0 ? 0 : row;
        const bf16* pr = P + (size_t)rowc * PC + h * 64 + 8 * c8;
        R.q[r] = *(const v4u*)(pr + C_GQ); R.k[r] = *(const v4u*)(pr + C_GK); R.v[r] = *(const v4u*)(pr + C_GV); }
    const float* AB = (const float*)(p.ws + WS_AB) + ((size_t)b * SEQ + t0 + tok) * 8;
    R.ga = AB[h]; R.gb = AB[4 + h];
}
constexpr int G_KH = 0, G_QH = 9216, G_VH = 18432, G_KTD = 27648, G_XT = 36864, G_AKK = 55296, G_AQK = 64512, G_TB = 73728, G_AD = 76800, G_SC = 80896;
constexpr int TBP = 24;
constexpr int G_ST_MF = 83968, G_ST_SL = 101376, G_ST_QT = 118784, G_ST_Y = 0;
__device__ __forceinline__ void gdn_chunk(const Params& p, int l, int ci, int ci_next, GdnRaw& R, LAS unsigned char* lds) {
    const int tid = TIDX(), lane = tid & 63, wid = __builtin_amdgcn_readfirstlane(tid >> 6), c15 = lane & 15, g = lane >> 4;
    const int b = ci >> 7, h = (ci >> 5) & 3, n = ci & 31, t0 = n * 64;
    const bf16* P = (const bf16*)(p.ws + WS_PROJ) + (size_t)b * SEQ * PC;
    LAS float* sc_g = (LAS float*)(lds + G_SC); LAS float* sc_b = sc_g + 64; LAS float* sc_gc = sc_g + 128; LAS float* sc_eg = sc_g + 192; LAS float* sc_dl = sc_g + 256;
    __syncthreads();
    for (int rp_ = 0; rp_ < GREP_S1A; ++rp_) {
        const int tok = tid >> 3, c8 = tid & 7;
        const float* cw = p.conv_w + (size_t)l * 4 * 768 + h * 64 + 8 * c8;
        float aq[8], ak[8], av[8];
#pragma unroll
        for (int i = 0; i < 8; ++i) { aq[i] = 0.f; ak[i] = 0.f; av[i] = 0.f; }
        float4 wgt[4][6];
#pragma unroll
        for (int r = 0; r < 4; ++r) {
            wgt[r][0] = *(const float4*)(cw + r * 768); wgt[r][1] = *(const float4*)(cw + r * 768 + 4); wgt[r][2] = *(const float4*)(cw + r * 768 + 256); wgt[r][3] = *(const float4*)(cw + r * 768 + 260);
            wgt[r][4] = *(const float4*)(cw + r * 768 + 512); wgt[r][5] = *(const float4*)(cw + r * 768 + 516);
        }
#pragma unroll
        for (int r = 0; r < 4; ++r) {
            const float m = (t0 + tok - 3 + r) < 0 ? 0.f : 1.f;
            float xq[8], xk[8], xv[8];
            unpack8(R.q[r], xq); unpack8(R.k[r], xk); unpack8(R.v[r], xv);
            const float wq[8] = {wgt[r][0].x, wgt[r][0].y, wgt[r][0].z, wgt[r][0].w, wgt[r][1].x, wgt[r][1].y, wgt[r][1].z, wgt[r][1].w};
            const float wk[8] = {wgt[r][2].x, wgt[r][2].y, wgt[r][2].z, wgt[r][2].w, wgt[r][3].x, wgt[r][3].y, wgt[r][3].z, wgt[r][3].w};
            const float wv[8] = {wgt[r][4].x, wgt[r][4].y, wgt[r][4].z, wgt[r][4].w, wgt[r][5].x, wgt[r][5].y, wgt[r][5].z, wgt[r][5].w};
#pragma unroll
            for (int i = 0; i < 8; ++i) { aq[i] += m * wq[i] * xq[i]; ak[i] += m * wk[i] * xk[i]; av[i] += m * wv[i] * xv[i]; }
        }
        float sq = 0.f, sk = 0.f;
#pragma unroll
        for (int i = 0; i < 8; ++i) { aq[i] = fsilu(aq[i]); ak[i] = fsilu(ak[i]); av[i] = fsilu(av[i]); sq += aq[i] * aq[i]; sk += ak[i] * ak[i]; }
        sq = sum8_dpp(sq); sk = sum8_dpp(sk);
        const float rq = __builtin_amdgcn_rsqf(sq + EPS) * 0.125f, rk = __builtin_amdgcn_rsqf(sk + EPS);
#pragma unroll
        for (int i = 0; i < 8; ++i) { aq[i] *= rq; ak[i] *= rk; }
        *(LAS v4u*)(lds + G_QH + tok * ROWB + 16 * c8) = pack8(aq);
        *(LAS v4u*)(lds + G_KH + tok * ROWB + 16 * c8) = pack8(ak);
        *(LAS v4u*)(lds + G_VH + tok * ROWB + 16 * c8) = pack8(av);
        if (c8 == 0) { sc_g[tok] = -expf(p.a_log[l * NH + h]) * fsoftplus(R.ga + p.dt_bias[l * NH + h]); sc_b[tok] = fsigmoid(R.gb); }
    }
    __syncthreads();
    for (int rp_ = 0; rp_ < GREP_S1B; ++rp_) {
        const int d = tid & 63, tq = tid >> 6;
        float pre = 0.f, tot = 0.f;
#pragma unroll
        for (int j = 0; j < 64; j += 4) { const f4 g4 = *(const LAS f4*)(sc_g + j); const float s4 = (g4.x + g4.y) + (g4.z + g4.w); tot += s4; if (j < 8 * tq) pre += s4; }
        float gc[8], bt[8];
        { const f4 a = *(const LAS f4*)(sc_g + 8 * tq), c = *(const LAS f4*)(sc_g + 8 * tq + 4), b0 = *(const LAS f4*)(sc_b + 8 * tq), b1 = *(const LAS f4*)(sc_b + 8 * tq + 4);
          gc[0] = pre + a.x; gc[1] = gc[0] + a.y; gc[2] = gc[1] + a.z; gc[3] = gc[2] + a.w; gc[4] = gc[3] + c.x; gc[5] = gc[4] + c.y; gc[6] = gc[5] + c.z; gc[7] = gc[6] + c.w;
          bt[0] = b0.x; bt[1] = b0.y; bt[2] = b0.z; bt[3] = b0.w; bt[4] = b1.x; bt[5] = b1.y; bt[6] = b1.z; bt[7] = b1.w; }
        float xv[8], xw[8], xk[8];
#pragma unroll
        for (int i = 0; i < 8; ++i) { const float eg = fexp(gc[i]), ed = fexp(tot - gc[i]);
            const float kv = bf2f(*(const LAS bf16*)(lds + G_KH + (8 * tq + i) * ROWB + 2 * d)), vv = bf2f(*(const LAS bf16*)(lds + G_VH + (8 * tq + i) * ROWB + 2 * d));
            xv[i] = vv * bt[i]; xw[i] = kv * bt[i] * eg; xk[i] = kv * ed;
            if (d == 0) { sc_gc[8 * tq + i] = gc[i]; sc_eg[8 * tq + i] = eg; } }
        if (tid == 0) sc_dl[0] = fexp(tot);
        *(LAS v4u*)(lds + G_XT + d * ROWB + 16 * tq) = pack8(xv);
        *(LAS v4u*)(lds + G_XT + (64 + d) * ROWB + 16 * tq) = pack8(xw);
        *(LAS v4u*)(lds + G_KTD + d * ROWB + 16 * tq) = pack8(xk);
    }
    __syncthreads();
    for (int rp_ = 0; rp_ < GREP_S2A; ++rp_) {
#pragma unroll 1
        for (int step = 0; step < 2; ++step) {
            if (step == 1) __syncthreads();
            const bool isq = step == 1;
            if (isq && wid == 0) {
                const int blk = lane >> 4, c = lane & 15;
                const LAS float* Ad = (const LAS float*)(lds + G_AD) + blk * 256;
                float t[16];
#pragma unroll
                for (int i = 0; i < 16; ++i) { float s = (i == c) ? 1.f : 0.f;
#pragma unroll
                    for (int j = 0; j < i; ++j) s -= Ad[i * 16 + j] * t[j];
                    t[i] = s; *(LAS bf16*)(lds + G_TB + ((blk * 16 + i) * TBP + c) * 2) = (bf16)f2bf(s); }
            } else {
                for (int tt = isq ? wid - 1 : wid; tt < 10; tt += (isq ? 7 : 8)) {
                    const int I = (tt >= 6) ? 3 : (tt >= 3) ? 2 : (tt >= 1) ? 1 : 0, J = tt - (I * (I + 1)) / 2;
                    f32x4 acc = zacc();
                    acc = mmk<64>(lds + (isq ? G_QH : G_KH), 16 * I, lds + G_KH, 16 * J, acc, c15, g);
                    const int jj = 16 * J + c15; const float gj = sc_gc[jj];
#pragma unroll
                    for (int r = 0; r < 4; ++r) { const int ii = 16 * I + 4 * g + r; const float dec = fexp(sc_gc[ii] - gj);
                        if (isq) { const float v = (jj <= ii) ? acc[r] * dec : 0.f; *(LAS bf16*)(lds + G_AQK + ii * ROWB + 2 * jj) = (bf16)f2bf(v); }
                        else { const float v = (jj < ii) ? acc[r] * dec * sc_b[ii] : 0.f; *(LAS bf16*)(lds + G_AKK + ii * ROWB + 2 * jj) = (bf16)f2bf(-v);
                            if (I == J) ((LAS float*)(lds + G_AD))[I * 256 + (4 * g + r) * 16 + c15] = v; } }
                }
            }
        }
    }
    __syncthreads();
    {
        const int cb = 16 * wid;
#pragma unroll
        for (int I = 0; I < 4; ++I) {
            LAS unsigned char* xp = lds + G_XT + (cb + c15) * ROWB + (16 * I + 4 * g) * 2;
            const v2u rr = *(const LAS v2u*)xp;
            f32x4 acc = (f32x4){__uint_as_float(rr.x << 16), __uint_as_float(rr.x & 0xffff0000u), __uint_as_float(rr.y << 16), __uint_as_float(rr.y & 0xffff0000u)};
            if (I == 1) acc = mmk<16>(lds + G_AKK, 16, lds + G_XT, cb, acc, c15, g);
            if (I == 2) acc = mmk<32>(lds + G_AKK, 32, lds + G_XT, cb, acc, c15, g);
            if (I == 3) acc = mmk<48>(lds + G_AKK, 48, lds + G_XT, cb, acc, c15, g);
            const bf16x4 ta = *(const LAS bf16x4*)(lds + G_TB + ((I * 16 + c15) * TBP + 4 * g) * 2);
            v2u bw; bw.x = pk2(acc[0], acc[1]); bw.y = pk2(acc[2], acc[3]);
            const bf16x4 tb = __builtin_bit_cast(bf16x4, bw);
            f32x4 x = __builtin_amdgcn_mfma_f32_16x16x16bf16_1k(ta, tb, zacc(), 0, 0, 0);
            asm volatile("" : "+v"(x) : "v"(ta), "v"(tb));
            v2u xw; xw.x = pk2(x[0], x[1]); xw.y = pk2(x[2], x[3]);
            *(LAS v2u*)xp = xw;
            asm volatile("s_waitcnt lgkmcnt(0)" ::: "memory");
        }
    }
    __syncthreads();
    if (ci_next < scn::NCH) gdn_load_raw(p, ci_next, R);
    for (int rp_ = 0; rp_ < GREP_S4; ++rp_) {
        const int type = wid >> 1, hf = wid & 1;
        const float dlast = sc_dl[0];
        if (type < 2) {
#pragma unroll
            for (int half = 0; half < 2; ++half) {
                int xr[4], yr[4]; f32x4 acc[4];
#pragma unroll
                for (int i = 0; i < 4; ++i) { const int rb = 2 * half + (i >> 1), cbk = 2 * hf + (i & 1); acc[i] = zacc();
                    xr[i] = 16 * rb; yr[i] = (type == 0 ? 64 : 0) + 16 * cbk; }
                if (type == 0) mm_batch<4, 64>(lds + G_KTD, xr, lds + G_XT, yr, acc, c15, g);
                else { int yk[4];
#pragma unroll
                    for (int i = 0; i < 4; ++i) yk[i] = 16 * (2 * hf + (i & 1));
                    mm_batch<4, 64>(lds + G_XT, xr, lds + G_KTD, yk, acc, c15, g); }
#pragma unroll
                for (int i = 0; i < 4; ++i) { const int rb = 2 * half + (i >> 1), col = 16 * (2 * hf + (i & 1)) + c15;
#pragma unroll
                    for (int r = 0; r < 4; ++r) { const int row = 16 * rb + 4 * g + r;
                        if (type == 0) *(LAS float*)(lds + G_ST_MF + row * 272 + col * 4) = ((row == col) ? dlast : 0.f) - acc[i][r];
                        else *(LAS float*)(lds + G_ST_SL + row * 272 + col * 4) = acc[i][r]; } }
            }
        } else {
            const int ybase = (type == 2 ? 64 : 0);
#pragma unroll
            for (int rb = 0; rb < 4; ++rb) {
                int xr[2] = {16 * rb, 16 * rb}, yr[2] = {ybase + 16 * (2 * hf), ybase + 16 * (2 * hf + 1)}; f32x4 acc[2] = {zacc(), zacc()};
                if (rb == 0) mm_batch<2, 16>(lds + G_AQK, xr, lds + G_XT, yr, acc, c15, g);
                if (rb == 1) mm_batch<2, 32>(lds + G_AQK, xr, lds + G_XT, yr, acc, c15, g);
                if (rb == 2) mm_batch<2, 48>(lds + G_AQK, xr, lds + G_XT, yr, acc, c15, g);
                if (rb == 3) mm_batch<2, 64>(lds + G_AQK, xr, lds + G_XT, yr, acc, c15, g);
#pragma unroll
                for (int i = 0; i < 2; ++i) { const int col = 16 * (2 * hf + i) + c15;
#pragma unroll
                    for (int r = 0; r < 4; ++r) { const int row = 16 * rb + 4 * g + r;
                        if (type == 2) *(LAS bf16*)(lds + G_ST_QT + row * ROWB + 2 * col) = (bf16)f2bf(sc_eg[row] * bf2f(*(const LAS bf16*)(lds + G_QH + row * ROWB + 2 * col)) - acc[i][r]);
                        else *(LAS bf16*)(lds + G_ST_Y + row * ROWB + 2 * col) = (bf16)f2bf(acc[i][r]); } }
            }
        }
    }
    __syncthreads();
    {
        float* MF = (float*)(p.ws + WS_SCR + scn::B_GMF + (size_t)ci * scn::CH_SL);
        float* SL = (float*)(p.ws + WS_SCR + scn::B_GSL + (size_t)ci * scn::CH_SL);
        bf16* QT = (bf16*)(p.ws + WS_XB + scn::A_GQT + (size_t)ci * scn::CH_QT);
        bf16* Y = (bf16*)(p.ws + WS_Y) + ((size_t)b * SEQ + t0) * DM + 0 + h * 64;
#pragma unroll
        for (int i = 0; i < 2; ++i) { const int pz = tid + 512 * i, row = pz >> 4, c4 = pz & 15;
            *(v4u*)(MF + row * 64 + c4 * 4) = *(const LAS v4u*)(lds + G_ST_MF + row * 272 + c4 * 16);
            *(v4u*)(SL + row * 64 + c4 * 4) = *(const LAS v4u*)(lds + G_ST_SL + row * 272 + c4 * 16); }
        { const int row = tid >> 3, c8 = tid & 7;
            *(v4u*)(QT + row * 64 + c8 * 8) = *(const LAS v4u*)(lds + G_ST_QT + row * ROWB + c8 * 16);
            *(v4u*)(Y + (size_t)row * DM + c8 * 8) = *(const LAS v4u*)(lds + G_ST_Y + row * ROWB + c8 * 16); }
    }
}

struct HgrnRaw { bf16 q[8], f[8], v[8]; };
__device__ __forceinline__ void hgrn_load_raw(const Params& p, int ci, HgrnRaw& R) {
    const int tid = TIDX(), ch = tid & 63, tq = tid >> 6;
    const int b = ci >> 7, h = (ci >> 5) & 3, n = ci & 31, t0 = n * 64;
    const bf16* P = (const bf16*)(p.ws + WS_PROJ) + ((size_t)b * SEQ + t0) * PC + h * 64;
#pragma unroll
    for (int i = 0; i < 8; ++i) { const bf16* pr = P + (size_t)(8 * tq + i) * PC + ch; R.q[i] = pr[C_HQ]; R.f[i] = pr[C_HF]; R.v[i] = pr[C_HI]; }
}
constexpr int H_QD = 0, H_KD = 9216, H_QO = 18432, H_KO1 = 27648  , H_KO2 = 29952  , H_KO3 = 34560  , H_KTD = 41472, H_VT = 50688, H_A = 59904, H_SC = 69120  , H_ST_SL = 73728, H_ST_Y = 91136;
__device__ __forceinline__ void hgrn_chunk(const Params& p, int l, int ci, int ci_next, HgrnRaw& R, LAS unsigned char* lds) {
    const int tid = TIDX(), lane = tid & 63, wid = __builtin_amdgcn_readfirstlane(tid >> 6), c15 = lane & 15, g = lane >> 4;
    const int b = ci >> 7, h = (ci >> 5) & 3, n = ci & 31, t0 = n * 64;
    const bf16* P = (const bf16*)(p.ws + WS_PROJ) + ((size_t)b * SEQ + t0) * PC + h * 64;
    LAS float* s_tot = (LAS float*)(lds + H_SC); LAS float* s_gm = s_tot + 512; LAS float* s_gr = s_tot + 768;
    const int ch = tid & 63, tq = tid >> 6;
    float lb = 0.f;
    if (l == 1) { const float a0 = p.hgrn_lb[h * 64 + ch], a1 = p.hgrn_lb[GW + h * 64 + ch]; lb = __builtin_amdgcn_rcpf(1.0f + fexp(a0 - a1)); }
    float qv[8], kv[8], vv[8], G[8];
    {
        float run = 0.f;
#pragma unroll
        for (int i = 0; i < 8; ++i) {
            const float qr = bf2f(R.q[i]), fr = bf2f(R.f[i]); vv[i] = bf2f(R.v[i]);
            const float sg = fsigmoid(fr), fg = lb + (1.0f - lb) * sg;
            kv[i] = (1.0f - lb) * (1.0f - sg); qv[i] = fsilu(qr);
            run += 0.6931471805599453f * __builtin_amdgcn_logf(fg); G[i] = run; }
        __syncthreads();
        s_tot[tq * 64 + ch] = run;
    }
    __syncthreads();
    float Glast;
    {
        float pre = 0.f, tot = 0.f;
#pragma unroll
        for (int j = 0; j < 8; ++j) { const float tj = s_tot[j * 64 + ch]; tot += tj; if (j < tq) pre += tj; }
#pragma unroll
        for (int i = 0; i < 8; ++i) G[i] += pre;
        Glast = tot;
        if (tq & 1) s_gm[(tq >> 1) * 64 + ch] = G[0];
        else if (tq > 0) s_gr[(tq >> 1) * 64 + ch] = pre;
    }
    __syncthreads();
    {
        const int I = tq >> 1;
        const float gm = s_gm[I * 64 + ch], gr = (I > 0) ? s_gr[I * 64 + ch] : 0.f;
        const float gr1 = s_gr[64 + ch], gr2 = s_gr[128 + ch], gr3 = s_gr[192 + ch];
        bf16* QT = (bf16*)(p.ws + WS_XB + scn::A_HQT + (size_t)ci * scn::CH_QT);
        float kt[8];
#pragma unroll
        for (int i = 0; i < 8; ++i) { const int tok = 8 * tq + i;
            QT[tok * 64 + ch] = (bf16)f2bf(qv[i] * fexp(G[i]));
            *(LAS bf16*)(lds + H_QD + tok * ROWB + 2 * ch) = (bf16)f2bf(qv[i] * fexp(G[i] - gm));
            *(LAS bf16*)(lds + H_KD + tok * ROWB + 2 * ch) = (bf16)f2bf(kv[i] * fexp(gm - G[i]));
            if (I > 0) *(LAS bf16*)(lds + H_QO + tok * ROWB + 2 * ch) = (bf16)f2bf(qv[i] * fexp(G[i] - gr));
            if (I < 1) *(LAS bf16*)(lds + H_KO1 + tok * ROWB + 2 * ch) = (bf16)f2bf(kv[i] * fexp(gr1 - G[i]));
            if (I < 2) *(LAS bf16*)(lds + H_KO2 + tok * ROWB + 2 * ch) = (bf16)f2bf(kv[i] * fexp(gr2 - G[i]));
            if (I < 3) *(LAS bf16*)(lds + H_KO3 + tok * ROWB + 2 * ch) = (bf16)f2bf(kv[i] * fexp(gr3 - G[i]));
            kt[i] = kv[i] * fexp(Glast - G[i]); }
        *(LAS v4u*)(lds + H_KTD + ch * ROWB + 16 * tq) = pack8(kt);
        *(LAS v4u*)(lds + H_VT + ch * ROWB + 16 * tq) = pack8(vv);
        if (tq == 0) ((float*)(p.ws + WS_SCR + scn::B_HDL + (size_t)ci * scn::CH_DL))[ch] = fexp(Glast);
    }
    __syncthreads();
    if (ci_next < scn::NCH) hgrn_load_raw(p, ci_next, R);
    {
        for (int t = wid; t < 10; t += 8) {
            f32x4 acc = zacc();
            const int I = (t >= 6) ? 3 : (t >= 3) ? 2 : (t >= 1) ? 1 : 0, J = t - (I * (I + 1)) / 2;
            if (I == J) acc = mmk<64>(lds + H_QD, 16 * I, lds + H_KD, 16 * I, acc, c15, g);
            else acc = mmk<64>(lds + H_QO, 16 * I, lds + (I == 1 ? H_KO1 : I == 2 ? H_KO2 : H_KO3), 16 * J, acc, c15, g);
#pragma unroll
            for (int r = 0; r < 4; ++r) { const int ii = 16 * I + 4 * g + r, jj = 16 * J + c15; *(LAS bf16*)(lds + H_A + ii * ROWB + 2 * jj) = (bf16)f2bf((jj <= ii) ? acc[r] : 0.f); }
        }
        {
            int xr[2], yr[2]; f32x4 acc[2] = {zacc(), zacc()};
#pragma unroll
            for (int i = 0; i < 2; ++i) { const int u = wid + 8 * i; xr[i] = 16 * (u >> 2); yr[i] = 16 * (u & 3); }
            mm_batch<2, 64>(lds + H_VT, xr, lds + H_KTD, yr, acc, c15, g);
#pragma unroll
            for (int i = 0; i < 2; ++i) { const int u = wid + 8 * i, rb = u >> 2, cbk = u & 3;
#pragma unroll
                for (int r = 0; r < 4; ++r) *(LAS float*)(lds + H_ST_SL + (16 * rb + 4 * g + r) * 272 + (16 * cbk + c15) * 4) = acc[i][r]; }
        }
    }
    __syncthreads();
    {
        bf16* Y = (bf16*)(p.ws + WS_Y) + ((size_t)b * SEQ + t0) * DM + 256 + h * 64;
        {
            const int rb = wid >> 1, c0 = (wid & 1) * 2;
            int xr[2] = {16 * rb, 16 * rb}, yr[2] = {16 * c0, 16 * (c0 + 1)}; f32x4 acc[2] = {zacc(), zacc()};
            if (rb == 0) mm_batch<2, 16>(lds + H_A, xr, lds + H_VT, yr, acc, c15, g);
            else if (rb == 1) mm_batch<2, 32>(lds + H_A, xr, lds + H_VT, yr, acc, c15, g);
            else if (rb == 2) mm_batch<2, 48>(lds + H_A, xr, lds + H_VT, yr, acc, c15, g);
            else mm_batch<2, 64>(lds + H_A, xr, lds + H_VT, yr, acc, c15, g);
#pragma unroll
            for (int i = 0; i < 2; ++i)
#pragma unroll
                for (int r = 0; r < 4; ++r) *(LAS bf16*)(lds + H_ST_Y + (16 * rb + 4 * g + r) * ROWB + 2 * (16 * (c0 + i) + c15)) = (bf16)f2bf(acc[i][r]);
        }
        __syncthreads();
        float* SL = (float*)(p.ws + WS_SCR + scn::B_HSL + (size_t)ci * scn::CH_SL);
#pragma unroll
        for (int i = 0; i < 2; ++i) { const int pz = tid + 512 * i, row = pz >> 4, c4 = pz & 15; *(v4u*)(SL + row * 64 + c4 * 4) = *(const LAS v4u*)(lds + H_ST_SL + row * 272 + c4 * 16); }
        { const int row = tid >> 3, c8 = tid & 7; *(v4u*)(Y + (size_t)row * DM + c8 * 8) = *(const LAS v4u*)(lds + H_ST_Y + row * ROWB + c8 * 16); }
    }
}

#ifndef WY_GDN
#define WY_GDN 1
#endif
#ifndef WY_REP_G
#define WY_REP_G 1
#endif
#ifndef WY_REP_H
#define WY_REP_H 1
#endif
#ifndef WY_HGRN
#define WY_HGRN 1
#endif
__device__ __forceinline__ void phase_pre_mfma(const Params& p, int l, LAS unsigned char* lds) {
    const int wave = TIDX() >> 6;
    LAS float* wl = (LAS float*)(lds + 100 * 1024 + wave * 1024);
    const int gw = BIDX() * NWAVES + wave, NGW = gridDim.x * NWAVES;
    if (WY_GDN && WY_OUTMASK == 15) { for (int rep = 0; rep < WY_REP_G; ++rep) { GdnRaw R; if (BIDX() < scn::NCH) gdn_load_raw(p, BIDX(), R); for (int ci = BIDX(); ci < scn::NCH; ci += gridDim.x) gdn_chunk(p, l, ci, ci + (int)gridDim.x, R, lds); } }
    else { for (int it = gw; it < 2 * scn::NCH; it += NGW) scn::gdn_pre<1>(p, l, it, wl); for (int it = gw; it < 2 * scn::NCH; it += NGW) scn::gdn_pre<0>(p, l, it, wl); }
    if (WY_HGRN) { for (int rep = 0; rep < WY_REP_H; ++rep) { HgrnRaw R; if (BIDX() < scn::NCH) hgrn_load_raw(p, BIDX(), R); for (int ci = BIDX(); ci < scn::NCH; ci += gridDim.x) hgrn_chunk(p, l, ci, ci + (int)gridDim.x, R, lds); } }
    else { __syncthreads(); for (int it = gw; it < scn::NCH; it += NGW) scn::hgrn_pre(p, l, it, wl); }
    __syncthreads();
    for (int it = gw; it < NB * NH * 8 * 4; it += NGW) scn::kmean_item(p, it);
}
}
#ifndef GIN_ALIGN
#define GIN_ALIGN true
#endif
#ifndef GIN_SP2
#define GIN_SP2 true
#endif
#ifndef REP_PRE
#define REP_PRE 1
#endif
#ifndef REP_POST0
#define REP_POST0 1
#endif
#ifndef REP_PROLOGUE
#define REP_PROLOGUE 1
#endif
#ifndef REP_BAR
#define REP_BAR 1
#endif
#ifndef REP_GIN
#define REP_GIN 1
#endif
#ifndef REP_GOUT
#define REP_GOUT 1
#endif
#ifndef REP_OUT
#define REP_OUT 1
#endif
#ifndef REP_MIX
#define REP_MIX 1
#endif

__device__ __forceinline__ Params load_params() {
    const __attribute__((address_space(4))) Params* q = (const __attribute__((address_space(4))) Params*)__builtin_amdgcn_kernarg_segment_ptr();
    asm volatile("" : "+s"(q));
    return *(const Params*)q;
}
__device__ __forceinline__ void grid_barrier(LAS unsigned char* lds) {
    const Params p = load_params();
    XcdBarrier bar; bar.bar = (unsigned*)(p.ws + WS_CTL) + 4096; bar.x = xb_xcc_id(); bar.st = (volatile LAS unsigned*)(lds + 131072 + 64);
    xcd_barrier(bar);
}
__global__ void __launch_bounds__(NT, 2) fwd_megakernel(Params p_unused) {
    extern __shared__ __attribute__((aligned(16))) unsigned char lds_raw[];
    LAS unsigned char* lds = (LAS unsigned char*)lds_raw;
    {
        const Params p = load_params();
        volatile LAS unsigned* st = (volatile LAS unsigned*)(lds + 131072 + 64);
        if (TIDX() < 2) st[TIDX()] = 0u;
        __syncthreads();
        (void)xcd_barrier_post((unsigned*)(p.ws + WS_CTL) + 4096, st);
        for (int rep = 0; rep < REP_PROLOGUE; ++rep) phase_prologue(p, lds);
    }
    grid_barrier(lds);
#pragma unroll 1
    for (int l = 0; l < DEPTH; ++l) {
        for (int rep = 0; rep < REP_GIN; ++rep) {
            const Params p = load_params();
            pg8::Gemm g{(const bf16*)(p.ws + WS_XB), (const bf16*)(p.ws + WS_WIN) + (size_t)l * PC * DM, NTOK, PC, DM}; pg8::StaticOrder S; S.init(NTOK, PC, (int)gridDim.x, BIDX());
            pg8::EpiProj E{(bf16*)(p.ws + WS_PROJ), PC, (const float*)(p.ws + WS_RSTD)};
            pg8::gemm_phase<pg8::EpiProj, pg8::StaticOrder, GIN_ALIGN, GIN_SP2>(lds, g, S, E);
        }
        grid_barrier(lds);
        for (int rep = 0; rep < REP_PRE; ++rep) { const Params p = load_params(); wy::phase_pre_mfma(p, l, lds); }

        grid_barrier(lds);
        { const Params p = load_params(); phase_mix(p, l, lds); }
        for (int rep = 0; rep < REP_BAR; ++rep) grid_barrier(lds);
        for (int rep = 0; rep < REP_OUT; ++rep) { const Params p = load_params(); scn::phase_out(p, l, rep + 1 < REP_OUT); }
        grid_barrier(lds);
        for (int rep = 0; rep < REP_GOUT; ++rep) {
            const Params p = load_params();
            pg8::Gemm g{(const bf16*)(p.ws + WS_Y), (const bf16*)(p.ws + WS_WOUT) + (size_t)l * DM * DM, NTOK, DM, DM}; pg8::StaticOrder S; S.init(NTOK, DM, (int)gridDim.x, BIDX());
            pg8::EpiBf16Plain E{(bf16*)(p.ws + WS_PROJ), DM};
            pg8::gemm_phase<pg8::EpiBf16Plain, pg8::StaticOrder, true, true>(lds, g, S, E);
        }
        grid_barrier(lds);
        for (int rep = 0; rep < ((l == 0) ? REP_POST0 : 1); ++rep) { const Params p = load_params(); phase_post(p, l, lds); }
        grid_barrier(lds);
    }
}

extern "C" void kernel_launch(void* const* d_in, const int* in_sizes, int n_in, void* d_out, int out_size, void* d_ws, size_t ws_size, hipStream_t stream) {
    static int grid_blocks = 0;
    if (!grid_blocks) {
        if (ws_size < WS_END) { fprintf(stderr, "workspace too small: %zu < %zu\n", ws_size, (size_t)WS_END); grid_blocks = -1; return; }
        int dev = 0, cus = 0, per_cu = 0;
        (void)hipGetDevice(&dev);
        (void)hipDeviceGetAttribute(&cus, hipDeviceAttributeMultiprocessorCount, dev);
        (void)hipFuncSetAttribute((const void*)fwd_megakernel, hipFuncAttributeMaxDynamicSharedMemorySize, LDS_BYTES);
        (void)hipOccupancyMaxActiveBlocksPerMultiprocessor(&per_cu, (const void*)fwd_megakernel, NT, LDS_BYTES);
        if (per_cu < 1) { fprintf(stderr, "occupancy query says %d blocks/CU\n", per_cu); per_cu = 1; }
        grid_blocks = cus * 1;
    }
    if (grid_blocks < 0) return;
    (void)hipMemsetAsync((char*)d_ws + WS_CTL, 0, 65536, stream);
    Params p{};
    p.x = (const float*)d_in[0]; p.pre_g = (const float*)d_in[1]; p.post_g = (const float*)d_in[2]; p.w_in = (const float*)d_in[3];
    p.conv_w = (const float*)d_in[4]; p.a_log = (const float*)d_in[5]; p.dt_bias = (const float*)d_in[6]; p.gdn_g = (const float*)d_in[7];
    p.hgrn_lb = (const float*)d_in[8]; p.hgrn_g = (const float*)d_in[9]; p.lq1 = (const float*)d_in[10]; p.lk1 = (const float*)d_in[11];
    p.lq2 = (const float*)d_in[12]; p.lk2 = (const float*)d_in[13]; p.diff_g = (const float*)d_in[14]; p.w_out = (const float*)d_in[15];
    p.out = (float*)d_out; p.ws = (unsigned char*)d_ws;
    void* args[] = {&p};
    hipError_t e = hipLaunchCooperativeKernel((void*)fwd_megakernel, dim3(grid_blocks), dim3(NT), args, LDS_BYTES, stream);
    if (e != hipSuccess) fprintf(stderr, "cooperative launch failed: %s (grid %d)\n", hipGetErrorString(e), grid_blocks);
}
```

```cpp
#include <hip/hip_runtime.h>
#include <hip/hip_cooperative_groups.h>
#include <cstdio>
#include <cstdint>
#include <cmath>
namespace cg = cooperative_groups;
__device__ __forceinline__ int TIDX() { int t = threadIdx.x; asm volatile("" : "+v"(t)); return t; }
__device__ __forceinline__ int BIDX() { int b = blockIdx.x; asm volatile("" : "+s"(b)); return b; }
namespace pg8 {
#define PG8_LAS __attribute__((address_space(3)))
typedef unsigned short bf16_t;
typedef short bf16x8 __attribute__((ext_vector_type(8)));
typedef float f32x4 __attribute__((ext_vector_type(4)));
typedef unsigned u32x4 __attribute__((ext_vector_type(4)));
constexpr int BM = 256, BK = 64, HALF = 128, HTB = HALF * BK * 2  , STAGE_BYTES = 8 * HTB, NXCD = 8, WGM = 8;

__host__ __device__ __forceinline__ int lds_byte(int r, int c) { const int st = (r >> 4) * 2 + (c >> 5), rr = r & 15, cc = c & 31, ob = rr * 64 + cc * 2; return st * 1024 + (ob ^ (((ob >> 9) & 1) << 5)); }
__host__ __device__ __forceinline__ void stage_rc(int b, int& R, int& C) { const int st = b / 1024, sb = b % 1024, swz = sb ^ (((sb >> 9) & 1) << 5); R = (st >> 1) * 16 + swz / 64; C = (st & 1) * 32 + (swz % 64) / 2; }
__host__ __device__ __forceinline__ int perm32(int rho) { const int n = rho >> 4, i = rho & 15; return 8 * (i >> 2) + 4 * n + (i & 3); }

struct Unit { int pm, pn; };
struct Gemm { const bf16_t* A; const bf16_t* Bt; int M, N, K; };

struct StaticOrder {
    int nM, nN, nwg, G, c;
    __host__ __device__ void init(int M, int N, int G_, int c_) { nM = M / BM; nN = N / BM; nwg = nM * nN; G = G_; c = c_; }
    __host__ __device__ bool next(int i, Unit& u) const {
        const long L = (long)i * G + c; if (L >= nwg) return false;
        int wgid = (int)L; { const int q = nwg / NXCD, r = nwg % NXCD, xcd = wgid % NXCD, off = wgid / NXCD; wgid = (xcd < r ? xcd * (q + 1) : r * (q + 1) + (xcd - r) * q) + off; }
        const int nig = WGM * nN, gid = wgid / nig, fm = gid * WGM, gsz = (nM - fm) < WGM ? (nM - fm) : WGM;
        u.pm = fm + ((wgid % nig) % gsz); u.pn = (wgid % nig) / gsz; return true;
    }
    __device__ __forceinline__ void a_ready(const Unit&) const {}
    __device__ __forceinline__ void done(const Unit&) const {}
};
__device__ __forceinline__ unsigned cvt_pk_bf16(float lo, float hi) { unsigned r; asm volatile("v_cvt_pk_bf16_f32 %0, %1, %2" : "=v"(r) : "v"(lo), "v"(hi)); return r; }
struct EpiProj {
    static constexpr bool PERM = true, AFTER_DRAIN = false;
    bf16_t* O; int ldc; const float* rstd;
    __device__ __forceinline__ void operator()(const f32x4 (&acc)[2][2][4][2], const Unit& u, int wr, int wc, int fr, int fq) const {
        const int row0 = u.pm * BM + wr * 64 + fr, col0 = u.pn * BM + wc * 32 + 8 * fq;
#pragma unroll
        for (int ai = 0; ai < 2; ++ai)
#pragma unroll
            for (int m = 0; m < 4; ++m) { const int row = row0 + ai * HALF + m * 16; const float s = rstd[row]; bf16_t* rowp = O + (size_t)row * ldc + col0;
#pragma unroll
                for (int bj = 0; bj < 2; ++bj) { const f32x4 v0 = acc[ai][bj][m][0] * s, v1 = acc[ai][bj][m][1] * s;
                    u32x4 w; w.x = cvt_pk_bf16(v0[0], v0[1]); w.y = cvt_pk_bf16(v0[2], v0[3]); w.z = cvt_pk_bf16(v1[0], v1[1]); w.w = cvt_pk_bf16(v1[2], v1[3]);
                    *(u32x4*)(rowp + bj * HALF) = w; } }
    }
};
struct EpiF32 {
    static constexpr bool PERM = false, AFTER_DRAIN = false;
    float* O; int ldc;
    __device__ __forceinline__ void operator()(const f32x4 (&acc)[2][2][4][2], const Unit& u, int wr, int wc, int fr, int fq) const {
        const int row0 = u.pm * BM + wr * 64 + fr, col0 = u.pn * BM + wc * 32 + 4 * fq;
#pragma unroll
        for (int ai = 0; ai < 2; ++ai)
#pragma unroll
            for (int m = 0; m < 4; ++m) { float* rowp = O + (size_t)(row0 + ai * HALF + m * 16) * ldc + col0;
#pragma unroll
                for (int bj = 0; bj < 2; ++bj)
#pragma unroll
                    for (int n = 0; n < 2; ++n) *(f32x4*)(rowp + bj * HALF + n * 16) = acc[ai][bj][m][n]; }
    }
};
struct EpiBf16Plain {
    static constexpr bool PERM = true, AFTER_DRAIN = false;
    bf16_t* O; int ldc;
    __device__ __forceinline__ void operator()(const f32x4 (&acc)[2][2][4][2], const Unit& u, int wr, int wc, int fr, int fq) const {
        const int row0 = u.pm * BM + wr * 64 + fr, col0 = u.pn * BM + wc * 32 + 8 * fq;
#pragma unroll
        for (int ai = 0; ai < 2; ++ai)
#pragma unroll
            for (int m = 0; m < 4; ++m) { bf16_t* rowp = O + (size_t)(row0 + ai * HALF + m * 16) * ldc + col0;
#pragma unroll
                for (int bj = 0; bj < 2; ++bj) { const f32x4 v0 = acc[ai][bj][m][0], v1 = acc[ai][bj][m][1];
                    u32x4 w; w.x = cvt_pk_bf16(v0[0], v0[1]); w.y = cvt_pk_bf16(v0[2], v0[3]); w.z = cvt_pk_bf16(v1[0], v1[1]); w.w = cvt_pk_bf16(v1[2], v1[3]);
                    *(u32x4*)(rowp + bj * HALF) = w; } }
    }
};
template <class Epi, class Sched, bool ALIGN_EPI = false, bool SP2 = false>
__device__ __forceinline__ void gemm_phase(PG8_LAS unsigned char* lds, const Gemm g, const Sched& S, const Epi& E) {
    const int tid = TIDX(), wid = __builtin_amdgcn_readfirstlane(tid >> 6), lane = tid & 63, wr = wid >> 2, wc = wid & 3, fr = lane & 15, fq = lane >> 4;
    const int K = g.K, nt = K / BK;
    unsigned voffA[2], voffB[2];
#pragma unroll
    for (int i = 0; i < 2; ++i) { int R, C; stage_rc(tid * 16 + i * 8192, R, C); const int Rb = Epi::PERM ? ((R & ~31) + perm32(R & 31)) : R;
        voffA[i] = (unsigned)(R * K + C) * 2u; voffB[i] = (unsigned)(Rb * K + C) * 2u; }
    const size_t kstep = (size_t)(BK * 2);
    const size_t hstep = (size_t)HALF * K * 2;
    const size_t tstep = 2 * hstep;
    const unsigned ldsw = (unsigned)wid * 1024u;
    const int aoff = lds_byte(wr * 64 + fr, fq * 8), boff = lds_byte(wc * 32 + fr, fq * 8);
#define PG8_SA(b, h) (((b) * 2 + (h)) * HTB)
#define PG8_SB(b, h) ((4 + (b) * 2 + (h)) * HTB)
#define PG8_STAGE(bufoff, gbase, voff) do { _Pragma("unroll") for (int _i = 0; _i < 2; ++_i) \
        __builtin_amdgcn_global_load_lds((const unsigned*)((const char*)(gbase) + (voff)[_i]), (PG8_LAS unsigned*)(lds + (bufoff) + ldsw + _i * 8192), 16, 0, 0); } while (0)
#define PG8_LDA(dst, b, h) do { _Pragma("unroll") for (int m = 0; m < 4; ++m) _Pragma("unroll") for (int k = 0; k < 2; ++k) dst[m][k] = *(const PG8_LAS bf16x8*)(lds + PG8_SA(b, h) + aoff + m * 2048 + k * 1024); } while (0)
#define PG8_LDB(dst, b, h) do { _Pragma("unroll") for (int n = 0; n < 2; ++n) _Pragma("unroll") for (int k = 0; k < 2; ++k) dst[n][k] = *(const PG8_LAS bf16x8*)(lds + PG8_SB(b, h) + boff + n * 2048 + k * 1024); } while (0)
#define PG8_MMA(ai, bj, At, Bt) do { __builtin_amdgcn_s_setprio(1); _Pragma("unroll") for (int m = 0; m < 4; ++m) _Pragma("unroll") for (int n = 0; n < 2; ++n) _Pragma("unroll") for (int k = 0; k < 2; ++k) \
        acc[ai][bj][m][n] = __builtin_amdgcn_mfma_f32_16x16x32_bf16(Bt[n][k], At[m][k], acc[ai][bj][m][n], 0, 0, 0); __builtin_amdgcn_s_setprio(0); } while (0)
#define PG8_WAIT_V(n) asm volatile("s_waitcnt vmcnt(" #n ")" ::: "memory")
#define PG8_WAIT_L(n) asm volatile("s_waitcnt lgkmcnt(" #n ")" ::: "memory")
#define PG8_BAR __builtin_amdgcn_s_barrier()
#define PG8_SCHED __builtin_amdgcn_sched_barrier(0)
    Unit cur, nxt; int ui = 0;
    if (!S.next(0, cur)) return;
    f32x4 acc[2][2][4][2];
#pragma unroll
    for (int a = 0; a < 2; ++a)
#pragma unroll
        for (int b = 0; b < 2; ++b)
#pragma unroll
            for (int m = 0; m < 4; ++m)
#pragma unroll
                for (int n = 0; n < 2; ++n) acc[a][b][m][n] = (f32x4){0.f, 0.f, 0.f, 0.f};
    bf16x8 At[4][2], B0[2][2], B1[2][2];
    const char* cA = (const char*)g.A + (size_t)cur.pm * tstep; const char* cB = (const char*)g.Bt + (size_t)cur.pn * tstep;
    S.a_ready(cur);
    if constexpr (SP2) {
        PG8_STAGE(PG8_SB(0, 0), cB, voffB); PG8_STAGE(PG8_SB(0, 1), cB + hstep, voffB); PG8_STAGE(PG8_SA(0, 0), cA, voffA); PG8_STAGE(PG8_SA(0, 1), cA + hstep, voffA);
        if (wr == 1) PG8_BAR;
        PG8_WAIT_V(2); PG8_BAR;
        PG8_STAGE(PG8_SB(1, 0), cB + kstep, voffB); PG8_STAGE(PG8_SA(1, 0), cA + kstep, voffA); PG8_STAGE(PG8_SB(1, 1), cB + hstep + kstep, voffB);
        PG8_WAIT_V(6); PG8_BAR;
    } else {
        PG8_STAGE(PG8_SB(0, 0), cB, voffB); PG8_STAGE(PG8_SA(0, 0), cA, voffA); PG8_STAGE(PG8_SB(0, 1), cB + hstep, voffB); PG8_STAGE(PG8_SA(0, 1), cA + hstep, voffA);
        if (wr == 1) PG8_BAR;
        PG8_WAIT_V(4); PG8_BAR;
        PG8_STAGE(PG8_SB(1, 0), cB + kstep, voffB); PG8_STAGE(PG8_SA(1, 0), cA + kstep, voffA); PG8_STAGE(PG8_SB(1, 1), cB + hstep + kstep, voffB);
        PG8_WAIT_V(6); PG8_BAR;
    }
    for (;;) {
        const bool has_next = S.next(ui + 1, nxt);
        const char* nA = has_next ? (const char*)g.A + (size_t)nxt.pm * tstep : cA; const char* nB = has_next ? (const char*)g.Bt + (size_t)nxt.pn * tstep : cB;
        for (int t = 0; t < nt; t += 2) {
            const bool last = (t == nt - 2);
            const char* a1 = cA + (size_t)(t + 1) * kstep;
            const char* a2 = last ? nA : cA + (size_t)(t + 2) * kstep; const char* b2 = last ? nB : cB + (size_t)(t + 2) * kstep;
            const char* a3 = a2 + kstep; const char* b3 = b2 + kstep;
            if (last && has_next) S.a_ready(nxt);
            if constexpr (SP2) {
            PG8_LDB(B0, 0, 0); PG8_LDB(B1, 0, 1); PG8_SCHED; PG8_LDA(At, 0, 0); PG8_STAGE(PG8_SA(1, 1), a1 + hstep, voffA);
            PG8_WAIT_V(8); PG8_WAIT_L(0); PG8_BAR; PG8_MMA(0, 0, At, B0); PG8_MMA(0, 1, At, B1); PG8_BAR; PG8_SCHED;
            PG8_LDA(At, 0, 1); PG8_STAGE(PG8_SB(0, 0), b2, voffB); PG8_STAGE(PG8_SB(0, 1), b2 + hstep, voffB); PG8_STAGE(PG8_SA(0, 0), a2, voffA);
            PG8_WAIT_V(8); PG8_WAIT_L(0); PG8_BAR; PG8_MMA(1, 0, At, B0); PG8_MMA(1, 1, At, B1); PG8_BAR; PG8_SCHED;
            PG8_LDB(B0, 1, 0); PG8_LDB(B1, 1, 1); PG8_SCHED; PG8_LDA(At, 1, 0); PG8_STAGE(PG8_SA(0, 1), a2 + hstep, voffA);
            PG8_WAIT_V(8); PG8_WAIT_L(0); PG8_BAR; PG8_MMA(0, 0, At, B0); PG8_MMA(0, 1, At, B1); PG8_BAR; PG8_SCHED;
            PG8_LDA(At, 1, 1); PG8_STAGE(PG8_SB(1, 0), b3, voffB); PG8_STAGE(PG8_SB(1, 1), b3 + hstep, voffB); PG8_STAGE(PG8_SA(1, 0), a3, voffA);
            PG8_WAIT_V(8); PG8_WAIT_L(0); PG8_BAR; PG8_MMA(1, 0, At, B0); PG8_MMA(1, 1, At, B1); PG8_BAR; PG8_SCHED;
            } else {
            PG8_LDB(B0, 0, 0); PG8_SCHED; PG8_LDA(At, 0, 0); PG8_STAGE(PG8_SA(1, 1), a1 + hstep, voffA);
            PG8_WAIT_L(8); PG8_BAR; PG8_WAIT_L(0); PG8_MMA(0, 0, At, B0); PG8_BAR; PG8_SCHED;
            PG8_LDB(B1, 0, 1); PG8_STAGE(PG8_SB(0, 0), b2, voffB);
            PG8_BAR; PG8_WAIT_L(0); PG8_MMA(0, 1, At, B1); PG8_BAR;
            PG8_LDA(At, 0, 1); PG8_STAGE(PG8_SA(0, 0), a2, voffA);
            PG8_BAR; PG8_WAIT_L(0); PG8_MMA(1, 0, At, B0); PG8_BAR; PG8_SCHED;
            PG8_STAGE(PG8_SB(0, 1), b2 + hstep, voffB);
            PG8_WAIT_V(6); PG8_BAR; PG8_MMA(1, 1, At, B1); PG8_BAR;
            PG8_LDB(B0, 1, 0); PG8_SCHED; PG8_LDA(At, 1, 0); PG8_STAGE(PG8_SA(0, 1), a2 + hstep, voffA);
            PG8_WAIT_L(8); PG8_BAR; PG8_WAIT_L(0); PG8_MMA(0, 0, At, B0); PG8_BAR; PG8_SCHED;
            PG8_LDB(B1, 1, 1); PG8_STAGE(PG8_SB(1, 0), b3, voffB);
            PG8_BAR; PG8_WAIT_L(0); PG8_MMA(0, 1, At, B1); PG8_BAR;
            PG8_LDA(At, 1, 1); PG8_STAGE(PG8_SA(1, 0), a3, voffA);
            PG8_BAR; PG8_WAIT_L(0); PG8_MMA(1, 0, At, B0); PG8_BAR; PG8_SCHED;
            PG8_STAGE(PG8_SB(1, 1), b3 + hstep, voffB);
            PG8_WAIT_V(6); PG8_BAR; PG8_MMA(1, 1, At, B1); PG8_BAR;
            }
        }
        if constexpr (ALIGN_EPI) { if (wr == 0) PG8_BAR; }
        if constexpr (!Epi::AFTER_DRAIN) { E(acc, cur, wr, wc, fr, fq); S.done(cur); }
        if (!has_next) break;
#pragma unroll
        for (int a = 0; a < 2; ++a)
#pragma unroll
            for (int b = 0; b < 2; ++b)
#pragma unroll
                for (int m = 0; m < 4; ++m)
#pragma unroll
                    for (int n = 0; n < 2; ++n) acc[a][b][m][n] = (f32x4){0.f, 0.f, 0.f, 0.f};
        cur = nxt; cA = nA; cB = nB; ++ui;
        if constexpr (ALIGN_EPI) { if (wr == 1) PG8_BAR; }
    }
    PG8_WAIT_V(0);
    if constexpr (!ALIGN_EPI) { if (wr == 0) PG8_BAR; }
    PG8_BAR;
    if constexpr (Epi::AFTER_DRAIN) { E.fused(acc, cur, wr, wc, fr, fq, lds, wid, lane); S.done(cur); }
#undef PG8_SA
#undef PG8_SB
#undef PG8_STAGE
#undef PG8_LDA
#undef PG8_LDB
#undef PG8_MMA
#undef PG8_WAIT_V
#undef PG8_WAIT_L
#undef PG8_BAR
#undef PG8_SCHED
}
}

#define LAS __attribute__((address_space(3)))
typedef unsigned short bf16;
typedef unsigned v4u __attribute__((ext_vector_type(4)));
typedef unsigned v2u __attribute__((ext_vector_type(2)));
typedef float f4 __attribute__((ext_vector_type(4)));
constexpr int DM = 1024, NB = 16, SEQ = 2048, DEPTH = 2, NTOK = NB * SEQ;
constexpr int GW = 256, NH = 4, HD = 64;
constexpr int INC = 4104;
constexpr int PC = 4096;
constexpr int NT = 512, NWAVES = 8;
constexpr float EPS = 1e-6f;
constexpr int C_GQ = 0, C_GK = 256, C_GV = 512, C_GZ = 768;
constexpr int C_HQ = 1024, C_HF = 1280, C_HI = 1536, C_HZ = 1792;
constexpr int C_MQ = 2048, C_MK = 2304, C_MV = 2560, C_MZ = 2816;
constexpr int C_DQ = 3072, C_DK = 3328, C_DV = 3584, C_DZ = 3840;
constexpr int LDS_BYTES = 147456;

constexpr size_t MiB = 1u << 20;
constexpr size_t WS_CTL = 0;
constexpr size_t WS_PROJ = 1 * MiB;
constexpr size_t WS_XB = WS_PROJ + 256 * MiB;
constexpr size_t WS_Y = WS_XB + 64 * MiB;
constexpr size_t WS_WIN = WS_Y + 64 * MiB;
constexpr size_t WS_WOUT = WS_WIN + 16 * MiB;
constexpr size_t WS_RSTD = WS_WOUT + 4 * MiB;
constexpr size_t WS_AB = WS_RSTD + 1 * MiB;
constexpr size_t WS_KMEAN = WS_AB + 1 * MiB;
constexpr size_t WS_SCR = WS_KMEAN + 1 * MiB;
constexpr size_t WS_END = WS_SCR + 104 * MiB;

struct Params {
    const float* x; const float* pre_g; const float* post_g; const float* w_in; const float* conv_w;
    const float* a_log; const float* dt_bias; const float* gdn_g; const float* hgrn_lb; const float* hgrn_g;
    const float* lq1; const float* lk1; const float* lq2; const float* lk2; const float* diff_g; const float* w_out;
    float* out; unsigned char* ws;
};

__device__ __forceinline__ float sigmoidf_(float x) { return 1.0f / (1.0f + expf(-x)); }
__device__ __forceinline__ float siluf_(float x) { return x / (1.0f + expf(-x)); }
__device__ __forceinline__ float softplusf_(float x) { return fmaxf(x, 0.f) + log1pf(expf(-fabsf(x))); }
__device__ __forceinline__ float fexp(float x) { return __builtin_amdgcn_exp2f(x * 1.4426950408889634f); }
__device__ __forceinline__ float fsigmoid(float x) { return __builtin_amdgcn_rcpf(1.0f + fexp(-x)); }
__device__ __forceinline__ float fsilu(float x) { return x * fsigmoid(x); }
__device__ __forceinline__ float fsoftplus(float x) { return fmaxf(x, 0.f) + 0.6931471805599453f * __builtin_amdgcn_logf(1.0f + fexp(-fabsf(x))); }
__device__ __forceinline__ float dpp_row16_sum(float v) {
    v += __int_as_float(__builtin_amdgcn_update_dpp(0, __float_as_int(v), 0xB1, 0xF, 0xF, true));
    v += __int_as_float(__builtin_amdgcn_update_dpp(0, __float_as_int(v), 0x4E, 0xF, 0xF, true));
    v += __int_as_float(__builtin_amdgcn_update_dpp(0, __float_as_int(v), 0x141, 0xF, 0xF, true));
    v += __int_as_float(__builtin_amdgcn_update_dpp(0, __float_as_int(v), 0x140, 0xF, 0xF, true));
    return v;
}
__device__ __forceinline__ float wave_sum(float v);
__device__ __forceinline__ float xor32_sum(float v) { const auto rr = __builtin_amdgcn_permlane32_swap(__float_as_uint(v), __float_as_uint(v), false, false); return __uint_as_float(rr[0]) + __uint_as_float(rr[1]); }
__device__ __forceinline__ float xor32_max(float v) { const auto rr = __builtin_amdgcn_permlane32_swap(__float_as_uint(v), __float_as_uint(v), false, false); return fmaxf(__uint_as_float(rr[0]), __uint_as_float(rr[1])); }
__device__ __forceinline__ float fwave_sum(float v) { v = dpp_row16_sum(v);
    return (__int_as_float(__builtin_amdgcn_readlane(__float_as_int(v), 0)) + __int_as_float(__builtin_amdgcn_readlane(__float_as_int(v), 16))) + (__int_as_float(__builtin_amdgcn_readlane(__float_as_int(v), 32)) + __int_as_float(__builtin_amdgcn_readlane(__float_as_int(v), 48))); }
__device__ __forceinline__ float bf2f(bf16 v) { return __uint_as_float((unsigned)v << 16); }
__device__ __forceinline__ unsigned pk2(float lo, float hi) { typedef float f2_ __attribute__((ext_vector_type(2))); typedef __bf16 b2_ __attribute__((ext_vector_type(2))); const f2_ v = {lo, hi}; return __builtin_bit_cast(unsigned, __builtin_convertvector(v, b2_)); }
__device__ __forceinline__ unsigned f2bf(float f) { return pk2(f, 0.f) & 0xffffu; }
__device__ __forceinline__ float rlane(float v, int l) { return __int_as_float(__builtin_amdgcn_readlane(__float_as_int(v), l)); }

__device__ __forceinline__ void transpose_item(const float* W, int ldw, int K, const float* gk, bf16* WT, int n_src0, int n_dst0, int k0, LAS float* scr, int lane) {
#pragma unroll 8
    for (int i = 0; i < 32; ++i) { const int kk = 2 * i + (lane >> 5); float v = W[(size_t)(k0 + kk) * ldw + n_src0 + (lane & 31)]; if (gk) v *= gk[k0 + kk]; scr[kk * 33 + (lane & 31)] = v; }
    asm volatile("s_waitcnt lgkmcnt(0)" ::: "memory");
    const int c = lane & 7;
#pragma unroll
    for (int j = 0; j < 4; ++j) { const int n = (lane >> 3) + 8 * j; const LAS float* s = scr + (8 * c) * 33 + n;
        v4u o; o.x = pk2(s[0 * 33], s[1 * 33]); o.y = pk2(s[2 * 33], s[3 * 33]); o.z = pk2(s[4 * 33], s[5 * 33]); o.w = pk2(s[6 * 33], s[7 * 33]);
        *(v4u*)(WT + (size_t)(n_dst0 + n) * K + k0 + 8 * c) = o; }
    asm volatile("s_waitcnt lgkmcnt(0)" ::: "memory");
}
__device__ __forceinline__ void load_wab(const Params& p, int l, LAS float* wab) {
    const float* W = p.w_in + (size_t)l * DM * INC; const float* g = p.pre_g + l * DM;
    for (int i = TIDX(); i < 8 * DM; i += NT) { const int k = i >> 3, j = i & 7; wab[j * DM + k] = W[(size_t)k * INC + 768 + j] * g[k]; }
}
__device__ __forceinline__ void row_prep(const float4 (&v)[4], int row, int lane, bf16* xb, float* rstd, float* ab, const LAS float* wab) {
    float ss = 0.f;
#pragma unroll
    for (int j = 0; j < 4; ++j) ss += v[j].x * v[j].x + v[j].y * v[j].y + v[j].z * v[j].z + v[j].w * v[j].w;
    ss = wave_sum(ss);
    const float rs = rsqrtf(ss * (1.0f / DM) + EPS);
    v2u* o8 = (v2u*)(xb + (size_t)row * DM) + lane;
#pragma unroll
    for (int j = 0; j < 4; ++j) { v2u w; w.x = pk2(v[j].x, v[j].y); w.y = pk2(v[j].z, v[j].w); o8[64 * j] = w; }
    float acc[8];
#pragma unroll
    for (int j8 = 0; j8 < 8; ++j8) { float a = 0.f;
#pragma unroll
        for (int j = 0; j < 4; ++j) { const f4 w = *(const LAS f4*)(wab + j8 * DM + 256 * j + 4 * lane); a += v[j].x * w.x + v[j].y * w.y + v[j].z * w.z + v[j].w * w.w; }
        acc[j8] = wave_sum(a); }
    if (lane == 0) { rstd[row] = rs;
        *(float4*)(ab + (size_t)row * 8) = make_float4(acc[0] * rs, acc[1] * rs, acc[2] * rs, acc[3] * rs);
        *(float4*)(ab + (size_t)row * 8 + 4) = make_float4(acc[4] * rs, acc[5] * rs, acc[6] * rs, acc[7] * rs); }
}

__device__ __forceinline__ void phase_prologue(const Params& p, LAS unsigned char* lds) {
    const int lane = TIDX() & 63, wave = TIDX() >> 6;
    LAS float* wab = (LAS float*)lds;
    load_wab(p, 0, wab);
    __syncthreads();
    LAS float* scr = (LAS float*)(lds + 32768 + wave * 12288);
    const int gw = BIDX() * NWAVES + wave, NGW = gridDim.x * NWAVES;
    bf16* win_t = (bf16*)(p.ws + WS_WIN); bf16* wout_t = (bf16*)(p.ws + WS_WOUT);
    constexpr int I_IN = (DM / 64) * (PC / 32), I_OUT = (DM / 64) * (DM / 32);
    for (int it = gw; it < DEPTH * (I_IN + I_OUT); it += NGW) {
        int r = it; const int l = r / (I_IN + I_OUT); r -= l * (I_IN + I_OUT);
        if (r < I_IN) { const int kb = r / (PC / 32), nb = r % (PC / 32), n0 = 32 * nb;
            transpose_item(p.w_in + (size_t)l * DM * INC, INC, DM, p.pre_g + l * DM, win_t + (size_t)l * PC * DM, n0 + (n0 >= 768 ? 8 : 0), n0, 64 * kb, scr, lane); }
        else { r -= I_IN; const int kb = r / (DM / 32), nb = r % (DM / 32);
            transpose_item(p.w_out + (size_t)l * DM * DM, DM, DM, nullptr, wout_t + (size_t)l * DM * DM, 32 * nb, 32 * nb, 64 * kb, scr, lane); }
    }
    bf16* xb = (bf16*)(p.ws + WS_XB); float* rstd = (float*)(p.ws + WS_RSTD); float* ab = (float*)(p.ws + WS_AB);
    for (int row = gw; row < NTOK; row += NGW) {
        const float4* xr = (const float4*)(p.x + (size_t)row * DM) + lane;
        float4 v[4];
#pragma unroll
        for (int j = 0; j < 4; ++j) v[j] = xr[64 * j];
        row_prep(v, row, lane, xb, rstd, ab, wab);
    }
}

__device__ __forceinline__ void phase_post(const Params& p, int l, LAS unsigned char* lds) {
    const int lane = TIDX() & 63, wave = TIDX() >> 6;
    LAS float* wab = (LAS float*)lds;
    const bool more = (l + 1 < DEPTH);
    if (more) load_wab(p, l + 1, wab);
    __syncthreads();
    const int gw = BIDX() * NWAVES + wave, NGW = gridDim.x * NWAVES;
    const float* xin = (l == 0) ? p.x : p.out;
    const float* g = p.post_g + l * DM;
    bf16* xb = (bf16*)(p.ws + WS_XB); float* rstd = (float*)(p.ws + WS_RSTD); float* ab = (float*)(p.ws + WS_AB);
    for (int row = gw; row < NTOK; row += NGW) {
        const v2u* yr = (const v2u*)((const bf16*)(p.ws + WS_PROJ) + (size_t)row * DM) + lane;
        const float4* xr = (const float4*)(xin + (size_t)row * DM) + lane;
        float4 v[4], xx[4]; float ss = 0.f;
#pragma unroll
        for (int j = 0; j < 4; ++j) { const v2u w = yr[64 * j]; xx[j] = xr[64 * j];
            v[j] = make_float4(__uint_as_float(w.x << 16), __uint_as_float(w.x & 0xffff0000u), __uint_as_float(w.y << 16), __uint_as_float(w.y & 0xffff0000u));
            ss += v[j].x * v[j].x + v[j].y * v[j].y + v[j].z * v[j].z + v[j].w * v[j].w; }
        ss = wave_sum(ss);
        const float rs = rsqrtf(ss * (1.0f / DM) + EPS);
        float4* orow = (float4*)(p.out + (size_t)row * DM) + lane;
#pragma unroll
        for (int j = 0; j < 4; ++j) { const float4 gg = ((const float4*)g)[lane + 64 * j];
            v[j] = make_float4(xx[j].x + v[j].x * rs * gg.x, xx[j].y + v[j].y * rs * gg.y, xx[j].z + v[j].z * rs * gg.z, xx[j].w + v[j].w * rs * gg.w);
            orow[64 * j] = v[j]; }
        if (more) row_prep(v, row, lane, xb, rstd, ab, wab);
    }
}


__device__ __forceinline__ float wave_sum(float v) { return fwave_sum(v); }
#define XB_TMO      128
#define XB_XCNT(j)  (256  + 64 * (j))
#define XB_XSUB(j)  (1280 + 64 * (j))
#define XB_XGEN(j)  (2304 + 64 * (j))
#define XB_TOP      3328
#define XB_TOPGEN   3392
#define XCD_BAR_WORDS 3456
#define XB_SPIN_CAP (1u << 18)

__device__ __forceinline__ unsigned xb_ld(unsigned* p)              { return __hip_atomic_load(p, __ATOMIC_RELAXED, __HIP_MEMORY_SCOPE_AGENT); }
__device__ __forceinline__ unsigned xb_add(unsigned* p, unsigned v) { return __hip_atomic_fetch_add(p, v, __ATOMIC_RELAXED, __HIP_MEMORY_SCOPE_AGENT); }
__device__ __forceinline__ unsigned xb_xcc_id() { return (unsigned)__builtin_amdgcn_s_getreg((3 << 11) | 20) & 0xFu; }
#define XB_SPIN(cond, bar) do { unsigned _sp = 0; while (cond) { __builtin_amdgcn_s_sleep(1); \
    if ((++_sp & 255u) == 0u) { if (xb_ld(&(bar)[XB_TMO])) break; if (_sp > XB_SPIN_CAP) { atomicAdd(&(bar)[XB_TMO], 1u); break; } } } } while (0)

struct XcdBarrier {
    unsigned* bar; unsigned x;
    volatile LAS unsigned* st;
};

__device__ __forceinline__ XcdBarrier xcd_barrier_post(unsigned* bar, volatile LAS unsigned* st) {
    XcdBarrier b; b.bar = bar; b.x = xb_xcc_id(); b.st = st;
    if (TIDX() == 0) (void)xb_add(&bar[XB_XCNT(b.x)], 1u);
    return b;
}
__device__ __forceinline__ void xcd_barrier_complete(unsigned* bar, unsigned x, unsigned& nloc, unsigned& nx) {
    const unsigned G = gridDim.x * gridDim.y * gridDim.z;
    unsigned sum, cnt, mine, sp = 0u;
    for (;;) {
        sum = 0u; cnt = 0u; mine = 0u;
#pragma unroll
        for (unsigned j = 0; j < 16; ++j) { const unsigned c = xb_ld(&bar[XB_XCNT(j)]); sum += c; cnt += (c > 0u) ? 1u : 0u; mine = (j == x) ? c : mine; }
        if (sum == G) break;
        __builtin_amdgcn_s_sleep(1);
        if ((++sp & 255u) == 0u) { if (xb_ld(&bar[XB_TMO])) break; if (sp > XB_SPIN_CAP) { atomicAdd(&bar[XB_TMO], 1u); break; } }
    }
    nloc = mine > 0u ? mine : 1u; nx = cnt > 0u ? cnt : 1u;
}

__device__ __forceinline__ void xcd_barrier(const XcdBarrier& b) {
    asm volatile("s_waitcnt vmcnt(0)" ::: "memory");
    __syncthreads();
    if (TIDX() == 0) {
        unsigned* bar = b.bar;
        __builtin_amdgcn_s_waitcnt(0);
        unsigned nloc = b.st[0], nx = b.st[1];
        if (nloc == 0u) { xcd_barrier_complete(bar, b.x, nloc, nx); b.st[0] = nloc; b.st[1] = nx; }
        const unsigned old = xb_add(&bar[XB_XSUB(b.x)], 1u);
        const unsigned gen = old / nloc;
        if (old + 1u == (gen + 1u) * nloc) {
            __builtin_amdgcn_fence(__ATOMIC_RELEASE, "agent");
            asm volatile("s_waitcnt vmcnt(0)" ::: "memory");
            const unsigned og = xb_add(&bar[XB_TOP], 1u);
            const unsigned tg = og / nx;
            if (og + 1u == (tg + 1u) * nx) xb_add(&bar[XB_TOPGEN], 1u);
            else XB_SPIN(xb_ld(&bar[XB_TOPGEN]) == tg, bar);
            __builtin_amdgcn_fence(__ATOMIC_ACQUIRE, "agent");
            xb_add(&bar[XB_XGEN(b.x)], 1u);
            asm volatile("s_waitcnt vmcnt(0)" ::: "memory");
        } else {
            XB_SPIN(xb_ld(&bar[XB_XGEN(b.x)]) == gen, bar);
            __builtin_amdgcn_fence(__ATOMIC_ACQUIRE, "agent");
            asm volatile("s_waitcnt vmcnt(0)" ::: "memory");
        }
    }
    __syncthreads();
}

namespace att {
typedef short bf16x8 __attribute__((ext_vector_type(8)));
typedef short s16x4 __attribute__((ext_vector_type(4)));
typedef float f32x16 __attribute__((ext_vector_type(16)));
constexpr int KCH = 1024, VOFF = 8192, BUFB = 16384, NSLOT = 4;
constexpr float NEG = -1e30f, LOG2E = 1.4426950408889634f;
__device__ __forceinline__ void glds16(const void* gsrc, unsigned lds_dst) { unsigned keep;
    asm volatile("s_mov_b32 %0, m0\n\ts_mov_b32 m0, %2\n\ts_nop 0\n\tglobal_load_lds_dwordx4 %1, off\n\ts_mov_b32 m0, %0" : "=&s"(keep) : "v"(gsrc), "s"(lds_dst) : "memory"); }
__device__ __forceinline__ unsigned cvtpk(float lo, float hi) { typedef float f2 __attribute__((ext_vector_type(2))); typedef __bf16 b2 __attribute__((ext_vector_type(2))); f2 v = {lo, hi}; b2 b = __builtin_convertvector(v, b2); return __builtin_bit_cast(unsigned, b); }
__device__ __forceinline__ s16x4 vtr(const LAS unsigned char* p) { return __builtin_bit_cast(s16x4, __builtin_amdgcn_ds_read_tr16_b64_v4i16((LAS s16x4*)p)); }
__device__ __forceinline__ unsigned scale_pk(unsigned w, float c) { return cvtpk(__uint_as_float(w << 16) * c, __uint_as_float(w & 0xffff0000u) * c); }
__device__ __forceinline__ float max16(const f32x16& a) {
    float m0 = fmaxf(fmaxf(a[0], a[1]), fmaxf(a[2], a[3])), m1 = fmaxf(fmaxf(a[4], a[5]), fmaxf(a[6], a[7]));
    float m2 = fmaxf(fmaxf(a[8], a[9]), fmaxf(a[10], a[11])), m3 = fmaxf(fmaxf(a[12], a[13]), fmaxf(a[14], a[15]));
    return fmaxf(fmaxf(m0, m1), fmaxf(m2, m3));
}

template <int MODE>
__device__ __forceinline__ void attn_unit(const Params& p, int l, int b, int h, int qb, LAS unsigned char* lds) {
    constexpr int NMAP = MODE == 0 ? 2 : 1, NKS = MODE == 0 ? 2 : 4;
    const int tid = TIDX(), lane = tid & 63, wid = __builtin_amdgcn_readfirstlane(tid >> 6), r32 = lane & 31, hi = lane >> 5;
    const bf16* P = (const bf16*)(p.ws + WS_PROJ) + (size_t)b * SEQ * PC;
    const int QC = (MODE == 0 ? C_DQ : C_MQ) + h * 64, KC = (MODE == 0 ? C_DK : C_MK) + h * 64, VC = (MODE == 0 ? C_DV : C_MV) + h * 64, ZC = (MODE == 0 ? C_DZ : C_MZ) + h * 64;
    const float slope = exp2f(-(float)(MODE == 0 ? 2 * h + 1 : 2 * h + 2));
    const float sl2 = slope * LOG2E;
    const float c1 = (MODE == 0 ? 0.17677669529663687f : 0.125f) * LOG2E;
    const int q0 = qb * 256 + wid * 32, qpos = q0 + r32;
    bf16x8 qf[NMAP][NKS];
#pragma unroll
    for (int mp = 0; mp < NMAP; ++mp)
#pragma unroll
        for (int ks = 0; ks < NKS; ++ks) { const v4u raw = *(const v4u*)(P + (size_t)qpos * PC + QC + mp * 32 + ks * 16 + hi * 8);
            v4u s; s.x = scale_pk(raw.x, c1); s.y = scale_pk(raw.y, c1); s.z = scale_pk(raw.z, c1); s.w = scale_pk(raw.w, c1); qf[mp][ks] = __builtin_bit_cast(bf16x8, s); }
    const bf16* zrow = P + (size_t)qpos * PC + ZC;
    v2u zpre[2][4];
#pragma unroll
    for (int d = 0; d < 2; ++d)
#pragma unroll
        for (int g4 = 0; g4 < 4; ++g4) zpre[d][g4] = *(const v2u*)(zrow + d * 32 + 8 * g4 + 4 * hi);
    unsigned sel = 0;
    if (MODE == 1) {
        const float* km = (const float*)(p.ws + WS_KMEAN) + (size_t)((b * NH + h) * 8) * 256;
        LAS float* kml = (LAS float*)(lds + NSLOT * BUFB + 64);
        __syncthreads();
        if (tid < qb * 64) { const int jj = tid >> 6, dd = tid & 63; kml[tid] = (km[jj * 256 + dd] + km[jj * 256 + 64 + dd]) + (km[jj * 256 + 128 + dd] + km[jj * 256 + 192 + dd]); }
        __syncthreads();
        float g[7];
#pragma unroll
        for (int j = 0; j < 7; ++j) { g[j] = -INFINITY;
            if (j < qb) { float s = 0.f;
#pragma unroll
                for (int ks = 0; ks < NKS; ++ks) { const v4u qq = __builtin_bit_cast(v4u, qf[0][ks]); const f4 k0 = *(const LAS f4*)(kml + j * 64 + ks * 16 + hi * 8), k1 = *(const LAS f4*)(kml + j * 64 + ks * 16 + hi * 8 + 4);
                    s += __uint_as_float(qq.x << 16) * k0.x + __uint_as_float(qq.x & 0xffff0000u) * k0.y + __uint_as_float(qq.y << 16) * k0.z + __uint_as_float(qq.y & 0xffff0000u) * k0.w
                       + __uint_as_float(qq.z << 16) * k1.x + __uint_as_float(qq.z & 0xffff0000u) * k1.y + __uint_as_float(qq.w << 16) * k1.z + __uint_as_float(qq.w & 0xffff0000u) * k1.w; }
                g[j] = xor32_sum(s); } }
#pragma unroll
        for (int r = 0; r < 3; ++r) { float best = -INFINITY; int bi = -1;
#pragma unroll
            for (int j = 0; j < 7; ++j) if (j < qb && !((sel >> j) & 1u) && g[j] > best) { best = g[j]; bi = j; }
            if (bi >= 0) sel |= 1u << bi; }
    }
    f32x16 cr;
#pragma unroll
    for (int r = 0; r < 16; ++r) cr[r] = sl2 * (float)((r & 3) + 8 * (r >> 2) + 4 * hi);
    const bf16* ksrc = P + (size_t)lane * PC + KC + wid * 8;
    const bf16* vsrc = P + (size_t)(16 * (wid & 3) + (lane >> 2)) * PC + VC + (wid >> 2) * 32 + (lane & 3) * 8;
    const int kdst = wid * 1024, vdst = VOFF + wid * 1024;
    const unsigned lds0 = (unsigned)(uintptr_t)lds;
#define ATT_DMA(T_) do { const unsigned sl_ = lds0 + (unsigned)(((T_) & (NSLOT - 1)) * BUFB); \
        glds16(ksrc + (size_t)(T_) * 64 * PC, (unsigned)__builtin_amdgcn_readfirstlane(sl_ + kdst)); \
        glds16(vsrc + (size_t)(T_) * 64 * PC, (unsigned)__builtin_amdgcn_readfirstlane(sl_ + vdst)); } while (0)
    const int koff = hi * KCH + r32 * 16;
    const int voff = VOFF + ((lane >> 4) & 1) * 32 + (lane & 3) * 8 + (4 * hi + ((lane & 15) >> 2)) * 64;
    f32x16 O[NMAP][2];
    float m[NMAP], lsum[NMAP];
#pragma unroll
    for (int mp = 0; mp < NMAP; ++mp) { m[mp] = NEG; lsum[mp] = 0.f;
#pragma unroll
        for (int d = 0; d < 2; ++d)
#pragma unroll
            for (int r = 0; r < 16; ++r) O[mp][d][r] = 0.f; }
    const int Tlast = 4 * qb + 3;
    __syncthreads();
    ATT_DMA(Tlast); ATT_DMA(Tlast - 1); ATT_DMA(Tlast - 2);
    for (int T = Tlast; T >= 0; --T) {
        if (T >= 2) asm volatile("s_waitcnt vmcnt(4)" ::: "memory"); else if (T == 1) asm volatile("s_waitcnt vmcnt(2)" ::: "memory"); else asm volatile("s_waitcnt vmcnt(0)" ::: "memory");
        __builtin_amdgcn_s_barrier();
        asm volatile("" ::: "memory");
        if (T >= 3) ATT_DMA(T - 3);
        const LAS unsigned char* kb = lds + (T & (NSLOT - 1)) * BUFB;
        bool selq = true; bool work = (64 * T <= q0 + 31);
        if (MODE == 1) { const int j = T >> 2; if (j < qb) { selq = (sel >> j) & 1u; work = work && __any(selq); } }
        if (work) {
            const bool diag = (64 * T + 63 > q0);
            const float tb0 = sl2 * (float)(64 * T - qb * 256), tb1 = tb0 + 32.f * sl2;
            unsigned pk[NMAP][2][2][4];
#pragma unroll
            for (int mp = 0; mp < NMAP; ++mp) {
                f32x16 u0 = cr, u1 = cr;
#pragma unroll
                for (int ks = 0; ks < NKS; ++ks) { const int cb = ((MODE == 0 ? 4 * mp : 0) + 2 * ks) * KCH;
                    const bf16x8 k0 = *(const LAS bf16x8*)(kb + koff + cb), k1 = *(const LAS bf16x8*)(kb + koff + cb + 512);
                    u0 = __builtin_amdgcn_mfma_f32_32x32x16_bf16(k0, qf[mp][ks], u0, 0, 0, 0);
                    u1 = __builtin_amdgcn_mfma_f32_32x32x16_bf16(k1, qf[mp][ks], u1, 0, 0, 0); }
                if (diag) { const int thr = qpos - 64 * T - 4 * hi;
#pragma unroll
                    for (int r = 0; r < 16; ++r) { const int c = (r & 3) + 8 * (r >> 2); if (c > thr) u0[r] = NEG; if (c + 32 > thr) u1[r] = NEG; } }
                float mu = fmaxf(max16(u0) + tb0, max16(u1) + tb1);
                if (MODE == 1) { if (!selq) mu = NEG; }
                mu = xor32_max(mu);
                const float mn = fmaxf(m[mp], mu);
                if (!__all(mn == m[mp])) { const float al = __builtin_amdgcn_exp2f(m[mp] - mn); lsum[mp] *= al;
#pragma unroll
                    for (int d = 0; d < 2; ++d)
#pragma unroll
                        for (int r = 0; r < 16; ++r) O[mp][d][r] *= al;
                    m[mp] = mn; }
                float ms0 = mn - tb0, ms1 = mn - tb1;
                if (MODE == 1) { if (!selq) { ms0 = 1e30f; ms1 = 1e30f; } }
                float ls = 0.f;
#pragma unroll
                for (int r = 0; r < 16; ++r) { u0[r] = __builtin_amdgcn_exp2f(u0[r] - ms0); u1[r] = __builtin_amdgcn_exp2f(u1[r] - ms1); ls += u0[r] + u1[r]; }
                lsum[mp] += ls;
#pragma unroll
                for (int s = 0; s < 2; ++s)
#pragma unroll
                    for (int i = 0; i < 4; ++i) { pk[mp][0][s][i] = cvtpk(u0[8 * s + 2 * i], u0[8 * s + 2 * i + 1]); pk[mp][1][s][i] = cvtpk(u1[8 * s + 2 * i], u1[8 * s + 2 * i + 1]); }
            }
#pragma unroll
            for (int d = 0; d < 2; ++d)
#pragma unroll
                for (int kh = 0; kh < 2; ++kh)
#pragma unroll
                    for (int s = 0; s < 2; ++s) {
                        const s16x4 lo = vtr(kb + voff + d * 4096 + kh * 2048 + s * 1024), hh = vtr(kb + voff + d * 4096 + kh * 2048 + s * 1024 + 512);
                        const bf16x8 vf = (bf16x8){lo[0], lo[1], lo[2], lo[3], hh[0], hh[1], hh[2], hh[3]};
#pragma unroll
                        for (int mp = 0; mp < NMAP; ++mp) { const v4u pw = {pk[mp][kh][s][0], pk[mp][kh][s][1], pk[mp][kh][s][2], pk[mp][kh][s][3]};
                            O[mp][d] = __builtin_amdgcn_mfma_f32_32x32x16_bf16(vf, __builtin_bit_cast(bf16x8, pw), O[mp][d], 0, 0, 0); }
                    }
        }
        asm volatile("s_waitcnt lgkmcnt(0)" ::: "memory");
    }
#undef ATT_DMA
    bf16* yrow = (bf16*)(p.ws + WS_Y) + ((size_t)b * SEQ + qpos) * DM + (MODE == 0 ? 768 : 512) + h * 64;
    if (MODE == 0) {
        const LAS float* cst = (const LAS float*)(lds + NSLOT * BUFB + 4096);
        const float lam = cst[0], lam_init = cst[1];
        const float l0 = xor32_sum(lsum[0]), l1 = xor32_sum(lsum[NMAP - 1]);
        const float i0 = 1.0f / l0, i1 = lam / l1;
        float ss = 0.f;
#pragma unroll
        for (int d = 0; d < 2; ++d)
#pragma unroll
            for (int r = 0; r < 16; ++r) { const float o = O[0][d][r] * i0 - O[NMAP - 1][d][r] * i1; O[0][d][r] = o; ss += o * o; }
        ss = xor32_sum(ss);
        const float rs = rsqrtf(ss * (1.0f / 64.0f) + EPS) * (1.0f - lam_init);
#pragma unroll
        for (int d = 0; d < 2; ++d)
#pragma unroll
            for (int g4 = 0; g4 < 4; ++g4) { const int dd = d * 32 + 8 * g4 + 4 * hi;
                const f4 gn = *(const LAS f4*)(cst + 16 + dd); const v2u z = zpre[d][g4];
                const float z0 = __uint_as_float(z.x << 16), z1 = __uint_as_float(z.x & 0xffff0000u), z2 = __uint_as_float(z.y << 16), z3 = __uint_as_float(z.y & 0xffff0000u);
                v2u w; w.x = cvtpk(O[0][d][4 * g4] * rs * gn.x * fsilu(z0), O[0][d][4 * g4 + 1] * rs * gn.y * fsilu(z1));
                w.y = cvtpk(O[0][d][4 * g4 + 2] * rs * gn.z * fsilu(z2), O[0][d][4 * g4 + 3] * rs * gn.w * fsilu(z3));
                *(v2u*)(yrow + dd) = w; }
    } else {
        const float l0 = xor32_sum(lsum[0]);
        const float i0 = 1.0f / l0;
#pragma unroll
        for (int d = 0; d < 2; ++d)
#pragma unroll
            for (int g4 = 0; g4 < 4; ++g4) { const int dd = d * 32 + 8 * g4 + 4 * hi;
                const v2u z = zpre[d][g4];
                const float z0 = __uint_as_float(z.x << 16), z1 = __uint_as_float(z.x & 0xffff0000u), z2 = __uint_as_float(z.y << 16), z3 = __uint_as_float(z.y & 0xffff0000u);
                v2u w; w.x = cvtpk(O[0][d][4 * g4] * i0 * fsilu(z0), O[0][d][4 * g4 + 1] * i0 * fsilu(z1));
                w.y = cvtpk(O[0][d][4 * g4 + 2] * i0 * fsilu(z2), O[0][d][4 * g4 + 3] * i0 * fsilu(z3));
                *(v2u*)(yrow + dd) = w; }
    }
}
}

__device__ __forceinline__ void phase_attn_mfma(const Params& p, int l, LAS unsigned char* lds) {
    for (int c = BIDX(); c < NB * NH * 4; c += gridDim.x) {
        const int bh = c >> 2, s = c & 3, b = bh >> 2, h = bh & 3;
        att::attn_unit<0>(p, l, b, h, 7 - s, lds);
        att::attn_unit<1>(p, l, b, h, 7 - s, lds);
        att::attn_unit<0>(p, l, b, h, s, lds);
        att::attn_unit<1>(p, l, b, h, s, lds);
    }
}

namespace scn {
typedef short bf16x8 __attribute__((ext_vector_type(8)));
typedef float f32x4 __attribute__((ext_vector_type(4)));
constexpr size_t CH_QT = 64 * 64 * 2, CH_OI = 64 * 64 * 2, CH_SL = 64 * 64 * 4, CH_M = 64 * 64 * 2, CH_DL = 64 * 4;
constexpr int NCH = NB * NH * 32;
constexpr size_t A_GST = 0, A_HST = 16 * MiB, A_GQT = 32 * MiB, A_HQT = 48 * MiB;
constexpr size_t B_GSL = 0, B_HSL = 32 * MiB, B_GMF = 64 * MiB, B_HDL = 96 * MiB;

__device__ __forceinline__ f32x4 mfma16(bf16x8 a, bf16x8 b, f32x4 c) { f32x4 r = __builtin_amdgcn_mfma_f32_16x16x32_bf16(a, b, c, 0, 0, 0); asm volatile("" : "+v"(r) : "v"(a), "v"(b)); return r; }
__device__ __forceinline__ float f_hi(float x) { return __uint_as_float(f2bf(x) << 16); }

template <int PART>
__device__ __forceinline__ void gdn_pre(const Params& p, int l, int item, LAS float* wl) {
    const int lane = TIDX() & 63, half = lane >> 5, j = lane & 31;
    const int ci = item >> 1, cb = (item & 1) * 32;
    const int b = ci >> 7, h = (ci >> 5) & 3, n = ci & 31, t0 = n * 64;
    const bf16* P = (const bf16*)(p.ws + WS_PROJ) + (size_t)b * SEQ * PC;
    const float* AB = (const float*)(p.ws + WS_AB) + (size_t)b * SEQ * 8;
    const float* cw = p.conv_w + (size_t)l * 4 * 768;
    const int cq_ = C_GQ + h * 64 + lane, ck_ = C_GK + h * 64 + lane, cv_ = C_GV + h * 64 + cb + j;
    float wq[4], wk[4], wv[4];
#pragma unroll
    for (int i = 0; i < 4; ++i) { wq[i] = cw[i * 768 + 0 + h * 64 + lane]; wk[i] = cw[i * 768 + 256 + h * 64 + lane]; wv[i] = cw[i * 768 + 512 + h * 64 + cb + j]; }
    const float Aexp = expf(p.a_log[l * NH + h]), dtb = p.dt_bias[l * NH + h];
    float xq[3] = {0.f, 0.f, 0.f}, xk[3] = {0.f, 0.f, 0.f}, xv[3] = {0.f, 0.f, 0.f};
    if (t0 > 0) {
#pragma unroll
        for (int i = 0; i < 3; ++i) { const bf16* pr = P + (size_t)(t0 - 3 + i) * PC; xq[i] = bf2f(pr[cq_]); xk[i] = bf2f(pr[ck_]); if (PART == 0) xv[i] = bf2f(pr[cv_]); }
    }
    float S[32];
#pragma unroll
    for (int i = 0; i < 32; ++i) S[i] = (PART == 1 && (32 * half + i) == (cb + j)) ? 1.f : 0.f;
    bf16* OI = (bf16*)(p.ws + WS_Y) + ((size_t)b * SEQ + t0) * DM + 0 + h * 64;
    bf16* QT = (bf16*)(p.ws + WS_XB + A_GQT + (size_t)ci * CH_QT);
    const LAS float* wk_ = wl + 32 * half; const LAS float* wq_ = wl + 64 + 32 * half;
    float nq, nk, nv = 0.f, na, nb;
    { const bf16* pr = P + (size_t)t0 * PC; nq = bf2f(pr[cq_]); nk = bf2f(pr[ck_]); if (PART == 0) nv = bf2f(pr[cv_]); na = AB[t0 * 8 + h]; nb = AB[t0 * 8 + 4 + h]; }
#pragma unroll 1
    for (int t = 0; t < 64; ++t) {
        const float cq = nq, ck = nk, cv = nv, ca = na, cb2 = nb;
        if (t + 1 < 64) { const bf16* pr = P + (size_t)(t0 + t + 1) * PC; nq = bf2f(pr[cq_]); nk = bf2f(pr[ck_]); if (PART == 0) nv = bf2f(pr[cv_]); na = AB[(t0 + t + 1) * 8 + h]; nb = AB[(t0 + t + 1) * 8 + 4 + h]; }
        float qc = wq[0] * xq[0] + wq[1] * xq[1] + wq[2] * xq[2] + wq[3] * cq;
        float kc = wk[0] * xk[0] + wk[1] * xk[1] + wk[2] * xk[2] + wk[3] * ck;
        xq[0] = xq[1]; xq[1] = xq[2]; xq[2] = cq; xk[0] = xk[1]; xk[1] = xk[2]; xk[2] = ck;
        float vc = 0.f;
        if (PART == 0) { vc = wv[0] * xv[0] + wv[1] * xv[1] + wv[2] * xv[2] + wv[3] * cv; xv[0] = xv[1]; xv[1] = xv[2]; xv[2] = cv; vc = fsilu(vc); }
        qc = fsilu(qc); kc = fsilu(kc);
        const float qss = fwave_sum(qc * qc), kss = fwave_sum(kc * kc);
        const float qn = qc * __builtin_amdgcn_rsqf(qss + EPS) * 0.125f, kn = kc * __builtin_amdgcn_rsqf(kss + EPS);
        const float g = -Aexp * fsoftplus(ca + dtb), beta = fsigmoid(cb2), eg = fexp(g);
        asm volatile("s_waitcnt lgkmcnt(0)" ::: "memory");
        wl[lane] = kn; wl[64 + lane] = qn;
        asm volatile("s_waitcnt lgkmcnt(0)" ::: "memory");
        float ks0 = 0.f, ks1 = 0.f, ks2 = 0.f, ks3 = 0.f;
#pragma unroll
        for (int i = 0; i < 32; i += 4) { const f4 k4 = *(const LAS f4*)(wk_ + i);
            S[i] *= eg; S[i + 1] *= eg; S[i + 2] *= eg; S[i + 3] *= eg;
            ks0 += k4.x * S[i]; ks1 += k4.y * S[i + 1]; ks2 += k4.z * S[i + 2]; ks3 += k4.w * S[i + 3]; }
        const float kS = xor32_sum((ks0 + ks1) + (ks2 + ks3));
        const float vn = beta * (vc - kS);
        float o0 = 0.f, o1 = 0.f, o2 = 0.f, o3 = 0.f;
#pragma unroll
        for (int i = 0; i < 32; i += 4) { const f4 k4 = *(const LAS f4*)(wk_ + i); const f4 q4 = *(const LAS f4*)(wq_ + i);
            S[i] += k4.x * vn; S[i + 1] += k4.y * vn; S[i + 2] += k4.z * vn; S[i + 3] += k4.w * vn;
            o0 += q4.x * S[i]; o1 += q4.y * S[i + 1]; o2 += q4.z * S[i + 2]; o3 += q4.w * S[i + 3]; }
        const float o = xor32_sum((o0 + o1) + (o2 + o3));
        if (half == 0) { if (PART == 1) QT[t * 64 + cb + j] = (bf16)f2bf(o); else OI[(size_t)t * DM + cb + j] = (bf16)f2bf(o); }
    }
    if (PART == 0) {
        float* SL = (float*)(p.ws + WS_SCR + B_GSL + (size_t)ci * CH_SL) + (cb + j) * 64 + 32 * half;
#pragma unroll
        for (int i = 0; i < 32; i += 4) *(float4*)(SL + i) = make_float4(S[i], S[i + 1], S[i + 2], S[i + 3]);
    } else {
        float* MF = (float*)(p.ws + WS_SCR + B_GMF + (size_t)ci * CH_SL) + (32 * half) * 64 + cb + j;
#pragma unroll
        for (int i = 0; i < 32; ++i) { MF[i * 64] = S[i]; if ((i & 7) == 7) asm volatile("" ::: "memory"); }
    }
}

__device__ __forceinline__ void hgrn_pre(const Params& p, int l, int ci, LAS float* wl) {
    const int lane = TIDX() & 63;
    const int b = ci >> 7, h = (ci >> 5) & 3, n = ci & 31, t0 = n * 64;
    const bf16* P = (const bf16*)(p.ws + WS_PROJ) + (size_t)b * SEQ * PC;
    float lb = 0.f;
    if (l == 1) { const float a0 = p.hgrn_lb[h * 64 + lane], a1 = p.hgrn_lb[GW + h * 64 + lane]; lb = 1.0f / (1.0f + expf(a0 - a1)); }
    float S[64];
#pragma unroll
    for (int d = 0; d < 64; ++d) S[d] = 0.f;
    float gam = 1.f;
    bf16* OI = (bf16*)(p.ws + WS_Y) + ((size_t)b * SEQ + t0) * DM + 256 + h * 64;
    bf16* QT = (bf16*)(p.ws + WS_XB + A_HQT + (size_t)ci * CH_QT);
    float nq, nf, nv;
    { const bf16* pr = P + (size_t)t0 * PC; nq = bf2f(pr[C_HQ + h * 64 + lane]); nf = bf2f(pr[C_HF + h * 64 + lane]); nv = bf2f(pr[C_HI + h * 64 + lane]); }
#pragma unroll 1
    for (int t = 0; t < 64; ++t) {
        const float cq = nq, cf = nf, vi = nv;
        if (t + 1 < 64) { const bf16* pr = P + (size_t)(t0 + t + 1) * PC; nq = bf2f(pr[C_HQ + h * 64 + lane]); nf = bf2f(pr[C_HF + h * 64 + lane]); nv = bf2f(pr[C_HI + h * 64 + lane]); }
        const float sg = fsigmoid(cf);
        const float fg = lb + (1.0f - lb) * sg;
        const float kk = (1.0f - lb) * (1.0f - sg);
        const float qq = fsilu(cq);
        gam *= fg;
        QT[t * 64 + lane] = (bf16)f2bf(qq * gam);
        asm volatile("s_waitcnt lgkmcnt(0)" ::: "memory");
        wl[lane] = fg; wl[64 + lane] = kk; wl[128 + lane] = qq;
        asm volatile("s_waitcnt lgkmcnt(0)" ::: "memory");
        float o0 = 0.f, o1 = 0.f, o2 = 0.f, o3 = 0.f;
#pragma unroll
        for (int d = 0; d < 64; d += 4) { const f4 f4_ = *(const LAS f4*)(wl + d); const f4 k4 = *(const LAS f4*)(wl + 64 + d); const f4 q4 = *(const LAS f4*)(wl + 128 + d);
            S[d] = f4_.x * S[d] + k4.x * vi; S[d + 1] = f4_.y * S[d + 1] + k4.y * vi; S[d + 2] = f4_.z * S[d + 2] + k4.z * vi; S[d + 3] = f4_.w * S[d + 3] + k4.w * vi;
            o0 += q4.x * S[d]; o1 += q4.y * S[d + 1]; o2 += q4.z * S[d + 2]; o3 += q4.w * S[d + 3]; }
        const float o = (o0 + o1) + (o2 + o3);
        OI[(size_t)t * DM + lane] = (bf16)f2bf(o);
    }
    float* SL = (float*)(p.ws + WS_SCR + B_HSL + (size_t)ci * CH_SL) + lane * 64;
#pragma unroll
    for (int d = 0; d < 64; d += 4) *(float4*)(SL + d) = make_float4(S[d], S[d + 1], S[d + 2], S[d + 3]);
    ((float*)(p.ws + WS_SCR + B_HDL + (size_t)ci * CH_DL))[lane] = gam;
}

__device__ __forceinline__ void kmean_item(const Params& p, int it) {
    const int lane = TIDX() & 63;
    const bf16* proj = (const bf16*)(p.ws + WS_PROJ); float* kmean = (float*)(p.ws + WS_KMEAN);
    const int sub = it & 3, j = (it >> 2) & 7, h = (it >> 5) & 3, b = it >> 7;
    const bf16* base = proj + ((size_t)b * SEQ + j * 256 + sub * 64) * PC + C_MK + h * 64 + lane;
    float acc[4] = {0.f, 0.f, 0.f, 0.f};
#pragma unroll
    for (int r0 = 0; r0 < 64; r0 += 16) { bf16 v[16];
#pragma unroll
        for (int i = 0; i < 16; ++i) v[i] = base[(size_t)(r0 + i) * PC];
#pragma unroll
        for (int i = 0; i < 16; ++i) acc[i & 3] += bf2f(v[i]); }
    kmean[(size_t)it * 64 + lane] = ((acc[0] + acc[1]) + (acc[2] + acc[3])) * (1.0f / 256.0f);
}

__device__ __forceinline__ void phase_pre(const Params& p, int l, LAS unsigned char* lds) {
    const int wave = TIDX() >> 6;
    LAS float* wl = (LAS float*)(lds + wave * 1024);
    const int gw = BIDX() * NWAVES + wave, NGW = gridDim.x * NWAVES;
    constexpr int N_G = 2 * NCH, N_H = NCH, N_K = NB * NH * 8;
    for (int it = gw; it < 2 * NCH; it += NGW) gdn_pre<1>(p, l, it, wl);
    for (int it = gw; it < 2 * NCH; it += NGW) gdn_pre<0>(p, l, it, wl);
    for (int it = gw; it < NCH; it += NGW) hgrn_pre(p, l, it, wl);
    for (int it = gw; it < N_K; it += NGW) kmean_item(p, it);
}

template <int KIND>
__device__ __forceinline__ void scan_unit(const Params& p, int l, int sp) {
    const int tid = TIDX(), lane = tid & 63, wid = __builtin_amdgcn_readfirstlane(tid >> 6), seq = wid >> 2, sl = wid & 3, c15 = lane & 15, g = lane >> 4;
    const int bh = sp * 2 + seq, dv = 16 * sl + c15;
    f32x4 S[4];
#pragma unroll
    for (int rb = 0; rb < 4; ++rb) S[rb] = (f32x4){0.f, 0.f, 0.f, 0.f};
    const unsigned char* SLb = p.ws + WS_SCR + (KIND == 0 ? B_GSL : B_HSL) + (size_t)bh * 32 * CH_SL;
    const unsigned char* MFb = p.ws + WS_SCR + B_GMF + (size_t)bh * 32 * CH_SL;
    const unsigned char* DLb = p.ws + WS_SCR + B_HDL + (size_t)bh * 32 * CH_DL;
    unsigned char* STb = p.ws + WS_XB + (KIND == 0 ? A_GST : A_HST) + (size_t)bh * 32 * CH_QT;
    float4 nsl[4], nm[KIND == 0 ? 16 : 4];
#define SCN_LOAD(n_) do { const float* SL_ = (const float*)(SLb + (size_t)(n_) * CH_SL); \
        _Pragma("unroll") for (int rb = 0; rb < 4; ++rb) nsl[rb] = *(const float4*)(SL_ + dv * 64 + 16 * rb + 4 * g); \
        if (KIND == 0) { const float* MF_ = (const float*)(MFb + (size_t)(n_) * CH_SL); \
            _Pragma("unroll") for (int rb = 0; rb < 4; ++rb) _Pragma("unroll") for (int ks = 0; ks < 2; ++ks) { const int off = (16 * rb + c15) * 64 + 32 * ks + 4 * g; \
                nm[(rb * 2 + ks) * 2] = *(const float4*)(MF_ + off); nm[(rb * 2 + ks) * 2 + 1] = *(const float4*)(MF_ + off + 16); } } \
        else { const float* DL_ = (const float*)(DLb + (size_t)(n_) * CH_DL); _Pragma("unroll") for (int rb = 0; rb < 4; ++rb) nm[rb] = *(const float4*)(DL_ + 16 * rb + 4 * g); } } while (0)
    SCN_LOAD(0);
#pragma unroll 1
    for (int n = 0; n < 32; ++n) {
        float4 csl[4], cm[KIND == 0 ? 16 : 4];
#pragma unroll
        for (int i = 0; i < 4; ++i) csl[i] = nsl[i];
#pragma unroll
        for (int i = 0; i < (KIND == 0 ? 16 : 4); ++i) cm[i] = nm[i];
        if (n + 1 < 32) SCN_LOAD(n + 1);
        bf16* ST = (bf16*)(STb + (size_t)n * CH_QT) + dv * 64 + 4 * g;
#pragma unroll
        for (int rb = 0; rb < 4; ++rb) { v2u w; w.x = pk2(S[rb][0], S[rb][1]); w.y = pk2(S[rb][2], S[rb][3]); *(v2u*)(ST + 16 * rb) = w; }
        if (KIND == 0) {
            bf16x8 Bh[2], Bl[2];
#pragma unroll
            for (int ks = 0; ks < 2; ++ks) { const f32x4 a = S[2 * ks], c = S[2 * ks + 1];
                v4u w; w.x = pk2(a[0], a[1]); w.y = pk2(a[2], a[3]); w.z = pk2(c[0], c[1]); w.w = pk2(c[2], c[3]); Bh[ks] = __builtin_bit_cast(bf16x8, w);
                v4u x; x.x = pk2(a[0] - f_hi(a[0]), a[1] - f_hi(a[1])); x.y = pk2(a[2] - f_hi(a[2]), a[3] - f_hi(a[3])); x.z = pk2(c[0] - f_hi(c[0]), c[1] - f_hi(c[1])); x.w = pk2(c[2] - f_hi(c[2]), c[3] - f_hi(c[3])); Bl[ks] = __builtin_bit_cast(bf16x8, x); }
#pragma unroll
            for (int rb = 0; rb < 4; ++rb) { f32x4 acc = (f32x4){csl[rb].x, csl[rb].y, csl[rb].z, csl[rb].w};
#pragma unroll
                for (int ks = 0; ks < 2; ++ks) { const float4 m0 = cm[(rb * 2 + ks) * 2], m1 = cm[(rb * 2 + ks) * 2 + 1];
                    v4u hw, lw;
                    hw.x = pk2(m0.x, m0.y); hw.y = pk2(m0.z, m0.w); hw.z = pk2(m1.x, m1.y); hw.w = pk2(m1.z, m1.w);
                    lw.x = pk2(m0.x - f_hi(m0.x), m0.y - f_hi(m0.y)); lw.y = pk2(m0.z - f_hi(m0.z), m0.w - f_hi(m0.w)); lw.z = pk2(m1.x - f_hi(m1.x), m1.y - f_hi(m1.y)); lw.w = pk2(m1.z - f_hi(m1.z), m1.w - f_hi(m1.w));
                    acc = mfma16(__builtin_bit_cast(bf16x8, lw), Bh[ks], acc);
                    acc = mfma16(__builtin_bit_cast(bf16x8, hw), Bl[ks], acc);
                    acc = mfma16(__builtin_bit_cast(bf16x8, hw), Bh[ks], acc); }
                csl[rb] = make_float4(acc[0], acc[1], acc[2], acc[3]); }
#pragma unroll
            for (int rb = 0; rb < 4; ++rb) S[rb] = (f32x4){csl[rb].x, csl[rb].y, csl[rb].z, csl[rb].w};
        } else {
#pragma unroll
            for (int rb = 0; rb < 4; ++rb) S[rb] = (f32x4){cm[rb].x * S[rb][0] + csl[rb].x, cm[rb].y * S[rb][1] + csl[rb].y, cm[rb].z * S[rb][2] + csl[rb].z, cm[rb].w * S[rb][3] + csl[rb].w};
        }
    }
#undef SCN_LOAD
}

__device__ __forceinline__ float row16_sum(float v) {
    v += __int_as_float(__builtin_amdgcn_update_dpp(0, __float_as_int(v), 0xB1, 0xF, 0xF, true));
    v += __int_as_float(__builtin_amdgcn_update_dpp(0, __float_as_int(v), 0x4E, 0xF, 0xF, true));
    v += __int_as_float(__builtin_amdgcn_update_dpp(0, __float_as_int(v), 0x141, 0xF, 0xF, true));
    v += __int_as_float(__builtin_amdgcn_update_dpp(0, __float_as_int(v), 0x140, 0xF, 0xF, true));
    return v;
}

template <int KIND>
__device__ __forceinline__ void out_item(const Params& p, int l, int ci, bool dry) {
    const int lane = TIDX() & 63, c15 = lane & 15, g = lane >> 4;
    const int b = ci >> 7, h = (ci >> 5) & 3, n = ci & 31, t0 = n * 64;
    const bf16* P = (const bf16*)(p.ws + WS_PROJ) + ((size_t)b * SEQ + t0) * PC + (KIND == 0 ? C_GZ : C_HZ) + h * 64;
    bf16* Y = (bf16*)(p.ws + WS_Y) + ((size_t)b * SEQ + t0) * DM + (KIND == 0 ? 0 : 256) + h * 64;
    const bf16* QT = (const bf16*)(p.ws + WS_XB + (KIND == 0 ? A_GQT : A_HQT) + (size_t)ci * CH_QT);
    const bf16* ST = (const bf16*)(p.ws + WS_XB + (KIND == 0 ? A_GST : A_HST) + (size_t)ci * CH_QT);
    const float* ngp = (KIND == 0 ? p.gdn_g : p.hgrn_g) + l * HD;
    bf16x8 Bf[4][2];
#pragma unroll
    for (int cbk = 0; cbk < 4; ++cbk)
#pragma unroll
        for (int ks = 0; ks < 2; ++ks) Bf[cbk][ks] = *(const bf16x8*)(ST + (16 * cbk + c15) * 64 + 32 * ks + 8 * g);
    float ng[4];
#pragma unroll
    for (int cbk = 0; cbk < 4; ++cbk) ng[cbk] = ngp[16 * cbk + c15];
#pragma unroll 1
    for (int rb = 0; rb < 4; ++rb) {
        bf16x8 Af[2];
#pragma unroll
        for (int ks = 0; ks < 2; ++ks) Af[ks] = *(const bf16x8*)(QT + (16 * rb + c15) * 64 + 32 * ks + 8 * g);
        f32x4 o[4]; float zz[4][4];
#pragma unroll
        for (int cbk = 0; cbk < 4; ++cbk) {
            const bf16* yi = Y + (size_t)(16 * rb + 4 * g) * DM + 16 * cbk + c15; const bf16* zi = P + (size_t)(16 * rb + 4 * g) * PC + 16 * cbk + c15;
            o[cbk] = (f32x4){bf2f(yi[0]), bf2f(yi[DM]), bf2f(yi[2 * DM]), bf2f(yi[3 * DM])};
#pragma unroll
            for (int r = 0; r < 4; ++r) zz[cbk][r] = bf2f(zi[(size_t)r * PC]);
        }
#pragma unroll
        for (int cbk = 0; cbk < 4; ++cbk)
#pragma unroll
            for (int ks = 0; ks < 2; ++ks) o[cbk] = mfma16(Af[ks], Bf[cbk][ks], o[cbk]);
#pragma unroll
        for (int r = 0; r < 4; ++r) {
            float ss = o[0][r] * o[0][r] + o[1][r] * o[1][r] + o[2][r] * o[2][r] + o[3][r] * o[3][r];
            ss = row16_sum(ss);
            const float rs = rsqrtf(ss * (1.0f / 64.0f) + EPS);
#pragma unroll
            for (int cbk = 0; cbk < 4; ++cbk) { const bf16 ov = (bf16)f2bf(o[cbk][r] * rs * ng[cbk] * fsilu(zz[cbk][r])); if (dry) asm volatile("" :: "v"(ov)); else Y[(size_t)(16 * rb + 4 * g + r) * DM + 16 * cbk + c15] = ov; }
        }
    }
}
__device__ __forceinline__ void phase_out(const Params& p, int l, bool dry = false) {
    const int wave = TIDX() >> 6;
    const int gw = BIDX() * NWAVES + wave, NGW = gridDim.x * NWAVES;
    for (int it = gw; it < 2 * NCH; it += NGW) { if (it < NCH) out_item<0>(p, l, it, dry); else out_item<1>(p, l, it - NCH, dry); }
}
}

#ifndef REP_SCAN
#define REP_SCAN 1
#endif
#ifndef REP_ATT
#define REP_ATT 1
#endif
#ifndef REP_ATT_KIND
#define REP_ATT_KIND 2
#endif
#ifndef REP_ATT_QB
#define REP_ATT_QB 0
#endif
#ifndef REP_ATT_DRY
#define REP_ATT_DRY 0
#endif
__device__ __forceinline__ void phase_mix(const Params& p, int l, LAS unsigned char* lds) {
    const int c = BIDX();
    for (int rep = 0; rep < REP_SCAN; ++rep)
    for (int u = c; u < 64; u += gridDim.x) { if (u < 32) scn::scan_unit<0>(p, l, u); else scn::scan_unit<1>(p, l, u - 32); }
    LAS unsigned* bc = (LAS unsigned*)(lds + att::NSLOT * att::BUFB);
    {
        LAS float* cst = (LAS float*)(lds + att::NSLOT * att::BUFB + 4096);
        __syncthreads();
        if (TIDX() < 64) { const int lane = TIDX();
            float pr = (lane < 32) ? p.lq1[l * 32 + lane] * p.lk1[l * 32 + lane] : -(p.lq2[l * 32 + lane - 32] * p.lk2[l * 32 + lane - 32]);
#pragma unroll
            for (int o = 16; o > 0; o >>= 1) pr += __shfl_xor(pr, o);
            const float e_mine = expf(lane < 32 ? pr : -pr), e_other = __shfl_xor(e_mine, 32);
            const float lam_init = 0.8f - 0.6f * expf(-0.3f * (float)l);
            if (lane == 0) { cst[0] = e_mine - e_other + lam_init; cst[1] = lam_init; }
            cst[16 + lane] = p.diff_g[l * HD + lane]; }
    }
    for (int rep = 0; rep < REP_ATT; ++rep) {
    unsigned* ctr = (unsigned*)(p.ws + WS_CTL) + 64 * (1 + l + 2 * rep);
    for (;;) {
        __syncthreads();
        if (TIDX() == 0) bc[0] = atomicAdd(ctr, 1u);
        __syncthreads();
        const unsigned u = bc[0];
        if (u >= 1024u) break;
        const int kind = (int)(u >> 9), qb = 7 - (int)((u >> 6) & 7), bh = u & 63, b = bh >> 2, h = bh & 3;
        if (kind == 0) att::attn_unit<0>(p, l, b, h, qb, lds); else att::attn_unit<1>(p, l, b, h, qb, lds);
    }
    }
}

#ifndef GREP_S1A
#define GREP_S1A 1
#endif
#ifndef GREP_S1B
#define GREP_S1B 1
#endif
#ifndef GREP_S2A
#define GREP_S2A 1
#endif
#ifndef GREP_S2B
#define GREP_S2B 1
#endif
#ifndef GREP_S4
#define GREP_S4 1
#endif
#ifndef WY_OUTMASK
#define WY_OUTMASK 15
#endif
namespace wy {
typedef short bf16x8 __attribute__((ext_vector_type(8)));
typedef short bf16x4 __attribute__((ext_vector_type(4)));
typedef float f32x4 __attribute__((ext_vector_type(4)));
constexpr int LP = 72, ROWB = LP * 2;
__device__ __forceinline__ f32x4 mm32(const LAS unsigned char* X, int xr, const LAS unsigned char* Y, int yr, int k0, f32x4 acc, int c15, int g) {
    const bf16x8 a = *(const LAS bf16x8*)(X + (xr + c15) * ROWB + (k0 + 8 * g) * 2);
    const bf16x8 b = *(const LAS bf16x8*)(Y + (yr + c15) * ROWB + (k0 + 8 * g) * 2);
    f32x4 r = __builtin_amdgcn_mfma_f32_16x16x32_bf16(a, b, acc, 0, 0, 0);
    asm volatile("" : "+v"(r) : "v"(a), "v"(b));
    return r;
}
__device__ __forceinline__ f32x4 mm16(const LAS unsigned char* X, int xr, const LAS unsigned char* Y, int yr, int k0, f32x4 acc, int c15, int g) {
    const bf16x4 a = *(const LAS bf16x4*)(X + (xr + c15) * ROWB + (k0 + 4 * g) * 2);
    const bf16x4 b = *(const LAS bf16x4*)(Y + (yr + c15) * ROWB + (k0 + 4 * g) * 2);
    f32x4 r = __builtin_amdgcn_mfma_f32_16x16x16bf16_1k(a, b, acc, 0, 0, 0);
    asm volatile("" : "+v"(r) : "v"(a), "v"(b));
    return r;
}
__device__ __forceinline__ f32x4 zacc() { f32x4 z = (f32x4){0.f, 0.f, 0.f, 0.f}; asm volatile("" : "+v"(z)); return z; }
template <int KLEN>
__device__ __forceinline__ f32x4 mmk(const LAS unsigned char* X, int xr, const LAS unsigned char* Y, int yr, f32x4 acc, int c15, int g) {
#pragma unroll
    for (int k = 0; k + 32 <= KLEN; k += 32) acc = mm32(X, xr, Y, yr, k, acc, c15, g);
    if (KLEN % 32) acc = mm16(X, xr, Y, yr, KLEN - 16, acc, c15, g);
    return acc;
}
template <int NTL, int KLEN>
__device__ __forceinline__ void mm_batch(const LAS unsigned char* X, const int (&xr)[NTL], const LAS unsigned char* Y, const int (&yr)[NTL], f32x4 (&acc)[NTL], int c15, int g) {
#pragma unroll
    for (int k = 0; k + 32 <= KLEN; k += 32) { bf16x8 a[NTL], b[NTL];
#pragma unroll
        for (int t = 0; t < NTL; ++t) { a[t] = *(const LAS bf16x8*)(X + (xr[t] + c15) * ROWB + (k + 8 * g) * 2); b[t] = *(const LAS bf16x8*)(Y + (yr[t] + c15) * ROWB + (k + 8 * g) * 2); }
#pragma unroll
        for (int t = 0; t < NTL; ++t) { acc[t] = __builtin_amdgcn_mfma_f32_16x16x32_bf16(a[t], b[t], acc[t], 0, 0, 0); asm volatile("" : "+v"(acc[t]) : "v"(a[t]), "v"(b[t])); } }
    if (KLEN % 32) { bf16x4 a[NTL], b[NTL];
#pragma unroll
        for (int t = 0; t < NTL; ++t) { a[t] = *(const LAS bf16x4*)(X + (xr[t] + c15) * ROWB + (KLEN - 16 + 4 * g) * 2); b[t] = *(const LAS bf16x4*)(Y + (yr[t] + c15) * ROWB + (KLEN - 16 + 4 * g) * 2); }
#pragma unroll
        for (int t = 0; t < NTL; ++t) { acc[t] = __builtin_amdgcn_mfma_f32_16x16x16bf16_1k(a[t], b[t], acc[t], 0, 0, 0); asm volatile("" : "+v"(acc[t]) : "v"(a[t]), "v"(b[t])); } }
}
__device__ __forceinline__ float sum8_dpp(float v) {
    v += __int_as_float(__builtin_amdgcn_update_dpp(0, __float_as_int(v), 0xB1, 0xF, 0xF, true));
    v += __int_as_float(__builtin_amdgcn_update_dpp(0, __float_as_int(v), 0x4E, 0xF, 0xF, true));
    v += __int_as_float(__builtin_amdgcn_update_dpp(0, __float_as_int(v), 0x141, 0xF, 0xF, true));
    return v;
}
__device__ __forceinline__ void unpack8(const v4u w, float (&f)[8]) {
    f[0] = __uint_as_float(w.x << 16); f[1] = __uint_as_float(w.x & 0xffff0000u); f[2] = __uint_as_float(w.y << 16); f[3] = __uint_as_float(w.y & 0xffff0000u);
    f[4] = __uint_as_float(w.z << 16); f[5] = __uint_as_float(w.z & 0xffff0000u); f[6] = __uint_as_float(w.w << 16); f[7] = __uint_as_float(w.w & 0xffff0000u);
}
__device__ __forceinline__ v4u pack8(const float (&f)[8]) { v4u w; w.x = pk2(f[0], f[1]); w.y = pk2(f[2], f[3]); w.z = pk2(f[4], f[5]); w.w = pk2(f[6], f[7]); return w; }

struct GdnRaw { v4u q[4], k[4], v[4]; float ga, gb; };
__device__ __forceinline__ void gdn_load_raw(const Params& p, int ci, GdnRaw& R) {
    const int tid = TIDX(), tok = tid >> 3, c8 = tid & 7;
    const int b = ci >> 7, h = (ci >> 5) & 3, n = ci & 31, t0 = n * 64;
    const bf16* P = (const bf16*)(p.ws + WS_PROJ) + (size_t)b * SEQ * PC;
#pragma unroll
    for (int r = 0; r < 4; ++r) { const int row = t0 + tok - 3 + r, rowc = row < 0 ? 0 : row;
        const bf16* pr = P + (size_t)rowc * PC + h * 64 + 8 * c8;
        R.q[r] = *(const v4u*)(pr + C_GQ); R.k[r] = *(const v4u*)(pr + C_GK); R.v[r] = *(const v4u*)(pr + C_GV); }
    const float* AB = (const float*)(p.ws + WS_AB) + ((size_t)b * SEQ + t0 + tok) * 8;
    R.ga = AB[h]; R.gb = AB[4 + h];
}
constexpr int G_KH = 0, G_QH = 9216, G_VH = 18432, G_KTD = 27648, G_XT = 36864, G_AKK = 55296, G_AQK = 64512, G_TB = 73728, G_AD = 76800, G_SC = 80896;
constexpr int TBP = 24;
constexpr int G_CW = 132096;
constexpr int G_ST_MF = 83968, G_ST_SL = 101376, G_ST_QT = 118784, G_ST_Y = 0;
__device__ __forceinline__ void gdn_chunk(const Params& p, int l, int ci, int ci_next, GdnRaw& R, LAS unsigned char* lds) {
    const int tid = TIDX(), lane = tid & 63, wid = __builtin_amdgcn_readfirstlane(tid >> 6), c15 = lane & 15, g = lane >> 4;
    const int b = ci >> 7, h = (ci >> 5) & 3, n = ci & 31, t0 = n * 64;
    const bf16* P = (const bf16*)(p.ws + WS_PROJ) + (size_t)b * SEQ * PC;
    LAS float* sc_g = (LAS float*)(lds + G_SC); LAS float* sc_b = sc_g + 64; LAS float* sc_gc = sc_g + 128; LAS float* sc_eg = sc_g + 192; LAS float* sc_dl = sc_g + 256;
    __syncthreads();
    for (int rp_ = 0; rp_ < GREP_S1A; ++rp_) {
        const int tok = tid >> 3, c8 = tid & 7;
        float aq[8], ak[8], av[8];
#pragma unroll
        for (int i = 0; i < 8; ++i) { aq[i] = 0.f; ak[i] = 0.f; av[i] = 0.f; }
        f4 wgt[4][6];
        { const LAS float* wl_ = (const LAS float*)(lds + G_CW) + c8 * 96;
#pragma unroll
          for (int r = 0; r < 4; ++r)
#pragma unroll
              for (int j = 0; j < 6; ++j) wgt[r][j] = *(const LAS f4*)(wl_ + (r * 6 + j) * 4); }
#pragma unroll
        for (int r = 0; r < 4; ++r) {
            const float m = (t0 + tok - 3 + r) < 0 ? 0.f : 1.f;
            float xq[8], xk[8], xv[8];
            unpack8(R.q[r], xq); unpack8(R.k[r], xk); unpack8(R.v[r], xv);
            const float wq[8] = {wgt[r][0].x, wgt[r][0].y, wgt[r][0].z, wgt[r][0].w, wgt[r][1].x, wgt[r][1].y, wgt[r][1].z, wgt[r][1].w};
            const float wk[8] = {wgt[r][2].x, wgt[r][2].y, wgt[r][2].z, wgt[r][2].w, wgt[r][3].x, wgt[r][3].y, wgt[r][3].z, wgt[r][3].w};
            const float wv[8] = {wgt[r][4].x, wgt[r][4].y, wgt[r][4].z, wgt[r][4].w, wgt[r][5].x, wgt[r][5].y, wgt[r][5].z, wgt[r][5].w};
#pragma unroll
            for (int i = 0; i < 8; ++i) { aq[i] += m * wq[i] * xq[i]; ak[i] += m * wk[i] * xk[i]; av[i] += m * wv[i] * xv[i]; }
        }
        float sq = 0.f, sk = 0.f;
#pragma unroll
        for (int i = 0; i < 8; ++i) { aq[i] = fsilu(aq[i]); ak[i] = fsilu(ak[i]); av[i] = fsilu(av[i]); sq += aq[i] * aq[i]; sk += ak[i] * ak[i]; }
        sq = sum8_dpp(sq); sk = sum8_dpp(sk);
        const float rq = __builtin_amdgcn_rsqf(sq + EPS) * 0.125f, rk = __builtin_amdgcn_rsqf(sk + EPS);
#pragma unroll
        for (int i = 0; i < 8; ++i) { aq[i] *= rq; ak[i] *= rk; }
        *(LAS v4u*)(lds + G_QH + tok * ROWB + 16 * c8) = pack8(aq);
        *(LAS v4u*)(lds + G_KH + tok * ROWB + 16 * c8) = pack8(ak);
        *(LAS v4u*)(lds + G_VH + tok * ROWB + 16 * c8) = pack8(av);
        if (c8 == 0) { sc_g[tok] = -expf(p.a_log[l * NH + h]) * fsoftplus(R.ga + p.dt_bias[l * NH + h]); sc_b[tok] = fsigmoid(R.gb); }
    }
    __syncthreads();
    for (int rp_ = 0; rp_ < GREP_S1B; ++rp_) {
        const int d = tid & 63, tq = tid >> 6;
        float pre = 0.f, tot = 0.f;
#pragma unroll
        for (int j = 0; j < 64; j += 4) { const f4 g4 = *(const LAS f4*)(sc_g + j); const float s4 = (g4.x + g4.y) + (g4.z + g4.w); tot += s4; if (j < 8 * tq) pre += s4; }
        float gc[8], bt[8];
        { const f4 a = *(const LAS f4*)(sc_g + 8 * tq), c = *(const LAS f4*)(sc_g + 8 * tq + 4), b0 = *(const LAS f4*)(sc_b + 8 * tq), b1 = *(const LAS f4*)(sc_b + 8 * tq + 4);
          gc[0] = pre + a.x; gc[1] = gc[0] + a.y; gc[2] = gc[1] + a.z; gc[3] = gc[2] + a.w; gc[4] = gc[3] + c.x; gc[5] = gc[4] + c.y; gc[6] = gc[5] + c.z; gc[7] = gc[6] + c.w;
          bt[0] = b0.x; bt[1] = b0.y; bt[2] = b0.z; bt[3] = b0.w; bt[4] = b1.x; bt[5] = b1.y; bt[6] = b1.z; bt[7] = b1.w; }
        float xv[8], xw[8], xk[8];
#pragma unroll
        for (int i = 0; i < 8; ++i) { const float eg = fexp(gc[i]), ed = fexp(tot - gc[i]);
            const float kv = bf2f(*(const LAS bf16*)(lds + G_KH + (8 * tq + i) * ROWB + 2 * d)), vv = bf2f(*(const LAS bf16*)(lds + G_VH + (8 * tq + i) * ROWB + 2 * d));
            xv[i] = vv * bt[i]; xw[i] = kv * bt[i] * eg; xk[i] = kv * ed;
            if (d == 0) { sc_gc[8 * tq + i] = gc[i]; sc_eg[8 * tq + i] = eg; } }
        if (tid == 0) sc_dl[0] = fexp(tot);
        *(LAS v4u*)(lds + G_XT + d * ROWB + 16 * tq) = pack8(xv);
        *(LAS v4u*)(lds + G_XT + (64 + d) * ROWB + 16 * tq) = pack8(xw);
        *(LAS v4u*)(lds + G_KTD + d * ROWB + 16 * tq) = pack8(xk);
    }
    __syncthreads();
    for (int rp_ = 0; rp_ < GREP_S2A; ++rp_) {
#pragma unroll 1
        for (int step = 0; step < 2; ++step) {
            if (step == 1) __syncthreads();
            const bool isq = step == 1;
            if (isq && wid == 0) {
                const int blk = lane >> 4, c = lane & 15;
                const LAS float* Ad = (const LAS float*)(lds + G_AD) + blk * 256;
                float t[16];
#pragma unroll
                for (int i = 0; i < 16; ++i) { float s = (i == c) ? 1.f : 0.f;
#pragma unroll
                    for (int j = 0; j < i; ++j) s -= Ad[i * 16 + j] * t[j];
                    t[i] = s; *(LAS bf16*)(lds + G_TB + ((blk * 16 + i) * TBP + c) * 2) = (bf16)f2bf(s); }
            } else {
                for (int tt = isq ? wid - 1 : wid; tt < 10; tt += (isq ? 7 : 8)) {
                    const int I = (tt >= 6) ? 3 : (tt >= 3) ? 2 : (tt >= 1) ? 1 : 0, J = tt - (I * (I + 1)) / 2;
                    f32x4 acc = zacc();
                    acc = mmk<64>(lds + (isq ? G_QH : G_KH), 16 * I, lds + G_KH, 16 * J, acc, c15, g);
                    const int jj = 16 * J + c15; const float gj = sc_gc[jj];
#pragma unroll
                    for (int r = 0; r < 4; ++r) { const int ii = 16 * I + 4 * g + r; const float dec = fexp(sc_gc[ii] - gj);
                        if (isq) { const float v = (jj <= ii) ? acc[r] * dec : 0.f; *(LAS bf16*)(lds + G_AQK + ii * ROWB + 2 * jj) = (bf16)f2bf(v); }
                        else { const float v = (jj < ii) ? acc[r] * dec * sc_b[ii] : 0.f; *(LAS bf16*)(lds + G_AKK + ii * ROWB + 2 * jj) = (bf16)f2bf(-v);
                            if (I == J) ((LAS float*)(lds + G_AD))[I * 256 + (4 * g + r) * 16 + c15] = v; } }
                }
            }
        }
    }
    __syncthreads();
    {
        const int cb = 16 * wid;
#pragma unroll
        for (int I = 0; I < 4; ++I) {
            LAS unsigned char* xp = lds + G_XT + (cb + c15) * ROWB + (16 * I + 4 * g) * 2;
            const v2u rr = *(const LAS v2u*)xp;
            f32x4 acc = (f32x4){__uint_as_float(rr.x << 16), __uint_as_float(rr.x & 0xffff0000u), __uint_as_float(rr.y << 16), __uint_as_float(rr.y & 0xffff0000u)};
            if (I == 1) acc = mmk<16>(lds + G_AKK, 16, lds + G_XT, cb, acc, c15, g);
            if (I == 2) acc = mmk<32>(lds + G_AKK, 32, lds + G_XT, cb, acc, c15, g);
            if (I == 3) acc = mmk<48>(lds + G_AKK, 48, lds + G_XT, cb, acc, c15, g);
            const bf16x4 ta = *(const LAS bf16x4*)(lds + G_TB + ((I * 16 + c15) * TBP + 4 * g) * 2);
            v2u bw; bw.x = pk2(acc[0], acc[1]); bw.y = pk2(acc[2], acc[3]);
            const bf16x4 tb = __builtin_bit_cast(bf16x4, bw);
            f32x4 x = __builtin_amdgcn_mfma_f32_16x16x16bf16_1k(ta, tb, zacc(), 0, 0, 0);
            asm volatile("" : "+v"(x) : "v"(ta), "v"(tb));
            v2u xw; xw.x = pk2(x[0], x[1]); xw.y = pk2(x[2], x[3]);
            *(LAS v2u*)xp = xw;
            asm volatile("s_waitcnt lgkmcnt(0)" ::: "memory");
        }
    }
    __syncthreads();
    if (ci_next < scn::NCH) gdn_load_raw(p, ci_next, R);
    for (int rp_ = 0; rp_ < GREP_S4; ++rp_) {
        const int type = wid >> 1, hf = wid & 1;
        const float dlast = sc_dl[0];
        if (type < 2) {
#pragma unroll
            for (int half = 0; half < 2; ++half) {
                int xr[4], yr[4]; f32x4 acc[4];
#pragma unroll
                for (int i = 0; i < 4; ++i) { const int rb = 2 * half + (i >> 1), cbk = 2 * hf + (i & 1); acc[i] = zacc();
                    xr[i] = 16 * rb; yr[i] = (type == 0 ? 64 : 0) + 16 * cbk; }
                if (type == 0) mm_batch<4, 64>(lds + G_KTD, xr, lds + G_XT, yr, acc, c15, g);
                else { int yk[4];
#pragma unroll
                    for (int i = 0; i < 4; ++i) yk[i] = 16 * (2 * hf + (i & 1));
                    mm_batch<4, 64>(lds + G_XT, xr, lds + G_KTD, yk, acc, c15, g); }
#pragma unroll
                for (int i = 0; i < 4; ++i) { const int rb = 2 * half + (i >> 1), col = 16 * (2 * hf + (i & 1)) + c15;
#pragma unroll
                    for (int r = 0; r < 4; ++r) { const int row = 16 * rb + 4 * g + r;
                        if (type == 0) *(LAS float*)(lds + G_ST_MF + row * 272 + col * 4) = ((row == col) ? dlast : 0.f) - acc[i][r];
                        else *(LAS float*)(lds + G_ST_SL + row * 272 + col * 4) = acc[i][r]; } }
            }
        } else {
            const int ybase = (type == 2 ? 64 : 0);
#pragma unroll
            for (int rb = 0; rb < 4; ++rb) {
                int xr[2] = {16 * rb, 16 * rb}, yr[2] = {ybase + 16 * (2 * hf), ybase + 16 * (2 * hf + 1)}; f32x4 acc[2] = {zacc(), zacc()};
                if (rb == 0) mm_batch<2, 16>(lds + G_AQK, xr, lds + G_XT, yr, acc, c15, g);
                if (rb == 1) mm_batch<2, 32>(lds + G_AQK, xr, lds + G_XT, yr, acc, c15, g);
                if (rb == 2) mm_batch<2, 48>(lds + G_AQK, xr, lds + G_XT, yr, acc, c15, g);
                if (rb == 3) mm_batch<2, 64>(lds + G_AQK, xr, lds + G_XT, yr, acc, c15, g);
#pragma unroll
                for (int i = 0; i < 2; ++i) { const int col = 16 * (2 * hf + i) + c15;
#pragma unroll
                    for (int r = 0; r < 4; ++r) { const int row = 16 * rb + 4 * g + r;
                        if (type == 2) *(LAS bf16*)(lds + G_ST_QT + row * ROWB + 2 * col) = (bf16)f2bf(sc_eg[row] * bf2f(*(const LAS bf16*)(lds + G_QH + row * ROWB + 2 * col)) - acc[i][r]);
                        else *(LAS bf16*)(lds + G_ST_Y + row * ROWB + 2 * col) = (bf16)f2bf(acc[i][r]); } }
            }
        }
    }
    __syncthreads();
    {
        float* MF = (float*)(p.ws + WS_SCR + scn::B_GMF + (size_t)ci * scn::CH_SL);
        float* SL = (float*)(p.ws + WS_SCR + scn::B_GSL + (size_t)ci * scn::CH_SL);
        bf16* QT = (bf16*)(p.ws + WS_XB + scn::A_GQT + (size_t)ci * scn::CH_QT);
        bf16* Y = (bf16*)(p.ws + WS_Y) + ((size_t)b * SEQ + t0) * DM + 0 + h * 64;
#pragma unroll
        for (int i = 0; i < 2; ++i) { const int pz = tid + 512 * i, row = pz >> 4, c4 = pz & 15;
            *(v4u*)(MF + row * 64 + c4 * 4) = *(const LAS v4u*)(lds + G_ST_MF + row * 272 + c4 * 16);
            *(v4u*)(SL + row * 64 + c4 * 4) = *(const LAS v4u*)(lds + G_ST_SL + row * 272 + c4 * 16); }
        { const int row = tid >> 3, c8 = tid & 7;
            *(v4u*)(QT + row * 64 + c8 * 8) = *(const LAS v4u*)(lds + G_ST_QT + row * ROWB + c8 * 16);
            *(v4u*)(Y + (size_t)row * DM + c8 * 8) = *(const LAS v4u*)(lds + G_ST_Y + row * ROWB + c8 * 16); }
    }
}

struct HgrnRaw { bf16 q[8], f[8], v[8]; };
__device__ __forceinline__ void hgrn_load_raw(const Params& p, int ci, HgrnRaw& R) {
    const int tid = TIDX(), ch = tid & 63, tq = tid >> 6;
    const int b = ci >> 7, h = (ci >> 5) & 3, n = ci & 31, t0 = n * 64;
    const bf16* P = (const bf16*)(p.ws + WS_PROJ) + ((size_t)b * SEQ + t0) * PC + h * 64;
#pragma unroll
    for (int i = 0; i < 8; ++i) { const bf16* pr = P + (size_t)(8 * tq + i) * PC + ch; R.q[i] = pr[C_HQ]; R.f[i] = pr[C_HF]; R.v[i] = pr[C_HI]; }
}
constexpr int H_QD = 0, H_KD = 9216, H_QO = 18432, H_KO1 = 27648  , H_KO2 = 29952  , H_KO3 = 34560  , H_KTD = 41472, H_VT = 50688, H_A = 59904, H_SC = 69120  , H_ST_SL = 73728, H_ST_Y = 91136;
__device__ __forceinline__ void hgrn_chunk(const Params& p, int l, int ci, int ci_next, HgrnRaw& R, LAS unsigned char* lds) {
    const int tid = TIDX(), lane = tid & 63, wid = __builtin_amdgcn_readfirstlane(tid >> 6), c15 = lane & 15, g = lane >> 4;
    const int b = ci >> 7, h = (ci >> 5) & 3, n = ci & 31, t0 = n * 64;
    const bf16* P = (const bf16*)(p.ws + WS_PROJ) + ((size_t)b * SEQ + t0) * PC + h * 64;
    LAS float* s_tot = (LAS float*)(lds + H_SC); LAS float* s_gm = s_tot + 512; LAS float* s_gr = s_tot + 768;
    const int ch = tid & 63, tq = tid >> 6;
    float lb = 0.f;
    if (l == 1) { const float a0 = p.hgrn_lb[h * 64 + ch], a1 = p.hgrn_lb[GW + h * 64 + ch]; lb = __builtin_amdgcn_rcpf(1.0f + fexp(a0 - a1)); }
    float qv[8], kv[8], vv[8], G[8];
    {
        float run = 0.f;
#pragma unroll
        for (int i = 0; i < 8; ++i) {
            const float qr = bf2f(R.q[i]), fr = bf2f(R.f[i]); vv[i] = bf2f(R.v[i]);
            const float sg = fsigmoid(fr), fg = lb + (1.0f - lb) * sg;
            kv[i] = (1.0f - lb) * (1.0f - sg); qv[i] = fsilu(qr);
            run += 0.6931471805599453f * __builtin_amdgcn_logf(fg); G[i] = run; }
        __syncthreads();
        s_tot[tq * 64 + ch] = run;
    }
    __syncthreads();
    float Glast;
    {
        float pre = 0.f, tot = 0.f;
#pragma unroll
        for (int j = 0; j < 8; ++j) { const float tj = s_tot[j * 64 + ch]; tot += tj; if (j < tq) pre += tj; }
#pragma unroll
        for (int i = 0; i < 8; ++i) G[i] += pre;
        Glast = tot;
        if (tq & 1) s_gm[(tq >> 1) * 64 + ch] = G[0];
        else if (tq > 0) s_gr[(tq >> 1) * 64 + ch] = pre;
    }
    __syncthreads();
    {
        const int I = tq >> 1;
        const float gm = s_gm[I * 64 + ch], gr = (I > 0) ? s_gr[I * 64 + ch] : 0.f;
        const float gr1 = s_gr[64 + ch], gr2 = s_gr[128 + ch], gr3 = s_gr[192 + ch];
        bf16* QT = (bf16*)(p.ws + WS_XB + scn::A_HQT + (size_t)ci * scn::CH_QT);
        float kt[8];
#pragma unroll
        for (int i = 0; i < 8; ++i) { const int tok = 8 * tq + i;
            QT[tok * 64 + ch] = (bf16)f2bf(qv[i] * fexp(G[i]));
            *(LAS bf16*)(lds + H_QD + tok * ROWB + 2 * ch) = (bf16)f2bf(qv[i] * fexp(G[i] - gm));
            *(LAS bf16*)(lds + H_KD + tok * ROWB + 2 * ch) = (bf16)f2bf(kv[i] * fexp(gm - G[i]));
            if (I > 0) *(LAS bf16*)(lds + H_QO + tok * ROWB + 2 * ch) = (bf16)f2bf(qv[i] * fexp(G[i] - gr));
            if (I < 1) *(LAS bf16*)(lds + H_KO1 + tok * ROWB + 2 * ch) = (bf16)f2bf(kv[i] * fexp(gr1 - G[i]));
            if (I < 2) *(LAS bf16*)(lds + H_KO2 + tok * ROWB + 2 * ch) = (bf16)f2bf(kv[i] * fexp(gr2 - G[i]));
            if (I < 3) *(LAS bf16*)(lds + H_KO3 + tok * ROWB + 2 * ch) = (bf16)f2bf(kv[i] * fexp(gr3 - G[i]));
            kt[i] = kv[i] * fexp(Glast - G[i]); }
        *(LAS v4u*)(lds + H_KTD + ch * ROWB + 16 * tq) = pack8(kt);
        *(LAS v4u*)(lds + H_VT + ch * ROWB + 16 * tq) = pack8(vv);
        if (tq == 0) ((float*)(p.ws + WS_SCR + scn::B_HDL + (size_t)ci * scn::CH_DL))[ch] = fexp(Glast);
    }
    __syncthreads();
    if (ci_next < scn::NCH) hgrn_load_raw(p, ci_next, R);
    {
        for (int t = wid; t < 10; t += 8) {
            f32x4 acc = zacc();
            const int I = (t >= 6) ? 3 : (t >= 3) ? 2 : (t >= 1) ? 1 : 0, J = t - (I * (I + 1)) / 2;
            if (I == J) acc = mmk<64>(lds + H_QD, 16 * I, lds + H_KD, 16 * I, acc, c15, g);
            else acc = mmk<64>(lds + H_QO, 16 * I, lds + (I == 1 ? H_KO1 : I == 2 ? H_KO2 : H_KO3), 16 * J, acc, c15, g);
#pragma unroll
            for (int r = 0; r < 4; ++r) { const int ii = 16 * I + 4 * g + r, jj = 16 * J + c15; *(LAS bf16*)(lds + H_A + ii * ROWB + 2 * jj) = (bf16)f2bf((jj <= ii) ? acc[r] : 0.f); }
        }
        {
            int xr[2], yr[2]; f32x4 acc[2] = {zacc(), zacc()};
#pragma unroll
            for (int i = 0; i < 2; ++i) { const int u = wid + 8 * i; xr[i] = 16 * (u >> 2); yr[i] = 16 * (u & 3); }
            mm_batch<2, 64>(lds + H_VT, xr, lds + H_KTD, yr, acc, c15, g);
#pragma unroll
            for (int i = 0; i < 2; ++i) { const int u = wid + 8 * i, rb = u >> 2, cbk = u & 3;
#pragma unroll
                for (int r = 0; r < 4; ++r) *(LAS float*)(lds + H_ST_SL + (16 * rb + 4 * g + r) * 272 + (16 * cbk + c15) * 4) = acc[i][r]; }
        }
    }
    __syncthreads();
    {
        bf16* Y = (bf16*)(p.ws + WS_Y) + ((size_t)b * SEQ + t0) * DM + 256 + h * 64;
        {
            const int rb = wid >> 1, c0 = (wid & 1) * 2;
            int xr[2] = {16 * rb, 16 * rb}, yr[2] = {16 * c0, 16 * (c0 + 1)}; f32x4 acc[2] = {zacc(), zacc()};
            if (rb == 0) mm_batch<2, 16>(lds + H_A, xr, lds + H_VT, yr, acc, c15, g);
            else if (rb == 1) mm_batch<2, 32>(lds + H_A, xr, lds + H_VT, yr, acc, c15, g);
            else if (rb == 2) mm_batch<2, 48>(lds + H_A, xr, lds + H_VT, yr, acc, c15, g);
            else mm_batch<2, 64>(lds + H_A, xr, lds + H_VT, yr, acc, c15, g);
#pragma unroll
            for (int i = 0; i < 2; ++i)
#pragma unroll
                for (int r = 0; r < 4; ++r) *(LAS bf16*)(lds + H_ST_Y + (16 * rb + 4 * g + r) * ROWB + 2 * (16 * (c0 + i) + c15)) = (bf16)f2bf(acc[i][r]);
        }
        __syncthreads();
        float* SL = (float*)(p.ws + WS_SCR + scn::B_HSL + (size_t)ci * scn::CH_SL);
#pragma unroll
        for (int i = 0; i < 2; ++i) { const int pz = tid + 512 * i, row = pz >> 4, c4 = pz & 15; *(v4u*)(SL + row * 64 + c4 * 4) = *(const LAS v4u*)(lds + H_ST_SL + row * 272 + c4 * 16); }
        { const int row = tid >> 3, c8 = tid & 7; *(v4u*)(Y + (size_t)row * DM + c8 * 8) = *(const LAS v4u*)(lds + H_ST_Y + row * ROWB + c8 * 16); }
    }
}

#ifndef WY_GDN
#define WY_GDN 1
#endif
#ifndef WY_REP_G
#define WY_REP_G 1
#endif
#ifndef WY_REP_H
#define WY_REP_H 1
#endif
#ifndef WY_HGRN
#define WY_HGRN 1
#endif
__device__ __forceinline__ void phase_pre_mfma(const Params& p, int l, LAS unsigned char* lds) {
    const int wave = TIDX() >> 6;
    LAS float* wl = (LAS float*)(lds + 100 * 1024 + wave * 1024);
    const int gw = BIDX() * NWAVES + wave, NGW = gridDim.x * NWAVES;
    if (WY_GDN && WY_OUTMASK == 15) { for (int rep = 0; rep < WY_REP_G; ++rep) { GdnRaw R; if (BIDX() < scn::NCH) gdn_load_raw(p, BIDX(), R);
        { const int hh = (BIDX() >> 5) & 3; const float* cwp = p.conv_w + (size_t)l * 4 * 768 + hh * 64; LAS float* wl_ = (LAS float*)(lds + G_CW);
          __syncthreads();
          for (int i = TIDX(); i < 768; i += NT) { const int c8 = i / 96, rem = i % 96, r = rem / 24, j = (rem % 24) >> 2, e = rem & 3;
              wl_[i] = cwp[r * 768 + (j >> 1) * 256 + 8 * c8 + (j & 1) * 4 + e]; }
        } for (int ci = BIDX(); ci < scn::NCH; ci += gridDim.x) gdn_chunk(p, l, ci, ci + (int)gridDim.x, R, lds); } }
    else { for (int it = gw; it < 2 * scn::NCH; it += NGW) scn::gdn_pre<1>(p, l, it, wl); for (int it = gw; it < 2 * scn::NCH; it += NGW) scn::gdn_pre<0>(p, l, it, wl); }
    if (WY_HGRN) { for (int rep = 0; rep < WY_REP_H; ++rep) { HgrnRaw R; if (BIDX() < scn::NCH) hgrn_load_raw(p, BIDX(), R); for (int ci = BIDX(); ci < scn::NCH; ci += gridDim.x) hgrn_chunk(p, l, ci, ci + (int)gridDim.x, R, lds); } }
    else { __syncthreads(); for (int it = gw; it < scn::NCH; it += NGW) scn::hgrn_pre(p, l, it, wl); }
    __syncthreads();
    for (int it = gw; it < NB * NH * 8 * 4; it += NGW) scn::kmean_item(p, it);
}
}
#ifndef GIN_ALIGN
#define GIN_ALIGN true
#endif
#ifndef GIN_SP2
#define GIN_SP2 true
#endif
#ifndef REP_PRE
#define REP_PRE 1
#endif
#ifndef REP_POST0
#define REP_POST0 1
#endif
#ifndef REP_PROLOGUE
#define REP_PROLOGUE 1
#endif
#ifndef REP_BAR
#define REP_BAR 1
#endif
#ifndef REP_GIN
#define REP_GIN 1
#endif
#ifndef REP_GOUT
#define REP_GOUT 1
#endif
#ifndef REP_OUT
#define REP_OUT 1
#endif
#ifndef REP_MIX
#define REP_MIX 1
#endif

__device__ __forceinline__ Params load_params() {
    const __attribute__((address_space(4))) Params* q = (const __attribute__((address_space(4))) Params*)__builtin_amdgcn_kernarg_segment_ptr();
    asm volatile("" : "+s"(q));
    return *(const Params*)q;
}
__device__ __forceinline__ void grid_barrier(LAS unsigned char* lds) {
    const Params p = load_params();
    XcdBarrier bar; bar.bar = (unsigned*)(p.ws + WS_CTL) + 4096; bar.x = xb_xcc_id(); bar.st = (volatile LAS unsigned*)(lds + 131072 + 64);
    xcd_barrier(bar);
}
__global__ void __launch_bounds__(NT, 2) fwd_megakernel(Params p_unused) {
    extern __shared__ __attribute__((aligned(16))) unsigned char lds_raw[];
    LAS unsigned char* lds = (LAS unsigned char*)lds_raw;
    {
        const Params p = load_params();
        volatile LAS unsigned* st = (volatile LAS unsigned*)(lds + 131072 + 64);
        if (TIDX() < 2) st[TIDX()] = 0u;
        __syncthreads();
        (void)xcd_barrier_post((unsigned*)(p.ws + WS_CTL) + 4096, st);
        for (int rep = 0; rep < REP_PROLOGUE; ++rep) phase_prologue(p, lds);
    }
    grid_barrier(lds);
#pragma unroll 1
    for (int l = 0; l < DEPTH; ++l) {
        for (int rep = 0; rep < REP_GIN; ++rep) {
            const Params p = load_params();
            pg8::Gemm g{(const bf16*)(p.ws + WS_XB), (const bf16*)(p.ws + WS_WIN) + (size_t)l * PC * DM, NTOK, PC, DM}; pg8::StaticOrder S; S.init(NTOK, PC, (int)gridDim.x, BIDX());
            pg8::EpiProj E{(bf16*)(p.ws + WS_PROJ), PC, (const float*)(p.ws + WS_RSTD)};
            pg8::gemm_phase<pg8::EpiProj, pg8::StaticOrder, GIN_ALIGN, GIN_SP2>(lds, g, S, E);
        }
        grid_barrier(lds);
        for (int rep = 0; rep < REP_PRE; ++rep) { const Params p = load_params(); wy::phase_pre_mfma(p, l, lds); }

        grid_barrier(lds);
        { const Params p = load_params(); phase_mix(p, l, lds); }
        for (int rep = 0; rep < REP_BAR; ++rep) grid_barrier(lds);
        for (int rep = 0; rep < REP_OUT; ++rep) { const Params p = load_params(); scn::phase_out(p, l, rep + 1 < REP_OUT); }
        grid_barrier(lds);
        for (int rep = 0; rep < REP_GOUT; ++rep) {
            const Params p = load_params();
            pg8::Gemm g{(const bf16*)(p.ws + WS_Y), (const bf16*)(p.ws + WS_WOUT) + (size_t)l * DM * DM, NTOK, DM, DM}; pg8::StaticOrder S; S.init(NTOK, DM, (int)gridDim.x, BIDX());
            pg8::EpiBf16Plain E{(bf16*)(p.ws + WS_PROJ), DM};
            pg8::gemm_phase<pg8::EpiBf16Plain, pg8::StaticOrder, true, true>(lds, g, S, E);
        }
        grid_barrier(lds);
        for (int rep = 0; rep < ((l == 0) ? REP_POST0 : 1); ++rep) { const Params p = load_params(); phase_post(p, l, lds); }
        grid_barrier(lds);
    }
}

extern "C" void kernel_launch(void* const* d_in, const int* in_sizes, int n_in, void* d_out, int out_size, void* d_ws, size_t ws_size, hipStream_t stream) {
    static int grid_blocks = 0;
    if (!grid_blocks) {
        if (ws_size < WS_END) { fprintf(stderr, "workspace too small: %zu < %zu\n", ws_size, (size_t)WS_END); grid_blocks = -1; return; }
        int dev = 0, cus = 0, per_cu = 0;
        (void)hipGetDevice(&dev);
        (void)hipDeviceGetAttribute(&cus, hipDeviceAttributeMultiprocessorCount, dev);
        (void)hipFuncSetAttribute((const void*)fwd_megakernel, hipFuncAttributeMaxDynamicSharedMemorySize, LDS_BYTES);
        (void)hipOccupancyMaxActiveBlocksPerMultiprocessor(&per_cu, (const void*)fwd_megakernel, NT, LDS_BYTES);
        if (per_cu < 1) { fprintf(stderr, "occupancy query says %d blocks/CU\n", per_cu); per_cu = 1; }
        grid_blocks = cus * 1;
    }
    if (grid_blocks < 0) return;
    (void)hipMemsetAsync((char*)d_ws + WS_CTL, 0, 65536, stream);
    Params p{};
    p.x = (const float*)d_in[0]; p.pre_g = (const float*)d_in[1]; p.post_g = (const float*)d_in[2]; p.w_in = (const float*)d_in[3];
    p.conv_w = (const float*)d_in[4]; p.a_log = (const float*)d_in[5]; p.dt_bias = (const float*)d_in[6]; p.gdn_g = (const float*)d_in[7];
    p.hgrn_lb = (const float*)d_in[8]; p.hgrn_g = (const float*)d_in[9]; p.lq1 = (const float*)d_in[10]; p.lk1 = (const float*)d_in[11];
    p.lq2 = (const float*)d_in[12]; p.lk2 = (const float*)d_in[13]; p.diff_g = (const float*)d_in[14]; p.w_out = (const float*)d_in[15];
    p.out = (float*)d_out; p.ws = (unsigned char*)d_ws;
    void* args[] = {&p};
    hipError_t e = hipLaunchCooperativeKernel((void*)fwd_megakernel, dim3(grid_blocks), dim3(NT), args, LDS_BYTES, stream);
    if (e != hipSuccess) fprintf(stderr, "cooperative launch failed: %s (grid %d)\n", hipGetErrorString(e), grid_blocks);
}
```

```cpp
#include <hip/hip_runtime.h>
#include <hip/hip_cooperative_groups.h>
#include <cstdio>
#include <cstdint>
#include <cmath>
namespace cg = cooperative_groups;
__device__ __forceinline__ int TIDX() { int t = threadIdx.x; asm volatile("" : "+v"(t)); return t; }
__device__ __forceinline__ int BIDX() { int b = blockIdx.x; asm volatile("" : "+s"(b)); return b; }
namespace pg8 {
#define PG8_LAS __attribute__((address_space(3)))
typedef unsigned short bf16_t;
typedef short bf16x8 __attribute__((ext_vector_type(8)));
typedef float f32x4 __attribute__((ext_vector_type(4)));
typedef unsigned u32x4 __attribute__((ext_vector_type(4)));
constexpr int BM = 256, BK = 64, HALF = 128, HTB = HALF * BK * 2  , STAGE_BYTES = 8 * HTB, NXCD = 8, WGM = 8;

__host__ __device__ __forceinline__ int lds_byte(int r, int c) { const int st = (r >> 4) * 2 + (c >> 5), rr = r & 15, cc = c & 31, ob = rr * 64 + cc * 2; return st * 1024 + (ob ^ (((ob >> 9) & 1) << 5)); }
__host__ __device__ __forceinline__ void stage_rc(int b, int& R, int& C) { const int st = b / 1024, sb = b % 1024, swz = sb ^ (((sb >> 9) & 1) << 5); R = (st >> 1) * 16 + swz / 64; C = (st & 1) * 32 + (swz % 64) / 2; }
__host__ __device__ __forceinline__ int perm32(int rho) { const int n = rho >> 4, i = rho & 15; return 8 * (i >> 2) + 4 * n + (i & 3); }

struct Unit { int pm, pn; };
struct Gemm { const bf16_t* A; const bf16_t* Bt; int M, N, K; };

struct StaticOrder {
    int nM, nN, nwg, G, c;
    __host__ __device__ void init(int M, int N, int G_, int c_) { nM = M / BM; nN = N / BM; nwg = nM * nN; G = G_; c = c_; }
    __host__ __device__ bool next(int i, Unit& u) const {
        const long L = (long)i * G + c; if (L >= nwg) return false;
        int wgid = (int)L; { const int q = nwg / NXCD, r = nwg % NXCD, xcd = wgid % NXCD, off = wgid / NXCD; wgid = (xcd < r ? xcd * (q + 1) : r * (q + 1) + (xcd - r) * q) + off; }
        const int nig = WGM * nN, gid = wgid / nig, fm = gid * WGM, gsz = (nM - fm) < WGM ? (nM - fm) : WGM;
        u.pm = fm + ((wgid % nig) % gsz); u.pn = (wgid % nig) / gsz; return true;
    }
    __device__ __forceinline__ void a_ready(const Unit&) const {}
    __device__ __forceinline__ void done(const Unit&) const {}
};
__device__ __forceinline__ unsigned cvt_pk_bf16(float lo, float hi) { unsigned r; asm volatile("v_cvt_pk_bf16_f32 %0, %1, %2" : "=v"(r) : "v"(lo), "v"(hi)); return r; }
struct EpiProj {
    static constexpr bool PERM = true, AFTER_DRAIN = false;
    bf16_t* O; int ldc; const float* rstd;
    __device__ __forceinline__ void operator()(const f32x4 (&acc)[2][2][4][2], const Unit& u, int wr, int wc, int fr, int fq) const {
        const int row0 = u.pm * BM + wr * 64 + fr, col0 = u.pn * BM + wc * 32 + 8 * fq;
#pragma unroll
        for (int ai = 0; ai < 2; ++ai)
#pragma unroll
            for (int m = 0; m < 4; ++m) { const int row = row0 + ai * HALF + m * 16; const float s = rstd[row]; bf16_t* rowp = O + (size_t)row * ldc + col0;
#pragma unroll
                for (int bj = 0; bj < 2; ++bj) { const f32x4 v0 = acc[ai][bj][m][0] * s, v1 = acc[ai][bj][m][1] * s;
                    u32x4 w; w.x = cvt_pk_bf16(v0[0], v0[1]); w.y = cvt_pk_bf16(v0[2], v0[3]); w.z = cvt_pk_bf16(v1[0], v1[1]); w.w = cvt_pk_bf16(v1[2], v1[3]);
                    *(u32x4*)(rowp + bj * HALF) = w; } }
    }
};
struct EpiF32 {
    static constexpr bool PERM = false, AFTER_DRAIN = false;
    float* O; int ldc;
    __device__ __forceinline__ void operator()(const f32x4 (&acc)[2][2][4][2], const Unit& u, int wr, int wc, int fr, int fq) const {
        const int row0 = u.pm * BM + wr * 64 + fr, col0 = u.pn * BM + wc * 32 + 4 * fq;
#pragma unroll
        for (int ai = 0; ai < 2; ++ai)
#pragma unroll
            for (int m = 0; m < 4; ++m) { float* rowp = O + (size_t)(row0 + ai * HALF + m * 16) * ldc + col0;
#pragma unroll
                for (int bj = 0; bj < 2; ++bj)
#pragma unroll
                    for (int n = 0; n < 2; ++n) *(f32x4*)(rowp + bj * HALF + n * 16) = acc[ai][bj][m][n]; }
    }
};
struct EpiBf16Plain {
    static constexpr bool PERM = true, AFTER_DRAIN = false;
    bf16_t* O; int ldc;
    __device__ __forceinline__ void operator()(const f32x4 (&acc)[2][2][4][2], const Unit& u, int wr, int wc, int fr, int fq) const {
        const int row0 = u.pm * BM + wr * 64 + fr, col0 = u.pn * BM + wc * 32 + 8 * fq;
#pragma unroll
        for (int ai = 0; ai < 2; ++ai)
#pragma unroll
            for (int m = 0; m < 4; ++m) { bf16_t* rowp = O + (size_t)(row0 + ai * HALF + m * 16) * ldc + col0;
#pragma unroll
                for (int bj = 0; bj < 2; ++bj) { const f32x4 v0 = acc[ai][bj][m][0], v1 = acc[ai][bj][m][1];
                    u32x4 w; w.x = cvt_pk_bf16(v0[0], v0[1]); w.y = cvt_pk_bf16(v0[2], v0[3]); w.z = cvt_pk_bf16(v1[0], v1[1]); w.w = cvt_pk_bf16(v1[2], v1[3]);
                    *(u32x4*)(rowp + bj * HALF) = w; } }
    }
};
struct PanelSsq {
    float* slots;
    unsigned* cnt;
    unsigned* tmo;
    float eps;
    __device__ __forceinline__ bool run(const f32x4 (&v)[2][2][4][2], int row_base, int pn, int wr, int wc, int fr, int fq, PG8_LAS unsigned char* lds, int wid, int lane) const {
        PG8_LAS float* P = (PG8_LAS float*)lds;
        PG8_LAS float* S = (PG8_LAS float*)(lds + 8192);
        PG8_LAS unsigned* flag = (PG8_LAS unsigned*)(lds + 8192 + 2048);
#pragma unroll
        for (int ai = 0; ai < 2; ++ai)
#pragma unroll
            for (int m = 0; m < 4; ++m) {
                float s = 0.f;
#pragma unroll
                for (int bj = 0; bj < 2; ++bj)
#pragma unroll
                    for (int n = 0; n < 2; ++n) { const f32x4 x = v[ai][bj][m][n]; s += (x[0] * x[0] + x[1] * x[1]) + (x[2] * x[2] + x[3] * x[3]); }
                s += __shfl_xor(s, 16); s += __shfl_xor(s, 32);
                if (fq == 0) P[(ai * HALF + wr * 64 + m * 16 + fr) * 4 + wc] = s;
            }
        asm volatile("s_waitcnt lgkmcnt(0)" ::: "memory"); __builtin_amdgcn_s_barrier(); asm volatile("" ::: "memory");
        const int row = wid * 32 + (lane & 31);
        if (lane < 32) { const float t = (P[row * 4 + 0] + P[row * 4 + 1]) + (P[row * 4 + 2] + P[row * 4 + 3]);
            __hip_atomic_store(slots + (size_t)(row_base + row) * 4 + pn, t, __ATOMIC_RELAXED, __HIP_MEMORY_SCOPE_AGENT); }
        asm volatile("s_waitcnt vmcnt(0)" ::: "memory");
        if (lane == 0) __hip_atomic_fetch_add(cnt, 1u, __ATOMIC_RELAXED, __HIP_MEMORY_SCOPE_AGENT);
        if (wid == 0) {
            bool dead = false; const unsigned long long t0 = __builtin_amdgcn_s_memrealtime();
            for (;;) {
                if ((unsigned)__builtin_amdgcn_readfirstlane(__hip_atomic_load(cnt, __ATOMIC_RELAXED, __HIP_MEMORY_SCOPE_AGENT)) >= 32u) break;
                if (__builtin_amdgcn_s_memrealtime() - t0 > 2000000ull) { if (lane == 0) __hip_atomic_store(tmo, 1u, __ATOMIC_RELAXED, __HIP_MEMORY_SCOPE_AGENT); dead = true; break; }
                __builtin_amdgcn_s_sleep(2);
            }
            __builtin_amdgcn_fence(__ATOMIC_ACQUIRE, "agent");
            if (lane == 0) flag[0] = dead ? 1u : 0u;
        }
        asm volatile("s_waitcnt vmcnt(0) lgkmcnt(0)" ::: "memory"); __builtin_amdgcn_s_barrier(); asm volatile("" ::: "memory");
        const bool bad = flag[0] != 0u;
        if (lane < 32) { const float* sl = slots + (size_t)(row_base + row) * 4; float t = 0.f;
#pragma unroll
            for (int k = 0; k < 4; ++k) t += __hip_atomic_load(sl + k, __ATOMIC_RELAXED, __HIP_MEMORY_SCOPE_AGENT);
            S[row] = 1.0f / sqrtf(t * (1.0f / 1024.0f) + eps); }
        asm volatile("s_waitcnt lgkmcnt(0)" ::: "memory"); __builtin_amdgcn_s_barrier(); asm volatile("" ::: "memory");
        return bad;
    }
};
struct EpiRmsRes {
    static constexpr bool PERM = false, AFTER_DRAIN = true;
    const float* base; float* out; bf16_t* xb; const float* gain; int ldc; int row_off; PanelSsq st; unsigned* cnt_base;
    __device__ __forceinline__ void fused(f32x4 (&acc)[2][2][4][2], const Unit& u, int wr, int wc, int fr, int fq, PG8_LAS unsigned char* lds, int wid, int lane) const {
        typedef unsigned u32x2v __attribute__((ext_vector_type(2)));
        PanelSsq s2 = st; s2.cnt = cnt_base + 16 * u.pm;
        const int rowb = row_off + u.pm * BM;
        const bool bad = s2.run(acc, rowb, u.pn, wr, wc, fr, fq, lds, wid, lane);
        const PG8_LAS float* S = (const PG8_LAS float*)(lds + 8192);
        const int col0 = u.pn * BM + wc * 32 + 4 * fq;
        const float qnan = __builtin_nanf("");
        f32x4 gv[2][2];
#pragma unroll
        for (int bj = 0; bj < 2; ++bj)
#pragma unroll
            for (int n = 0; n < 2; ++n) gv[bj][n] = *(const f32x4*)(gain + col0 + bj * HALF + n * 16);
#pragma unroll
        for (int ai = 0; ai < 2; ++ai)
#pragma unroll
            for (int m = 0; m < 4; ++m) { const int r = ai * HALF + wr * 64 + m * 16 + fr; const float rs = S[r]; const size_t off = (size_t)(rowb + r) * ldc + col0;
#pragma unroll
                for (int bj = 0; bj < 2; ++bj)
#pragma unroll
                    for (int n = 0; n < 2; ++n) { const f32x4 bs = *(const f32x4*)(base + off + bj * HALF + n * 16); f32x4 o = bs + acc[ai][bj][m][n] * rs * gv[bj][n];
                        if (bad) o = (f32x4){qnan, qnan, qnan, qnan};
                        *(f32x4*)(out + off + bj * HALF + n * 16) = o;
                        if (xb) { u32x2v w; w.x = cvt_pk_bf16(o[0], o[1]); w.y = cvt_pk_bf16(o[2], o[3]); *(u32x2v*)(xb + off + bj * HALF + n * 16) = w; } }
                if (m & 1) asm volatile("" ::: "memory"); }
    }
};
template <class Epi, class Sched, bool ALIGN_EPI = false, bool SP2 = false>
__device__ __forceinline__ void gemm_phase(PG8_LAS unsigned char* lds, const Gemm g, const Sched& S, const Epi& E) {
    const int tid = TIDX(), wid = __builtin_amdgcn_readfirstlane(tid >> 6), lane = tid & 63, wr = wid >> 2, wc = wid & 3, fr = lane & 15, fq = lane >> 4;
    const int K = g.K, nt = K / BK;
    unsigned voffA[2], voffB[2];
#pragma unroll
    for (int i = 0; i < 2; ++i) { int R, C; stage_rc(tid * 16 + i * 8192, R, C); const int Rb = Epi::PERM ? ((R & ~31) + perm32(R & 31)) : R;
        voffA[i] = (unsigned)(R * K + C) * 2u; voffB[i] = (unsigned)(Rb * K + C) * 2u; }
    const size_t kstep = (size_t)(BK * 2);
    const size_t hstep = (size_t)HALF * K * 2;
    const size_t tstep = 2 * hstep;
    const unsigned ldsw = (unsigned)wid * 1024u;
    const int aoff = lds_byte(wr * 64 + fr, fq * 8), boff = lds_byte(wc * 32 + fr, fq * 8);
#define PG8_SA(b, h) (((b) * 2 + (h)) * HTB)
#define PG8_SB(b, h) ((4 + (b) * 2 + (h)) * HTB)
#define PG8_STAGE(bufoff, gbase, voff) do { _Pragma("unroll") for (int _i = 0; _i < 2; ++_i) \
        __builtin_amdgcn_global_load_lds((const unsigned*)((const char*)(gbase) + (voff)[_i]), (PG8_LAS unsigned*)(lds + (bufoff) + ldsw + _i * 8192), 16, 0, 0); } while (0)
#define PG8_LDA(dst, b, h) do { _Pragma("unroll") for (int m = 0; m < 4; ++m) _Pragma("unroll") for (int k = 0; k < 2; ++k) dst[m][k] = *(const PG8_LAS bf16x8*)(lds + PG8_SA(b, h) + aoff + m * 2048 + k * 1024); } while (0)
#define PG8_LDB(dst, b, h) do { _Pragma("unroll") for (int n = 0; n < 2; ++n) _Pragma("unroll") for (int k = 0; k < 2; ++k) dst[n][k] = *(const PG8_LAS bf16x8*)(lds + PG8_SB(b, h) + boff + n * 2048 + k * 1024); } while (0)
#define PG8_MMA(ai, bj, At, Bt) do { __builtin_amdgcn_s_setprio(1); _Pragma("unroll") for (int m = 0; m < 4; ++m) _Pragma("unroll") for (int n = 0; n < 2; ++n) _Pragma("unroll") for (int k = 0; k < 2; ++k) \
        acc[ai][bj][m][n] = __builtin_amdgcn_mfma_f32_16x16x32_bf16(Bt[n][k], At[m][k], acc[ai][bj][m][n], 0, 0, 0); __builtin_amdgcn_s_setprio(0); } while (0)
#define PG8_WAIT_V(n) asm volatile("s_waitcnt vmcnt(" #n ")" ::: "memory")
#define PG8_WAIT_L(n) asm volatile("s_waitcnt lgkmcnt(" #n ")" ::: "memory")
#define PG8_BAR __builtin_amdgcn_s_barrier()
#define PG8_SCHED __builtin_amdgcn_sched_barrier(0)
    Unit cur, nxt; int ui = 0;
    if (!S.next(0, cur)) return;
    f32x4 acc[2][2][4][2];
#pragma unroll
    for (int a = 0; a < 2; ++a)
#pragma unroll
        for (int b = 0; b < 2; ++b)
#pragma unroll
            for (int m = 0; m < 4; ++m)
#pragma unroll
                for (int n = 0; n < 2; ++n) acc[a][b][m][n] = (f32x4){0.f, 0.f, 0.f, 0.f};
    bf16x8 At[4][2], B0[2][2], B1[2][2];
    const char* cA = (const char*)g.A + (size_t)cur.pm * tstep; const char* cB = (const char*)g.Bt + (size_t)cur.pn * tstep;
    S.a_ready(cur);
    if constexpr (SP2) {
        PG8_STAGE(PG8_SB(0, 0), cB, voffB); PG8_STAGE(PG8_SB(0, 1), cB + hstep, voffB); PG8_STAGE(PG8_SA(0, 0), cA, voffA); PG8_STAGE(PG8_SA(0, 1), cA + hstep, voffA);
        if (wr == 1) PG8_BAR;
        PG8_WAIT_V(2); PG8_BAR;
        PG8_STAGE(PG8_SB(1, 0), cB + kstep, voffB); PG8_STAGE(PG8_SA(1, 0), cA + kstep, voffA); PG8_STAGE(PG8_SB(1, 1), cB + hstep + kstep, voffB);
        PG8_WAIT_V(6); PG8_BAR;
    } else {
        PG8_STAGE(PG8_SB(0, 0), cB, voffB); PG8_STAGE(PG8_SA(0, 0), cA, voffA); PG8_STAGE(PG8_SB(0, 1), cB + hstep, voffB); PG8_STAGE(PG8_SA(0, 1), cA + hstep, voffA);
        if (wr == 1) PG8_BAR;
        PG8_WAIT_V(4); PG8_BAR;
        PG8_STAGE(PG8_SB(1, 0), cB + kstep, voffB); PG8_STAGE(PG8_SA(1, 0), cA + kstep, voffA); PG8_STAGE(PG8_SB(1, 1), cB + hstep + kstep, voffB);
        PG8_WAIT_V(6); PG8_BAR;
    }
    for (;;) {
        const bool has_next = S.next(ui + 1, nxt);
        const char* nA = has_next ? (const char*)g.A + (size_t)nxt.pm * tstep : cA; const char* nB = has_next ? (const char*)g.Bt + (size_t)nxt.pn * tstep : cB;
        for (int t = 0; t < nt; t += 2) {
            const bool last = (t == nt - 2);
            const char* a1 = cA + (size_t)(t + 1) * kstep;
            const char* a2 = last ? nA : cA + (size_t)(t + 2) * kstep; const char* b2 = last ? nB : cB + (size_t)(t + 2) * kstep;
            const char* a3 = a2 + kstep; const char* b3 = b2 + kstep;
            if (last && has_next) S.a_ready(nxt);
            if constexpr (SP2) {
            PG8_LDB(B0, 0, 0); PG8_LDB(B1, 0, 1); PG8_SCHED; PG8_LDA(At, 0, 0); PG8_STAGE(PG8_SA(1, 1), a1 + hstep, voffA);
            PG8_WAIT_V(8); PG8_WAIT_L(0); PG8_BAR; PG8_MMA(0, 0, At, B0); PG8_MMA(0, 1, At, B1); PG8_BAR; PG8_SCHED;
            PG8_LDA(At, 0, 1); PG8_STAGE(PG8_SB(0, 0), b2, voffB); PG8_STAGE(PG8_SB(0, 1), b2 + hstep, voffB); PG8_STAGE(PG8_SA(0, 0), a2, voffA);
            PG8_WAIT_V(8); PG8_WAIT_L(0); PG8_BAR; PG8_MMA(1, 0, At, B0); PG8_MMA(1, 1, At, B1); PG8_BAR; PG8_SCHED;
            PG8_LDB(B0, 1, 0); PG8_LDB(B1, 1, 1); PG8_SCHED; PG8_LDA(At, 1, 0); PG8_STAGE(PG8_SA(0, 1), a2 + hstep, voffA);
            PG8_WAIT_V(8); PG8_WAIT_L(0); PG8_BAR; PG8_MMA(0, 0, At, B0); PG8_MMA(0, 1, At, B1); PG8_BAR; PG8_SCHED;
            PG8_LDA(At, 1, 1); PG8_STAGE(PG8_SB(1, 0), b3, voffB); PG8_STAGE(PG8_SB(1, 1), b3 + hstep, voffB); PG8_STAGE(PG8_SA(1, 0), a3, voffA);
            PG8_WAIT_V(8); PG8_WAIT_L(0); PG8_BAR; PG8_MMA(1, 0, At, B0); PG8_MMA(1, 1, At, B1); PG8_BAR; PG8_SCHED;
            } else {
            PG8_LDB(B0, 0, 0); PG8_SCHED; PG8_LDA(At, 0, 0); PG8_STAGE(PG8_SA(1, 1), a1 + hstep, voffA);
            PG8_WAIT_L(8); PG8_BAR; PG8_WAIT_L(0); PG8_MMA(0, 0, At, B0); PG8_BAR; PG8_SCHED;
            PG8_LDB(B1, 0, 1); PG8_STAGE(PG8_SB(0, 0), b2, voffB);
            PG8_BAR; PG8_WAIT_L(0); PG8_MMA(0, 1, At, B1); PG8_BAR;
            PG8_LDA(At, 0, 1); PG8_STAGE(PG8_SA(0, 0), a2, voffA);
            PG8_BAR; PG8_WAIT_L(0); PG8_MMA(1, 0, At, B0); PG8_BAR; PG8_SCHED;
            PG8_STAGE(PG8_SB(0, 1), b2 + hstep, voffB);
            PG8_WAIT_V(6); PG8_BAR; PG8_MMA(1, 1, At, B1); PG8_BAR;
            PG8_LDB(B0, 1, 0); PG8_SCHED; PG8_LDA(At, 1, 0); PG8_STAGE(PG8_SA(0, 1), a2 + hstep, voffA);
            PG8_WAIT_L(8); PG8_BAR; PG8_WAIT_L(0); PG8_MMA(0, 0, At, B0); PG8_BAR; PG8_SCHED;
            PG8_LDB(B1, 1, 1); PG8_STAGE(PG8_SB(1, 0), b3, voffB);
            PG8_BAR; PG8_WAIT_L(0); PG8_MMA(0, 1, At, B1); PG8_BAR;
            PG8_LDA(At, 1, 1); PG8_STAGE(PG8_SA(1, 0), a3, voffA);
            PG8_BAR; PG8_WAIT_L(0); PG8_MMA(1, 0, At, B0); PG8_BAR; PG8_SCHED;
            PG8_STAGE(PG8_SB(1, 1), b3 + hstep, voffB);
            PG8_WAIT_V(6); PG8_BAR; PG8_MMA(1, 1, At, B1); PG8_BAR;
            }
        }
        if constexpr (ALIGN_EPI) { if (wr == 0) PG8_BAR; }
        if constexpr (!Epi::AFTER_DRAIN) { E(acc, cur, wr, wc, fr, fq); S.done(cur); }
        if (!has_next) break;
#pragma unroll
        for (int a = 0; a < 2; ++a)
#pragma unroll
            for (int b = 0; b < 2; ++b)
#pragma unroll
                for (int m = 0; m < 4; ++m)
#pragma unroll
                    for (int n = 0; n < 2; ++n) acc[a][b][m][n] = (f32x4){0.f, 0.f, 0.f, 0.f};
        cur = nxt; cA = nA; cB = nB; ++ui;
        if constexpr (ALIGN_EPI) { if (wr == 1) PG8_BAR; }
    }
    PG8_WAIT_V(0);
    if constexpr (!ALIGN_EPI) { if (wr == 0) PG8_BAR; }
    PG8_BAR;
    if constexpr (Epi::AFTER_DRAIN) { E.fused(acc, cur, wr, wc, fr, fq, lds, wid, lane); S.done(cur); }
#undef PG8_SA
#undef PG8_SB
#undef PG8_STAGE
#undef PG8_LDA
#undef PG8_LDB
#undef PG8_MMA
#undef PG8_WAIT_V
#undef PG8_WAIT_L
#undef PG8_BAR
#undef PG8_SCHED
}
}

#define LAS __attribute__((address_space(3)))
typedef unsigned short bf16;
typedef unsigned v4u __attribute__((ext_vector_type(4)));
typedef unsigned v2u __attribute__((ext_vector_type(2)));
typedef float f4 __attribute__((ext_vector_type(4)));
constexpr int DM = 1024, NB = 16, SEQ = 2048, DEPTH = 2, NTOK = NB * SEQ;
constexpr int GW = 256, NH = 4, HD = 64;
constexpr int INC = 4104;
constexpr int PC = 4096;
constexpr int NT = 512, NWAVES = 8;
constexpr float EPS = 1e-6f;
constexpr int C_GQ = 0, C_GK = 256, C_GV = 512, C_GZ = 768;
constexpr int C_HQ = 1024, C_HF = 1280, C_HI = 1536, C_HZ = 1792;
constexpr int C_MQ = 2048, C_MK = 2304, C_MV = 2560, C_MZ = 2816;
constexpr int C_DQ = 3072, C_DK = 3328, C_DV = 3584, C_DZ = 3840;
constexpr int LDS_BYTES = 147456;

constexpr size_t MiB = 1u << 20;
constexpr size_t WS_CTL = 0;
constexpr size_t WS_PROJ = 1 * MiB;
constexpr size_t WS_XB = WS_PROJ + 256 * MiB;
constexpr size_t WS_Y = WS_XB + 64 * MiB;
constexpr size_t WS_WIN = WS_Y + 64 * MiB;
constexpr size_t WS_WOUT = WS_WIN + 16 * MiB;
constexpr size_t WS_RSTD = WS_WOUT + 4 * MiB;
constexpr size_t WS_AB = WS_RSTD + 1 * MiB;
constexpr size_t WS_KMEAN = WS_AB + 1 * MiB;
constexpr size_t WS_SCR = WS_KMEAN + 1 * MiB;
constexpr size_t WS_END = WS_SCR + 104 * MiB;

struct Params {
    const float* x; const float* pre_g; const float* post_g; const float* w_in; const float* conv_w;
    const float* a_log; const float* dt_bias; const float* gdn_g; const float* hgrn_lb; const float* hgrn_g;
    const float* lq1; const float* lk1; const float* lq2; const float* lk2; const float* diff_g; const float* w_out;
    float* out; unsigned char* ws;
};

__device__ __forceinline__ float sigmoidf_(float x) { return 1.0f / (1.0f + expf(-x)); }
__device__ __forceinline__ float siluf_(float x) { return x / (1.0f + expf(-x)); }
__device__ __forceinline__ float softplusf_(float x) { return fmaxf(x, 0.f) + log1pf(expf(-fabsf(x))); }
__device__ __forceinline__ float fexp(float x) { return __builtin_amdgcn_exp2f(x * 1.4426950408889634f); }
__device__ __forceinline__ float fsigmoid(float x) { return __builtin_amdgcn_rcpf(1.0f + fexp(-x)); }
__device__ __forceinline__ float fsilu(float x) { return x * fsigmoid(x); }
__device__ __forceinline__ float fsoftplus(float x) { return fmaxf(x, 0.f) + 0.6931471805599453f * __builtin_amdgcn_logf(1.0f + fexp(-fabsf(x))); }
__device__ __forceinline__ float dpp_row16_sum(float v) {
    v += __int_as_float(__builtin_amdgcn_update_dpp(0, __float_as_int(v), 0xB1, 0xF, 0xF, true));
    v += __int_as_float(__builtin_amdgcn_update_dpp(0, __float_as_int(v), 0x4E, 0xF, 0xF, true));
    v += __int_as_float(__builtin_amdgcn_update_dpp(0, __float_as_int(v), 0x141, 0xF, 0xF, true));
    v += __int_as_float(__builtin_amdgcn_update_dpp(0, __float_as_int(v), 0x140, 0xF, 0xF, true));
    return v;
}
__device__ __forceinline__ float wave_sum(float v);
__device__ __forceinline__ float xor32_sum(float v) { const auto rr = __builtin_amdgcn_permlane32_swap(__float_as_uint(v), __float_as_uint(v), false, false); return __uint_as_float(rr[0]) + __uint_as_float(rr[1]); }
__device__ __forceinline__ float xor32_max(float v) { const auto rr = __builtin_amdgcn_permlane32_swap(__float_as_uint(v), __float_as_uint(v), false, false); return fmaxf(__uint_as_float(rr[0]), __uint_as_float(rr[1])); }
__device__ __forceinline__ float fwave_sum(float v) { v = dpp_row16_sum(v);
    return (__int_as_float(__builtin_amdgcn_readlane(__float_as_int(v), 0)) + __int_as_float(__builtin_amdgcn_readlane(__float_as_int(v), 16))) + (__int_as_float(__builtin_amdgcn_readlane(__float_as_int(v), 32)) + __int_as_float(__builtin_amdgcn_readlane(__float_as_int(v), 48))); }
__device__ __forceinline__ float bf2f(bf16 v) { return __uint_as_float((unsigned)v << 16); }
__device__ __forceinline__ unsigned pk2(float lo, float hi) { typedef float f2_ __attribute__((ext_vector_type(2))); typedef __bf16 b2_ __attribute__((ext_vector_type(2))); const f2_ v = {lo, hi}; return __builtin_bit_cast(unsigned, __builtin_convertvector(v, b2_)); }
__device__ __forceinline__ unsigned f2bf(float f) { return pk2(f, 0.f) & 0xffffu; }
__device__ __forceinline__ float rlane(float v, int l) { return __int_as_float(__builtin_amdgcn_readlane(__float_as_int(v), l)); }

__device__ __forceinline__ void transpose_item(const float* W, int ldw, int K, const float* gk, bf16* WT, int n_src0, int n_dst0, int k0, LAS float* scr, int lane) {
#pragma unroll 8
    for (int i = 0; i < 32; ++i) { const int kk = 2 * i + (lane >> 5); float v = W[(size_t)(k0 + kk) * ldw + n_src0 + (lane & 31)]; if (gk) v *= gk[k0 + kk]; scr[kk * 33 + (lane & 31)] = v; }
    asm volatile("s_waitcnt lgkmcnt(0)" ::: "memory");
    const int c = lane & 7;
#pragma unroll
    for (int j = 0; j < 4; ++j) { const int n = (lane >> 3) + 8 * j; const LAS float* s = scr + (8 * c) * 33 + n;
        v4u o; o.x = pk2(s[0 * 33], s[1 * 33]); o.y = pk2(s[2 * 33], s[3 * 33]); o.z = pk2(s[4 * 33], s[5 * 33]); o.w = pk2(s[6 * 33], s[7 * 33]);
        *(v4u*)(WT + (size_t)(n_dst0 + n) * K + k0 + 8 * c) = o; }
    asm volatile("s_waitcnt lgkmcnt(0)" ::: "memory");
}
__device__ __forceinline__ void load_wab(const Params& p, int l, LAS float* wab) {
    const float* W = p.w_in + (size_t)l * DM * INC; const float* g = p.pre_g + l * DM;
    for (int i = TIDX(); i < 8 * DM; i += NT) { const int k = i >> 3, j = i & 7; wab[j * DM + k] = W[(size_t)k * INC + 768 + j] * g[k]; }
}
__device__ __forceinline__ void row_prep(const float4 (&v)[4], int row, int lane, bf16* xb, float* rstd, float* ab, const LAS float* wab) {
    float ss = 0.f;
#pragma unroll
    for (int j = 0; j < 4; ++j) ss += v[j].x * v[j].x + v[j].y * v[j].y + v[j].z * v[j].z + v[j].w * v[j].w;
    ss = wave_sum(ss);
    const float rs = rsqrtf(ss * (1.0f / DM) + EPS);
    v2u* o8 = (v2u*)(xb + (size_t)row * DM) + lane;
#pragma unroll
    for (int j = 0; j < 4; ++j) { v2u w; w.x = pk2(v[j].x, v[j].y); w.y = pk2(v[j].z, v[j].w); o8[64 * j] = w; }
    float acc[8];
#pragma unroll
    for (int j8 = 0; j8 < 8; ++j8) { float a = 0.f;
#pragma unroll
        for (int j = 0; j < 4; ++j) { const f4 w = *(const LAS f4*)(wab + j8 * DM + 256 * j + 4 * lane); a += v[j].x * w.x + v[j].y * w.y + v[j].z * w.z + v[j].w * w.w; }
        acc[j8] = wave_sum(a); }
    if (lane == 0) { rstd[row] = rs;
        *(float4*)(ab + (size_t)row * 8) = make_float4(acc[0] * rs, acc[1] * rs, acc[2] * rs, acc[3] * rs);
        *(float4*)(ab + (size_t)row * 8 + 4) = make_float4(acc[4] * rs, acc[5] * rs, acc[6] * rs, acc[7] * rs); }
}

__device__ __forceinline__ void phase_prologue(const Params& p, LAS unsigned char* lds) {
    const int lane = TIDX() & 63, wave = TIDX() >> 6;
    LAS float* wab = (LAS float*)lds;
    load_wab(p, 0, wab);
    __syncthreads();
    LAS float* scr = (LAS float*)(lds + 32768 + wave * 12288);
    const int gw = BIDX() * NWAVES + wave, NGW = gridDim.x * NWAVES;
    bf16* win_t = (bf16*)(p.ws + WS_WIN); bf16* wout_t = (bf16*)(p.ws + WS_WOUT);
    constexpr int I_IN = (DM / 64) * (PC / 32), I_OUT = (DM / 64) * (DM / 32);
    for (int it = gw; it < DEPTH * (I_IN + I_OUT); it += NGW) {
        int r = it; const int l = r / (I_IN + I_OUT); r -= l * (I_IN + I_OUT);
        if (r < I_IN) { const int kb = r / (PC / 32), nb = r % (PC / 32), n0 = 32 * nb;
            transpose_item(p.w_in + (size_t)l * DM * INC, INC, DM, p.pre_g + l * DM, win_t + (size_t)l * PC * DM, n0 + (n0 >= 768 ? 8 : 0), n0, 64 * kb, scr, lane); }
        else { r -= I_IN; const int kb = r / (DM / 32), nb = r % (DM / 32);
            transpose_item(p.w_out + (size_t)l * DM * DM, DM, DM, nullptr, wout_t + (size_t)l * DM * DM, 32 * nb, 32 * nb, 64 * kb, scr, lane); }
    }
    bf16* xb = (bf16*)(p.ws + WS_XB); float* rstd = (float*)(p.ws + WS_RSTD); float* ab = (float*)(p.ws + WS_AB);
    for (int row = gw; row < NTOK; row += NGW) {
        const float4* xr = (const float4*)(p.x + (size_t)row * DM) + lane;
        float4 v[4];
#pragma unroll
        for (int j = 0; j < 4; ++j) v[j] = xr[64 * j];
        row_prep(v, row, lane, xb, rstd, ab, wab);
    }
}

__device__ __forceinline__ void phase_post(const Params& p, int l, LAS unsigned char* lds) {
    const int lane = TIDX() & 63, wave = TIDX() >> 6;
    LAS float* wab = (LAS float*)lds;
    const bool more = (l + 1 < DEPTH);
    if (more) load_wab(p, l + 1, wab);
    __syncthreads();
    const int gw = BIDX() * NWAVES + wave, NGW = gridDim.x * NWAVES;
    const float* xin = (l == 0) ? p.x : p.out;
    const float* g = p.post_g + l * DM;
    bf16* xb = (bf16*)(p.ws + WS_XB); float* rstd = (float*)(p.ws + WS_RSTD); float* ab = (float*)(p.ws + WS_AB);
    for (int row = gw; row < NTOK; row += NGW) {
        const v2u* yr = (const v2u*)((const bf16*)(p.ws + WS_PROJ) + (size_t)row * DM) + lane;
        const float4* xr = (const float4*)(xin + (size_t)row * DM) + lane;
        float4 v[4], xx[4]; float ss = 0.f;
#pragma unroll
        for (int j = 0; j < 4; ++j) { const v2u w = yr[64 * j]; xx[j] = xr[64 * j];
            v[j] = make_float4(__uint_as_float(w.x << 16), __uint_as_float(w.x & 0xffff0000u), __uint_as_float(w.y << 16), __uint_as_float(w.y & 0xffff0000u));
            ss += v[j].x * v[j].x + v[j].y * v[j].y + v[j].z * v[j].z + v[j].w * v[j].w; }
        ss = wave_sum(ss);
        const float rs = rsqrtf(ss * (1.0f / DM) + EPS);
        float4* orow = (float4*)(p.out + (size_t)row * DM) + lane;
#pragma unroll
        for (int j = 0; j < 4; ++j) { const float4 gg = ((const float4*)g)[lane + 64 * j];
            v[j] = make_float4(xx[j].x + v[j].x * rs * gg.x, xx[j].y + v[j].y * rs * gg.y, xx[j].z + v[j].z * rs * gg.z, xx[j].w + v[j].w * rs * gg.w);
            orow[64 * j] = v[j]; }
        if (more) row_prep(v, row, lane, xb, rstd, ab, wab);
    }
}


__device__ __forceinline__ float wave_sum(float v) { return fwave_sum(v); }

__device__ __forceinline__ void phase_post2(const Params& p, int l, LAS unsigned char* lds) {
    const int lane = TIDX() & 63, wave = TIDX() >> 6;
    LAS float* wab = (LAS float*)lds;
    load_wab(p, l + 1, wab);
    __syncthreads();
    const int gw = BIDX() * NWAVES + wave, NGW = gridDim.x * NWAVES;
    const bf16* xb = (const bf16*)(p.ws + WS_XB); float* rstd = (float*)(p.ws + WS_RSTD); float* ab = (float*)(p.ws + WS_AB);
    for (int row = gw; row < NTOK; row += NGW) {
        const v2u* xr = (const v2u*)(xb + (size_t)row * DM) + lane;
        float4 v[4]; float ss = 0.f;
#pragma unroll
        for (int j = 0; j < 4; ++j) { const v2u w = xr[64 * j];
            v[j] = make_float4(__uint_as_float(w.x << 16), __uint_as_float(w.x & 0xffff0000u), __uint_as_float(w.y << 16), __uint_as_float(w.y & 0xffff0000u));
            ss += v[j].x * v[j].x + v[j].y * v[j].y + v[j].z * v[j].z + v[j].w * v[j].w; }
        ss = wave_sum(ss);
        const float rs = rsqrtf(ss * (1.0f / DM) + EPS);
        float acc[8];
#pragma unroll
        for (int j8 = 0; j8 < 8; ++j8) { float a = 0.f;
#pragma unroll
            for (int j = 0; j < 4; ++j) { const f4 w = *(const LAS f4*)(wab + j8 * DM + 256 * j + 4 * lane); a += v[j].x * w.x + v[j].y * w.y + v[j].z * w.z + v[j].w * w.w; }
            acc[j8] = wave_sum(a); }
        if (lane == 0) { rstd[row] = rs;
            *(float4*)(ab + (size_t)row * 8) = make_float4(acc[0] * rs, acc[1] * rs, acc[2] * rs, acc[3] * rs);
            *(float4*)(ab + (size_t)row * 8 + 4) = make_float4(acc[4] * rs, acc[5] * rs, acc[6] * rs, acc[7] * rs); }
    }
}
#define XB_TMO      128
#define XB_XCNT(j)  (256  + 64 * (j))
#define XB_XSUB(j)  (1280 + 64 * (j))
#define XB_XGEN(j)  (2304 + 64 * (j))
#define XB_TOP      3328
#define XB_TOPGEN   3392
#define XCD_BAR_WORDS 3456
#define XB_SPIN_CAP (1u << 18)

__device__ __forceinline__ unsigned xb_ld(unsigned* p)              { return __hip_atomic_load(p, __ATOMIC_RELAXED, __HIP_MEMORY_SCOPE_AGENT); }
__device__ __forceinline__ unsigned xb_add(unsigned* p, unsigned v) { return __hip_atomic_fetch_add(p, v, __ATOMIC_RELAXED, __HIP_MEMORY_SCOPE_AGENT); }
__device__ __forceinline__ unsigned xb_xcc_id() { return (unsigned)__builtin_amdgcn_s_getreg((3 << 11) | 20) & 0xFu; }
#define XB_SPIN(cond, bar) do { unsigned _sp = 0; while (cond) { __builtin_amdgcn_s_sleep(1); \
    if ((++_sp & 255u) == 0u) { if (xb_ld(&(bar)[XB_TMO])) break; if (_sp > XB_SPIN_CAP) { atomicAdd(&(bar)[XB_TMO], 1u); break; } } } } while (0)

struct XcdBarrier {
    unsigned* bar; unsigned x;
    volatile LAS unsigned* st;
};

__device__ __forceinline__ XcdBarrier xcd_barrier_post(unsigned* bar, volatile LAS unsigned* st) {
    XcdBarrier b; b.bar = bar; b.x = xb_xcc_id(); b.st = st;
    if (TIDX() == 0) (void)xb_add(&bar[XB_XCNT(b.x)], 1u);
    return b;
}
__device__ __forceinline__ void xcd_barrier_complete(unsigned* bar, unsigned x, unsigned& nloc, unsigned& nx) {
    const unsigned G = gridDim.x * gridDim.y * gridDim.z;
    unsigned sum, cnt, mine, sp = 0u;
    for (;;) {
        sum = 0u; cnt = 0u; mine = 0u;
#pragma unroll
        for (unsigned j = 0; j < 16; ++j) { const unsigned c = xb_ld(&bar[XB_XCNT(j)]); sum += c; cnt += (c > 0u) ? 1u : 0u; mine = (j == x) ? c : mine; }
        if (sum == G) break;
        __builtin_amdgcn_s_sleep(1);
        if ((++sp & 255u) == 0u) { if (xb_ld(&bar[XB_TMO])) break; if (sp > XB_SPIN_CAP) { atomicAdd(&bar[XB_TMO], 1u); break; } }
    }
    nloc = mine > 0u ? mine : 1u; nx = cnt > 0u ? cnt : 1u;
}

__device__ __forceinline__ void xcd_barrier(const XcdBarrier& b) {
    asm volatile("s_waitcnt vmcnt(0)" ::: "memory");
    __syncthreads();
    if (TIDX() == 0) {
        unsigned* bar = b.bar;
        __builtin_amdgcn_s_waitcnt(0);
        unsigned nloc = b.st[0], nx = b.st[1];
        if (nloc == 0u) { xcd_barrier_complete(bar, b.x, nloc, nx); b.st[0] = nloc; b.st[1] = nx; }
        const unsigned old = xb_add(&bar[XB_XSUB(b.x)], 1u);
        const unsigned gen = old / nloc;
        if (old + 1u == (gen + 1u) * nloc) {
            __builtin_amdgcn_fence(__ATOMIC_RELEASE, "agent");
            asm volatile("s_waitcnt vmcnt(0)" ::: "memory");
            const unsigned og = xb_add(&bar[XB_TOP], 1u);
            const unsigned tg = og / nx;
            if (og + 1u == (tg + 1u) * nx) xb_add(&bar[XB_TOPGEN], 1u);
            else XB_SPIN(xb_ld(&bar[XB_TOPGEN]) == tg, bar);
            __builtin_amdgcn_fence(__ATOMIC_ACQUIRE, "agent");
            xb_add(&bar[XB_XGEN(b.x)], 1u);
            asm volatile("s_waitcnt vmcnt(0)" ::: "memory");
        } else {
            XB_SPIN(xb_ld(&bar[XB_XGEN(b.x)]) == gen, bar);
            __builtin_amdgcn_fence(__ATOMIC_ACQUIRE, "agent");
            asm volatile("s_waitcnt vmcnt(0)" ::: "memory");
        }
    }
    __syncthreads();
}

namespace att {
typedef short bf16x8 __attribute__((ext_vector_type(8)));
typedef short s16x4 __attribute__((ext_vector_type(4)));
typedef float f32x16 __attribute__((ext_vector_type(16)));
constexpr int KCH = 1024, VOFF = 8192, BUFB = 16384, NSLOT = 4;
constexpr float NEG = -1e30f, LOG2E = 1.4426950408889634f;
__device__ __forceinline__ void glds16(const void* gsrc, unsigned lds_dst) { unsigned keep;
    asm volatile("s_mov_b32 %0, m0\n\ts_mov_b32 m0, %2\n\ts_nop 0\n\tglobal_load_lds_dwordx4 %1, off\n\ts_mov_b32 m0, %0" : "=&s"(keep) : "v"(gsrc), "s"(lds_dst) : "memory"); }
__device__ __forceinline__ unsigned cvtpk(float lo, float hi) { typedef float f2 __attribute__((ext_vector_type(2))); typedef __bf16 b2 __attribute__((ext_vector_type(2))); f2 v = {lo, hi}; b2 b = __builtin_convertvector(v, b2); return __builtin_bit_cast(unsigned, b); }
__device__ __forceinline__ s16x4 vtr(const LAS unsigned char* p) { return __builtin_bit_cast(s16x4, __builtin_amdgcn_ds_read_tr16_b64_v4i16((LAS s16x4*)p)); }
__device__ __forceinline__ unsigned scale_pk(unsigned w, float c) { return cvtpk(__uint_as_float(w << 16) * c, __uint_as_float(w & 0xffff0000u) * c); }
__device__ __forceinline__ float max16(const f32x16& a) {
    float m0 = fmaxf(fmaxf(a[0], a[1]), fmaxf(a[2], a[3])), m1 = fmaxf(fmaxf(a[4], a[5]), fmaxf(a[6], a[7]));
    float m2 = fmaxf(fmaxf(a[8], a[9]), fmaxf(a[10], a[11])), m3 = fmaxf(fmaxf(a[12], a[13]), fmaxf(a[14], a[15]));
    return fmaxf(fmaxf(m0, m1), fmaxf(m2, m3));
}

template <int MODE>
__device__ __forceinline__ void attn_unit(const Params& p, int l, int b, int h, int qb, LAS unsigned char* lds) {
    constexpr int NMAP = MODE == 0 ? 2 : 1, NKS = MODE == 0 ? 2 : 4;
    const int tid = TIDX(), lane = tid & 63, wid = __builtin_amdgcn_readfirstlane(tid >> 6), r32 = lane & 31, hi = lane >> 5;
    const bf16* P = (const bf16*)(p.ws + WS_PROJ) + (size_t)b * SEQ * PC;
    const int QC = (MODE == 0 ? C_DQ : C_MQ) + h * 64, KC = (MODE == 0 ? C_DK : C_MK) + h * 64, VC = (MODE == 0 ? C_DV : C_MV) + h * 64, ZC = (MODE == 0 ? C_DZ : C_MZ) + h * 64;
    const float slope = exp2f(-(float)(MODE == 0 ? 2 * h + 1 : 2 * h + 2));
    const float sl2 = slope * LOG2E;
    const float c1 = (MODE == 0 ? 0.17677669529663687f : 0.125f) * LOG2E;
    const int q0 = qb * 256 + wid * 32, qpos = q0 + r32;
    bf16x8 qf[NMAP][NKS];
#pragma unroll
    for (int mp = 0; mp < NMAP; ++mp)
#pragma unroll
        for (int ks = 0; ks < NKS; ++ks) { const v4u raw = *(const v4u*)(P + (size_t)qpos * PC + QC + mp * 32 + ks * 16 + hi * 8);
            v4u s; s.x = scale_pk(raw.x, c1); s.y = scale_pk(raw.y, c1); s.z = scale_pk(raw.z, c1); s.w = scale_pk(raw.w, c1); qf[mp][ks] = __builtin_bit_cast(bf16x8, s); }
    const bf16* zrow = P + (size_t)qpos * PC + ZC;
    v2u zpre[2][4];
#pragma unroll
    for (int d = 0; d < 2; ++d)
#pragma unroll
        for (int g4 = 0; g4 < 4; ++g4) zpre[d][g4] = *(const v2u*)(zrow + d * 32 + 8 * g4 + 4 * hi);
    unsigned sel = 0;
    if (MODE == 1) {
        const float* km = (const float*)(p.ws + WS_KMEAN) + (size_t)((b * NH + h) * 8) * 256;
        LAS float* kml = (LAS float*)(lds + NSLOT * BUFB + 64);
        __syncthreads();
        if (tid < qb * 64) { const int jj = tid >> 6, dd = tid & 63; kml[tid] = (km[jj * 256 + dd] + km[jj * 256 + 64 + dd]) + (km[jj * 256 + 128 + dd] + km[jj * 256 + 192 + dd]); }
        __syncthreads();
        float g[7];
#pragma unroll
        for (int j = 0; j < 7; ++j) { g[j] = -INFINITY;
            if (j < qb) { float s = 0.f;
#pragma unroll
                for (int ks = 0; ks < NKS; ++ks) { const v4u qq = __builtin_bit_cast(v4u, qf[0][ks]); const f4 k0 = *(const LAS f4*)(kml + j * 64 + ks * 16 + hi * 8), k1 = *(const LAS f4*)(kml + j * 64 + ks * 16 + hi * 8 + 4);
                    s += __uint_as_float(qq.x << 16) * k0.x + __uint_as_float(qq.x & 0xffff0000u) * k0.y + __uint_as_float(qq.y << 16) * k0.z + __uint_as_float(qq.y & 0xffff0000u) * k0.w
                       + __uint_as_float(qq.z << 16) * k1.x + __uint_as_float(qq.z & 0xffff0000u) * k1.y + __uint_as_float(qq.w << 16) * k1.z + __uint_as_float(qq.w & 0xffff0000u) * k1.w; }
                g[j] = xor32_sum(s); } }
#pragma unroll
        for (int r = 0; r < 3; ++r) { float best = -INFINITY; int bi = -1;
#pragma unroll
            for (int j = 0; j < 7; ++j) if (j < qb && !((sel >> j) & 1u) && g[j] > best) { best = g[j]; bi = j; }
            if (bi >= 0) sel |= 1u << bi; }
    }
    f32x16 cr;
#pragma unroll
    for (int r = 0; r < 16; ++r) cr[r] = sl2 * (float)((r & 3) + 8 * (r >> 2) + 4 * hi);
    const bf16* ksrc = P + (size_t)lane * PC + KC + wid * 8;
    const bf16* vsrc = P + (size_t)(16 * (wid & 3) + (lane >> 2)) * PC + VC + (wid >> 2) * 32 + (lane & 3) * 8;
    const int kdst = wid * 1024, vdst = VOFF + wid * 1024;
    const unsigned lds0 = (unsigned)(uintptr_t)lds;
#define ATT_DMA(T_) do { const unsigned sl_ = lds0 + (unsigned)(((T_) & (NSLOT - 1)) * BUFB); \
        glds16(ksrc + (size_t)(T_) * 64 * PC, (unsigned)__builtin_amdgcn_readfirstlane(sl_ + kdst)); \
        glds16(vsrc + (size_t)(T_) * 64 * PC, (unsigned)__builtin_amdgcn_readfirstlane(sl_ + vdst)); } while (0)
    const int koff = hi * KCH + r32 * 16;
    const int voff = VOFF + ((lane >> 4) & 1) * 32 + (lane & 3) * 8 + (4 * hi + ((lane & 15) >> 2)) * 64;
    f32x16 O[NMAP][2];
    float m[NMAP], lsum[NMAP];
#pragma unroll
    for (int mp = 0; mp < NMAP; ++mp) { m[mp] = NEG; lsum[mp] = 0.f;
#pragma unroll
        for (int d = 0; d < 2; ++d)
#pragma unroll
            for (int r = 0; r < 16; ++r) O[mp][d][r] = 0.f; }
    const int Tlast = 4 * qb + 3;
    __syncthreads();
    ATT_DMA(Tlast); ATT_DMA(Tlast - 1); ATT_DMA(Tlast - 2);
    for (int T = Tlast; T >= 0; --T) {
        if (T >= 2) asm volatile("s_waitcnt vmcnt(4)" ::: "memory"); else if (T == 1) asm volatile("s_waitcnt vmcnt(2)" ::: "memory"); else asm volatile("s_waitcnt vmcnt(0)" ::: "memory");
        __builtin_amdgcn_s_barrier();
        asm volatile("" ::: "memory");
        if (T >= 3) ATT_DMA(T - 3);
        const LAS unsigned char* kb = lds + (T & (NSLOT - 1)) * BUFB;
        bool selq = true; bool work = (64 * T <= q0 + 31);
        if (MODE == 1) { const int j = T >> 2; if (j < qb) { selq = (sel >> j) & 1u; work = work && __any(selq); } }
        if (work) {
            const bool diag = (64 * T + 63 > q0);
            const float tb0 = sl2 * (float)(64 * T - qb * 256), tb1 = tb0 + 32.f * sl2;
            unsigned pk[NMAP][2][2][4];
#pragma unroll
            for (int mp = 0; mp < NMAP; ++mp) {
                f32x16 u0 = cr, u1 = cr;
#pragma unroll
                for (int ks = 0; ks < NKS; ++ks) { const int cb = ((MODE == 0 ? 4 * mp : 0) + 2 * ks) * KCH;
                    const bf16x8 k0 = *(const LAS bf16x8*)(kb + koff + cb), k1 = *(const LAS bf16x8*)(kb + koff + cb + 512);
                    u0 = __builtin_amdgcn_mfma_f32_32x32x16_bf16(k0, qf[mp][ks], u0, 0, 0, 0);
                    u1 = __builtin_amdgcn_mfma_f32_32x32x16_bf16(k1, qf[mp][ks], u1, 0, 0, 0); }
                if (diag) { const int thr = qpos - 64 * T - 4 * hi;
#pragma unroll
                    for (int r = 0; r < 16; ++r) { const int c = (r & 3) + 8 * (r >> 2); if (c > thr) u0[r] = NEG; if (c + 32 > thr) u1[r] = NEG; } }
                float mu = fmaxf(max16(u0) + tb0, max16(u1) + tb1);
                if (MODE == 1) { if (!selq) mu = NEG; }
                mu = xor32_max(mu);
                const float mn = fmaxf(m[mp], mu);
                if (!__all(mn == m[mp])) { const float al = __builtin_amdgcn_exp2f(m[mp] - mn); lsum[mp] *= al;
#pragma unroll
                    for (int d = 0; d < 2; ++d)
#pragma unroll
                        for (int r = 0; r < 16; ++r) O[mp][d][r] *= al;
                    m[mp] = mn; }
                float ms0 = mn - tb0, ms1 = mn - tb1;
                if (MODE == 1) { if (!selq) { ms0 = 1e30f; ms1 = 1e30f; } }
                float ls = 0.f;
#pragma unroll
                for (int r = 0; r < 16; ++r) { u0[r] = __builtin_amdgcn_exp2f(u0[r] - ms0); u1[r] = __builtin_amdgcn_exp2f(u1[r] - ms1); ls += u0[r] + u1[r]; }
                lsum[mp] += ls;
#pragma unroll
                for (int s = 0; s < 2; ++s)
#pragma unroll
                    for (int i = 0; i < 4; ++i) { pk[mp][0][s][i] = cvtpk(u0[8 * s + 2 * i], u0[8 * s + 2 * i + 1]); pk[mp][1][s][i] = cvtpk(u1[8 * s + 2 * i], u1[8 * s + 2 * i + 1]); }
            }
#pragma unroll
            for (int d = 0; d < 2; ++d)
#pragma unroll
                for (int kh = 0; kh < 2; ++kh)
#pragma unroll
                    for (int s = 0; s < 2; ++s) {
                        const s16x4 lo = vtr(kb + voff + d * 4096 + kh * 2048 + s * 1024), hh = vtr(kb + voff + d * 4096 + kh * 2048 + s * 1024 + 512);
                        const bf16x8 vf = (bf16x8){lo[0], lo[1], lo[2], lo[3], hh[0], hh[1], hh[2], hh[3]};
#pragma unroll
                        for (int mp = 0; mp < NMAP; ++mp) { const v4u pw = {pk[mp][kh][s][0], pk[mp][kh][s][1], pk[mp][kh][s][2], pk[mp][kh][s][3]};
                            O[mp][d] = __builtin_amdgcn_mfma_f32_32x32x16_bf16(vf, __builtin_bit_cast(bf16x8, pw), O[mp][d], 0, 0, 0); }
                    }
        }
        asm volatile("s_waitcnt lgkmcnt(0)" ::: "memory");
    }
#undef ATT_DMA
    bf16* yrow = (bf16*)(p.ws + WS_Y) + ((size_t)b * SEQ + qpos) * DM + (MODE == 0 ? 768 : 512) + h * 64;
    if (MODE == 0) {
        const LAS float* cst = (const LAS float*)(lds + NSLOT * BUFB + 4096);
        const float lam = cst[0], lam_init = cst[1];
        const float l0 = xor32_sum(lsum[0]), l1 = xor32_sum(lsum[NMAP - 1]);
        const float i0 = 1.0f / l0, i1 = lam / l1;
        float ss = 0.f;
#pragma unroll
        for (int d = 0; d < 2; ++d)
#pragma unroll
            for (int r = 0; r < 16; ++r) { const float o = O[0][d][r] * i0 - O[NMAP - 1][d][r] * i1; O[0][d][r] = o; ss += o * o; }
        ss = xor32_sum(ss);
        const float rs = rsqrtf(ss * (1.0f / 64.0f) + EPS) * (1.0f - lam_init);
#pragma unroll
        for (int d = 0; d < 2; ++d)
#pragma unroll
            for (int g4 = 0; g4 < 4; ++g4) { const int dd = d * 32 + 8 * g4 + 4 * hi;
                const f4 gn = *(const LAS f4*)(cst + 16 + dd); const v2u z = zpre[d][g4];
                const float z0 = __uint_as_float(z.x << 16), z1 = __uint_as_float(z.x & 0xffff0000u), z2 = __uint_as_float(z.y << 16), z3 = __uint_as_float(z.y & 0xffff0000u);
                v2u w; w.x = cvtpk(O[0][d][4 * g4] * rs * gn.x * fsilu(z0), O[0][d][4 * g4 + 1] * rs * gn.y * fsilu(z1));
                w.y = cvtpk(O[0][d][4 * g4 + 2] * rs * gn.z * fsilu(z2), O[0][d][4 * g4 + 3] * rs * gn.w * fsilu(z3));
                *(v2u*)(yrow + dd) = w; }
    } else {
        const float l0 = xor32_sum(lsum[0]);
        const float i0 = 1.0f / l0;
#pragma unroll
        for (int d = 0; d < 2; ++d)
#pragma unroll
            for (int g4 = 0; g4 < 4; ++g4) { const int dd = d * 32 + 8 * g4 + 4 * hi;
                const v2u z = zpre[d][g4];
                const float z0 = __uint_as_float(z.x << 16), z1 = __uint_as_float(z.x & 0xffff0000u), z2 = __uint_as_float(z.y << 16), z3 = __uint_as_float(z.y & 0xffff0000u);
                v2u w; w.x = cvtpk(O[0][d][4 * g4] * i0 * fsilu(z0), O[0][d][4 * g4 + 1] * i0 * fsilu(z1));
                w.y = cvtpk(O[0][d][4 * g4 + 2] * i0 * fsilu(z2), O[0][d][4 * g4 + 3] * i0 * fsilu(z3));
                *(v2u*)(yrow + dd) = w; }
    }
}
}

__device__ __forceinline__ void phase_attn_mfma(const Params& p, int l, LAS unsigned char* lds) {
    for (int c = BIDX(); c < NB * NH * 4; c += gridDim.x) {
        const int bh = c >> 2, s = c & 3, b = bh >> 2, h = bh & 3;
        att::attn_unit<0>(p, l, b, h, 7 - s, lds);
        att::attn_unit<1>(p, l, b, h, 7 - s, lds);
        att::attn_unit<0>(p, l, b, h, s, lds);
        att::attn_unit<1>(p, l, b, h, s, lds);
    }
}

namespace scn {
typedef short bf16x8 __attribute__((ext_vector_type(8)));
typedef float f32x4 __attribute__((ext_vector_type(4)));
constexpr size_t CH_QT = 64 * 64 * 2, CH_OI = 64 * 64 * 2, CH_SL = 64 * 64 * 4, CH_M = 64 * 64 * 2, CH_DL = 64 * 4;
constexpr int NCH = NB * NH * 32;
constexpr size_t A_GST = 0, A_HST = 16 * MiB, A_GQT = 32 * MiB, A_HQT = 48 * MiB;
constexpr size_t B_GSL = 0, B_HSL = 32 * MiB, B_GMF = 64 * MiB, B_HDL = 96 * MiB;

__device__ __forceinline__ f32x4 mfma16(bf16x8 a, bf16x8 b, f32x4 c) { f32x4 r = __builtin_amdgcn_mfma_f32_16x16x32_bf16(a, b, c, 0, 0, 0); asm volatile("" : "+v"(r) : "v"(a), "v"(b)); return r; }
__device__ __forceinline__ float f_hi(float x) { return __uint_as_float(f2bf(x) << 16); }

template <int PART>
__device__ __forceinline__ void gdn_pre(const Params& p, int l, int item, LAS float* wl) {
    const int lane = TIDX() & 63, half = lane >> 5, j = lane & 31;
    const int ci = item >> 1, cb = (item & 1) * 32;
    const int b = ci >> 7, h = (ci >> 5) & 3, n = ci & 31, t0 = n * 64;
    const bf16* P = (const bf16*)(p.ws + WS_PROJ) + (size_t)b * SEQ * PC;
    const float* AB = (const float*)(p.ws + WS_AB) + (size_t)b * SEQ * 8;
    const float* cw = p.conv_w + (size_t)l * 4 * 768;
    const int cq_ = C_GQ + h * 64 + lane, ck_ = C_GK + h * 64 + lane, cv_ = C_GV + h * 64 + cb + j;
    float wq[4], wk[4], wv[4];
#pragma unroll
    for (int i = 0; i < 4; ++i) { wq[i] = cw[i * 768 + 0 + h * 64 + lane]; wk[i] = cw[i * 768 + 256 + h * 64 + lane]; wv[i] = cw[i * 768 + 512 + h * 64 + cb + j]; }
    const float Aexp = expf(p.a_log[l * NH + h]), dtb = p.dt_bias[l * NH + h];
    float xq[3] = {0.f, 0.f, 0.f}, xk[3] = {0.f, 0.f, 0.f}, xv[3] = {0.f, 0.f, 0.f};
    if (t0 > 0) {
#pragma unroll
        for (int i = 0; i < 3; ++i) { const bf16* pr = P + (size_t)(t0 - 3 + i) * PC; xq[i] = bf2f(pr[cq_]); xk[i] = bf2f(pr[ck_]); if (PART == 0) xv[i] = bf2f(pr[cv_]); }
    }
    float S[32];
#pragma unroll
    for (int i = 0; i < 32; ++i) S[i] = (PART == 1 && (32 * half + i) == (cb + j)) ? 1.f : 0.f;
    bf16* OI = (bf16*)(p.ws + WS_Y) + ((size_t)b * SEQ + t0) * DM + 0 + h * 64;
    bf16* QT = (bf16*)(p.ws + WS_XB + A_GQT + (size_t)ci * CH_QT);
    const LAS float* wk_ = wl + 32 * half; const LAS float* wq_ = wl + 64 + 32 * half;
    float nq, nk, nv = 0.f, na, nb;
    { const bf16* pr = P + (size_t)t0 * PC; nq = bf2f(pr[cq_]); nk = bf2f(pr[ck_]); if (PART == 0) nv = bf2f(pr[cv_]); na = AB[t0 * 8 + h]; nb = AB[t0 * 8 + 4 + h]; }
#pragma unroll 1
    for (int t = 0; t < 64; ++t) {
        const float cq = nq, ck = nk, cv = nv, ca = na, cb2 = nb;
        if (t + 1 < 64) { const bf16* pr = P + (size_t)(t0 + t + 1) * PC; nq = bf2f(pr[cq_]); nk = bf2f(pr[ck_]); if (PART == 0) nv = bf2f(pr[cv_]); na = AB[(t0 + t + 1) * 8 + h]; nb = AB[(t0 + t + 1) * 8 + 4 + h]; }
        float qc = wq[0] * xq[0] + wq[1] * xq[1] + wq[2] * xq[2] + wq[3] * cq;
        float kc = wk[0] * xk[0] + wk[1] * xk[1] + wk[2] * xk[2] + wk[3] * ck;
        xq[0] = xq[1]; xq[1] = xq[2]; xq[2] = cq; xk[0] = xk[1]; xk[1] = xk[2]; xk[2] = ck;
        float vc = 0.f;
        if (PART == 0) { vc = wv[0] * xv[0] + wv[1] * xv[1] + wv[2] * xv[2] + wv[3] * cv; xv[0] = xv[1]; xv[1] = xv[2]; xv[2] = cv; vc = fsilu(vc); }
        qc = fsilu(qc); kc = fsilu(kc);
        const float qss = fwave_sum(qc * qc), kss = fwave_sum(kc * kc);
        const float qn = qc * __builtin_amdgcn_rsqf(qss + EPS) * 0.125f, kn = kc * __builtin_amdgcn_rsqf(kss + EPS);
        const float g = -Aexp * fsoftplus(ca + dtb), beta = fsigmoid(cb2), eg = fexp(g);
        asm volatile("s_waitcnt lgkmcnt(0)" ::: "memory");
        wl[lane] = kn; wl[64 + lane] = qn;
        asm volatile("s_waitcnt lgkmcnt(0)" ::: "memory");
        float ks0 = 0.f, ks1 = 0.f, ks2 = 0.f, ks3 = 0.f;
#pragma unroll
        for (int i = 0; i < 32; i += 4) { const f4 k4 = *(const LAS f4*)(wk_ + i);
            S[i] *= eg; S[i + 1] *= eg; S[i + 2] *= eg; S[i + 3] *= eg;
            ks0 += k4.x * S[i]; ks1 += k4.y * S[i + 1]; ks2 += k4.z * S[i + 2]; ks3 += k4.w * S[i + 3]; }
        const float kS = xor32_sum((ks0 + ks1) + (ks2 + ks3));
        const float vn = beta * (vc - kS);
        float o0 = 0.f, o1 = 0.f, o2 = 0.f, o3 = 0.f;
#pragma unroll
        for (int i = 0; i < 32; i += 4) { const f4 k4 = *(const LAS f4*)(wk_ + i); const f4 q4 = *(const LAS f4*)(wq_ + i);
            S[i] += k4.x * vn; S[i + 1] += k4.y * vn; S[i + 2] += k4.z * vn; S[i + 3] += k4.w * vn;
            o0 += q4.x * S[i]; o1 += q4.y * S[i + 1]; o2 += q4.z * S[i + 2]; o3 += q4.w * S[i + 3]; }
        const float o = xor32_sum((o0 + o1) + (o2 + o3));
        if (half == 0) { if (PART == 1) QT[t * 64 + cb + j] = (bf16)f2bf(o); else OI[(size_t)t * DM + cb + j] = (bf16)f2bf(o); }
    }
    if (PART == 0) {
        float* SL = (float*)(p.ws + WS_SCR + B_GSL + (size_t)ci * CH_SL) + (cb + j) * 64 + 32 * half;
#pragma unroll
        for (int i = 0; i < 32; i += 4) *(float4*)(SL + i) = make_float4(S[i], S[i + 1], S[i + 2], S[i + 3]);
    } else {
        float* MF = (float*)(p.ws + WS_SCR + B_GMF + (size_t)ci * CH_SL) + (32 * half) * 64 + cb + j;
#pragma unroll
        for (int i = 0; i < 32; ++i) { MF[i * 64] = S[i]; if ((i & 7) == 7) asm volatile("" ::: "memory"); }
    }
}

__device__ __forceinline__ void hgrn_pre(const Params& p, int l, int ci, LAS float* wl) {
    const int lane = TIDX() & 63;
    const int b = ci >> 7, h = (ci >> 5) & 3, n = ci & 31, t0 = n * 64;
    const bf16* P = (const bf16*)(p.ws + WS_PROJ) + (size_t)b * SEQ * PC;
    float lb = 0.f;
    if (l == 1) { const float a0 = p.hgrn_lb[h * 64 + lane], a1 = p.hgrn_lb[GW + h * 64 + lane]; lb = 1.0f / (1.0f + expf(a0 - a1)); }
    float S[64];
#pragma unroll
    for (int d = 0; d < 64; ++d) S[d] = 0.f;
    float gam = 1.f;
    bf16* OI = (bf16*)(p.ws + WS_Y) + ((size_t)b * SEQ + t0) * DM + 256 + h * 64;
    bf16* QT = (bf16*)(p.ws + WS_XB + A_HQT + (size_t)ci * CH_QT);
    float nq, nf, nv;
    { const bf16* pr = P + (size_t)t0 * PC; nq = bf2f(pr[C_HQ + h * 64 + lane]); nf = bf2f(pr[C_HF + h * 64 + lane]); nv = bf2f(pr[C_HI + h * 64 + lane]); }
#pragma unroll 1
    for (int t = 0; t < 64; ++t) {
        const float cq = nq, cf = nf, vi = nv;
        if (t + 1 < 64) { const bf16* pr = P + (size_t)(t0 + t + 1) * PC; nq = bf2f(pr[C_HQ + h * 64 + lane]); nf = bf2f(pr[C_HF + h * 64 + lane]); nv = bf2f(pr[C_HI + h * 64 + lane]); }
        const float sg = fsigmoid(cf);
        const float fg = lb + (1.0f - lb) * sg;
        const float kk = (1.0f - lb) * (1.0f - sg);
        const float qq = fsilu(cq);
        gam *= fg;
        QT[t * 64 + lane] = (bf16)f2bf(qq * gam);
        asm volatile("s_waitcnt lgkmcnt(0)" ::: "memory");
        wl[lane] = fg; wl[64 + lane] = kk; wl[128 + lane] = qq;
        asm volatile("s_waitcnt lgkmcnt(0)" ::: "memory");
        float o0 = 0.f, o1 = 0.f, o2 = 0.f, o3 = 0.f;
#pragma unroll
        for (int d = 0; d < 64; d += 4) { const f4 f4_ = *(const LAS f4*)(wl + d); const f4 k4 = *(const LAS f4*)(wl + 64 + d); const f4 q4 = *(const LAS f4*)(wl + 128 + d);
            S[d] = f4_.x * S[d] + k4.x * vi; S[d + 1] = f4_.y * S[d + 1] + k4.y * vi; S[d + 2] = f4_.z * S[d + 2] + k4.z * vi; S[d + 3] = f4_.w * S[d + 3] + k4.w * vi;
            o0 += q4.x * S[d]; o1 += q4.y * S[d + 1]; o2 += q4.z * S[d + 2]; o3 += q4.w * S[d + 3]; }
        const float o = (o0 + o1) + (o2 + o3);
        OI[(size_t)t * DM + lane] = (bf16)f2bf(o);
    }
    float* SL = (float*)(p.ws + WS_SCR + B_HSL + (size_t)ci * CH_SL) + lane * 64;
#pragma unroll
    for (int d = 0; d < 64; d += 4) *(float4*)(SL + d) = make_float4(S[d], S[d + 1], S[d + 2], S[d + 3]);
    ((float*)(p.ws + WS_SCR + B_HDL + (size_t)ci * CH_DL))[lane] = gam;
}

__device__ __forceinline__ void kmean_item(const Params& p, int it) {
    const int lane = TIDX() & 63;
    const bf16* proj = (const bf16*)(p.ws + WS_PROJ); float* kmean = (float*)(p.ws + WS_KMEAN);
    const int sub = it & 3, j = (it >> 2) & 7, h = (it >> 5) & 3, b = it >> 7;
    const bf16* base = proj + ((size_t)b * SEQ + j * 256 + sub * 64) * PC + C_MK + h * 64 + lane;
    float acc[4] = {0.f, 0.f, 0.f, 0.f};
#pragma unroll
    for (int r0 = 0; r0 < 64; r0 += 16) { bf16 v[16];
#pragma unroll
        for (int i = 0; i < 16; ++i) v[i] = base[(size_t)(r0 + i) * PC];
#pragma unroll
        for (int i = 0; i < 16; ++i) acc[i & 3] += bf2f(v[i]); }
    kmean[(size_t)it * 64 + lane] = ((acc[0] + acc[1]) + (acc[2] + acc[3])) * (1.0f / 256.0f);
}

__device__ __forceinline__ void phase_pre(const Params& p, int l, LAS unsigned char* lds) {
    const int wave = TIDX() >> 6;
    LAS float* wl = (LAS float*)(lds + wave * 1024);
    const int gw = BIDX() * NWAVES + wave, NGW = gridDim.x * NWAVES;
    constexpr int N_G = 2 * NCH, N_H = NCH, N_K = NB * NH * 8;
    for (int it = gw; it < 2 * NCH; it += NGW) gdn_pre<1>(p, l, it, wl);
    for (int it = gw; it < 2 * NCH; it += NGW) gdn_pre<0>(p, l, it, wl);
    for (int it = gw; it < NCH; it += NGW) hgrn_pre(p, l, it, wl);
    for (int it = gw; it < N_K; it += NGW) kmean_item(p, it);
}

template <int KIND>
__device__ __forceinline__ void scan_unit(const Params& p, int l, int sp, LAS unsigned char* lds) {
    const int tid = TIDX(), lane = tid & 63, wid = __builtin_amdgcn_readfirstlane(tid >> 6), seq = wid >> 2, sl = wid & 3, c15 = lane & 15, g = lane >> 4;
    const int bh = sp * 2 + seq, dv = 16 * sl + c15;
    f32x4 S[4];
#pragma unroll
    for (int rb = 0; rb < 4; ++rb) S[rb] = (f32x4){0.f, 0.f, 0.f, 0.f};
    const unsigned char* SLb = p.ws + WS_SCR + (KIND == 0 ? B_GSL : B_HSL) + (size_t)bh * 32 * CH_SL;
    const unsigned char* MFb = p.ws + WS_SCR + B_GMF + (size_t)bh * 32 * CH_SL;
    const unsigned char* DLb = p.ws + WS_SCR + B_HDL + (size_t)bh * 32 * CH_DL;
    unsigned char* STb = p.ws + WS_XB + (KIND == 0 ? A_GST : A_HST) + (size_t)bh * 32 * CH_QT;
    constexpr int MP = 272;
    LAS unsigned char* mring = lds + seq * (3 * 64 * MP);
    const int mrow = 16 * sl + (lane >> 2), mq = (lane & 3) * 16;
    f32x4 ma[4], mb[4];
    f32x4 csl[4], nsl[4], cd[4], nd[4];
#define SCN_MLOAD(dst, n_) do { const float* MF_ = (const float*)(MFb + (size_t)(n_) * CH_SL) + mrow * 64 + mq; \
        _Pragma("unroll") for (int i = 0; i < 4; ++i) dst[i] = *(const f32x4*)(MF_ + 4 * i); } while (0)
#define SCN_MSTORE(src, n_) do { LAS unsigned char* d_ = mring + ((n_) % 3) * (64 * MP) + mrow * MP + mq * 4; \
        _Pragma("unroll") for (int i = 0; i < 4; ++i) *(LAS f32x4*)(d_ + 16 * i) = src[i]; } while (0)
#define SCN_SLOAD(dsl, dd, n_) do { const float* SL_ = (const float*)(SLb + (size_t)(n_) * CH_SL); \
        _Pragma("unroll") for (int rb = 0; rb < 4; ++rb) dsl[rb] = *(const f32x4*)(SL_ + dv * 64 + 16 * rb + 4 * g); \
        if (KIND == 1) { const float* DL_ = (const float*)(DLb + (size_t)(n_) * CH_DL); _Pragma("unroll") for (int rb = 0; rb < 4; ++rb) dd[rb] = *(const f32x4*)(DL_ + 16 * rb + 4 * g); } } while (0)
    __syncthreads();
    if (KIND == 0) { SCN_MLOAD(ma, 0); SCN_MSTORE(ma, 0); SCN_MLOAD(ma, 1); SCN_MLOAD(mb, 2); }
    SCN_SLOAD(nsl, nd, 0);
    __syncthreads();
#pragma unroll 1
    for (int n = 0; n < 32; ++n) {
#pragma unroll
        for (int i = 0; i < 4; ++i) { csl[i] = nsl[i]; if (KIND == 1) cd[i] = nd[i]; }
        if (n + 1 < 32) SCN_SLOAD(nsl, nd, n + 1);
        bf16* ST = (bf16*)(STb + (size_t)n * CH_QT) + dv * 64 + 4 * g;
#pragma unroll
        for (int rb = 0; rb < 4; ++rb) { v2u w; w.x = pk2(S[rb][0], S[rb][1]); w.y = pk2(S[rb][2], S[rb][3]); *(v2u*)(ST + 16 * rb) = w; }
        if (KIND == 0) {
            bf16x8 Bh[2], Bl[2];
#pragma unroll
            for (int ks = 0; ks < 2; ++ks) { const f32x4 a = S[2 * ks], c = S[2 * ks + 1];
                v4u w; w.x = pk2(a[0], a[1]); w.y = pk2(a[2], a[3]); w.z = pk2(c[0], c[1]); w.w = pk2(c[2], c[3]); Bh[ks] = __builtin_bit_cast(bf16x8, w);
                v4u x; x.x = pk2(a[0] - f_hi(a[0]), a[1] - f_hi(a[1])); x.y = pk2(a[2] - f_hi(a[2]), a[3] - f_hi(a[3])); x.z = pk2(c[0] - f_hi(c[0]), c[1] - f_hi(c[1])); x.w = pk2(c[2] - f_hi(c[2]), c[3] - f_hi(c[3])); Bl[ks] = __builtin_bit_cast(bf16x8, x); }
            const LAS unsigned char* mc = mring + (n % 3) * (64 * MP);
#pragma unroll
            for (int rb = 0; rb < 4; ++rb) { f32x4 acc = csl[rb];
#pragma unroll
                for (int ks = 0; ks < 2; ++ks) { const LAS unsigned char* mp_ = mc + (16 * rb + c15) * MP + (32 * ks + 4 * g) * 4;
                    const f32x4 m0 = *(const LAS f32x4*)mp_, m1 = *(const LAS f32x4*)(mp_ + 64); v4u hw, lw;
                    hw.x = pk2(m0[0], m0[1]); hw.y = pk2(m0[2], m0[3]); hw.z = pk2(m1[0], m1[1]); hw.w = pk2(m1[2], m1[3]);
                    lw.x = pk2(m0[0] - f_hi(m0[0]), m0[1] - f_hi(m0[1])); lw.y = pk2(m0[2] - f_hi(m0[2]), m0[3] - f_hi(m0[3])); lw.z = pk2(m1[0] - f_hi(m1[0]), m1[1] - f_hi(m1[1])); lw.w = pk2(m1[2] - f_hi(m1[2]), m1[3] - f_hi(m1[3]));
                    acc = mfma16(__builtin_bit_cast(bf16x8, lw), Bh[ks], acc);
                    acc = mfma16(__builtin_bit_cast(bf16x8, hw), Bl[ks], acc);
                    acc = mfma16(__builtin_bit_cast(bf16x8, hw), Bh[ks], acc); }
                S[rb] = acc; }
            if (n + 1 < 32) { if (n & 1) SCN_MSTORE(mb, n + 1); else SCN_MSTORE(ma, n + 1); }
            if (n + 3 < 32) { if (n & 1) SCN_MLOAD(mb, n + 3); else SCN_MLOAD(ma, n + 3); }
            __syncthreads();
        } else {
#pragma unroll
            for (int rb = 0; rb < 4; ++rb) S[rb] = cd[rb] * S[rb] + csl[rb];
        }
    }
#undef SCN_MLOAD
#undef SCN_MSTORE
#undef SCN_SLOAD
}

__device__ __forceinline__ float row16_sum(float v) {
    v += __int_as_float(__builtin_amdgcn_update_dpp(0, __float_as_int(v), 0xB1, 0xF, 0xF, true));
    v += __int_as_float(__builtin_amdgcn_update_dpp(0, __float_as_int(v), 0x4E, 0xF, 0xF, true));
    v += __int_as_float(__builtin_amdgcn_update_dpp(0, __float_as_int(v), 0x141, 0xF, 0xF, true));
    v += __int_as_float(__builtin_amdgcn_update_dpp(0, __float_as_int(v), 0x140, 0xF, 0xF, true));
    return v;
}

template <int KIND>
__device__ __forceinline__ void out_item(const Params& p, int l, int ci, bool dry) {
    const int lane = TIDX() & 63, c15 = lane & 15, g = lane >> 4;
    const int b = ci >> 7, h = (ci >> 5) & 3, n = ci & 31, t0 = n * 64;
    const bf16* P = (const bf16*)(p.ws + WS_PROJ) + ((size_t)b * SEQ + t0) * PC + (KIND == 0 ? C_GZ : C_HZ) + h * 64;
    bf16* Y = (bf16*)(p.ws + WS_Y) + ((size_t)b * SEQ + t0) * DM + (KIND == 0 ? 0 : 256) + h * 64;
    const bf16* QT = (const bf16*)(p.ws + WS_XB + (KIND == 0 ? A_GQT : A_HQT) + (size_t)ci * CH_QT);
    const bf16* ST = (const bf16*)(p.ws + WS_XB + (KIND == 0 ? A_GST : A_HST) + (size_t)ci * CH_QT);
    const float* ngp = (KIND == 0 ? p.gdn_g : p.hgrn_g) + l * HD;
    bf16x8 Bf[4][2];
#pragma unroll
    for (int cbk = 0; cbk < 4; ++cbk)
#pragma unroll
        for (int ks = 0; ks < 2; ++ks) Bf[cbk][ks] = *(const bf16x8*)(ST + (16 * cbk + c15) * 64 + 32 * ks + 8 * g);
    float ng[4];
#pragma unroll
    for (int cbk = 0; cbk < 4; ++cbk) ng[cbk] = ngp[16 * cbk + c15];
#pragma unroll
    for (int rb = 0; rb < 4; ++rb) {
        bf16x8 Af[2];
#pragma unroll
        for (int ks = 0; ks < 2; ++ks) Af[ks] = *(const bf16x8*)(QT + (16 * rb + c15) * 64 + 32 * ks + 8 * g);
        f32x4 o[4]; float zz[4][4];
#pragma unroll
        for (int cbk = 0; cbk < 4; ++cbk) {
            const bf16* yi = Y + (size_t)(16 * rb + 4 * g) * DM + 16 * cbk + c15; const bf16* zi = P + (size_t)(16 * rb + 4 * g) * PC + 16 * cbk + c15;
            o[cbk] = (f32x4){bf2f(yi[0]), bf2f(yi[DM]), bf2f(yi[2 * DM]), bf2f(yi[3 * DM])};
#pragma unroll
            for (int r = 0; r < 4; ++r) zz[cbk][r] = bf2f(zi[(size_t)r * PC]);
        }
#pragma unroll
        for (int cbk = 0; cbk < 4; ++cbk)
#pragma unroll
            for (int ks = 0; ks < 2; ++ks) o[cbk] = mfma16(Af[ks], Bf[cbk][ks], o[cbk]);
#pragma unroll
        for (int r = 0; r < 4; ++r) {
            float ss = o[0][r] * o[0][r] + o[1][r] * o[1][r] + o[2][r] * o[2][r] + o[3][r] * o[3][r];
            ss = row16_sum(ss);
            const float rs = rsqrtf(ss * (1.0f / 64.0f) + EPS);
#pragma unroll
            for (int cbk = 0; cbk < 4; ++cbk) { const bf16 ov = (bf16)f2bf(o[cbk][r] * rs * ng[cbk] * fsilu(zz[cbk][r])); if (dry) asm volatile("" :: "v"(ov)); else Y[(size_t)(16 * rb + 4 * g + r) * DM + 16 * cbk + c15] = ov; }
        }
    }
}
__device__ __forceinline__ void phase_out(const Params& p, int l, bool dry = false) {
    const int wave = TIDX() >> 6;
    const int gw = BIDX() * NWAVES + wave, NGW = gridDim.x * NWAVES;
    for (int it = gw; it < 2 * NCH; it += NGW) { if (it < NCH) out_item<0>(p, l, it, dry); else out_item<1>(p, l, it - NCH, dry); }
}
}

#ifndef REP_SCAN
#define REP_SCAN 1
#endif
#ifndef REP_ATT
#define REP_ATT 1
#endif
#ifndef REP_ATT_KIND
#define REP_ATT_KIND 2
#endif
#ifndef REP_ATT_QB
#define REP_ATT_QB 0
#endif
#ifndef REP_ATT_DRY
#define REP_ATT_DRY 0
#endif
__device__ __forceinline__ void phase_mix(const Params& p, int l, LAS unsigned char* lds) {
    const int c = BIDX();
    for (int rep = 0; rep < REP_SCAN; ++rep)
    for (int u = c; u < 64; u += gridDim.x) { if (u < 32) scn::scan_unit<0>(p, l, u, lds); else scn::scan_unit<1>(p, l, u - 32, lds); }
    LAS unsigned* bc = (LAS unsigned*)(lds + att::NSLOT * att::BUFB);
    {
        LAS float* cst = (LAS float*)(lds + att::NSLOT * att::BUFB + 4096);
        __syncthreads();
        if (TIDX() < 64) { const int lane = TIDX();
            float pr = (lane < 32) ? p.lq1[l * 32 + lane] * p.lk1[l * 32 + lane] : -(p.lq2[l * 32 + lane - 32] * p.lk2[l * 32 + lane - 32]);
#pragma unroll
            for (int o = 16; o > 0; o >>= 1) pr += __shfl_xor(pr, o);
            const float e_mine = expf(lane < 32 ? pr : -pr), e_other = __shfl_xor(e_mine, 32);
            const float lam_init = 0.8f - 0.6f * expf(-0.3f * (float)l);
            if (lane == 0) { cst[0] = e_mine - e_other + lam_init; cst[1] = lam_init; }
            cst[16 + lane] = p.diff_g[l * HD + lane]; }
    }
    for (int rep = 0; rep < REP_ATT; ++rep) {
    unsigned* ctr = (unsigned*)(p.ws + WS_CTL) + 64 * (1 + l + 2 * rep);
    for (;;) {
        __syncthreads();
        if (TIDX() == 0) bc[0] = atomicAdd(ctr, 1u);
        __syncthreads();
        const unsigned u = bc[0];
        if (u >= 1024u) break;
        const int kind = (int)(u >> 9), qb = 7 - (int)((u >> 6) & 7), bh = u & 63, b = bh >> 2, h = bh & 3;
        if (kind == 0) att::attn_unit<0>(p, l, b, h, qb, lds); else att::attn_unit<1>(p, l, b, h, qb, lds);
    }
    }
}

#ifndef GREP_S1A
#define GREP_S1A 1
#endif
#ifndef GREP_S1B
#define GREP_S1B 1
#endif
#ifndef GREP_S2A
#define GREP_S2A 1
#endif
#ifndef GREP_S2B
#define GREP_S2B 1
#endif
#ifndef GREP_S4
#define GREP_S4 1
#endif
#ifndef WY_OUTMASK
#define WY_OUTMASK 15
#endif
namespace wy {
typedef short bf16x8 __attribute__((ext_vector_type(8)));
typedef short bf16x4 __attribute__((ext_vector_type(4)));
typedef float f32x4 __attribute__((ext_vector_type(4)));
constexpr int LP = 72, ROWB = LP * 2;
__device__ __forceinline__ f32x4 mm32(const LAS unsigned char* X, int xr, const LAS unsigned char* Y, int yr, int k0, f32x4 acc, int c15, int g) {
    const bf16x8 a = *(const LAS bf16x8*)(X + (xr + c15) * ROWB + (k0 + 8 * g) * 2);
    const bf16x8 b = *(const LAS bf16x8*)(Y + (yr + c15) * ROWB + (k0 + 8 * g) * 2);
    f32x4 r = __builtin_amdgcn_mfma_f32_16x16x32_bf16(a, b, acc, 0, 0, 0);
    asm volatile("" : "+v"(r) : "v"(a), "v"(b));
    return r;
}
__device__ __forceinline__ f32x4 mm16(const LAS unsigned char* X, int xr, const LAS unsigned char* Y, int yr, int k0, f32x4 acc, int c15, int g) {
    const bf16x4 a = *(const LAS bf16x4*)(X + (xr + c15) * ROWB + (k0 + 4 * g) * 2);
    const bf16x4 b = *(const LAS bf16x4*)(Y + (yr + c15) * ROWB + (k0 + 4 * g) * 2);
    f32x4 r = __builtin_amdgcn_mfma_f32_16x16x16bf16_1k(a, b, acc, 0, 0, 0);
    asm volatile("" : "+v"(r) : "v"(a), "v"(b));
    return r;
}
__device__ __forceinline__ f32x4 zacc() { f32x4 z = (f32x4){0.f, 0.f, 0.f, 0.f}; asm volatile("" : "+v"(z)); return z; }
template <int KLEN>
__device__ __forceinline__ f32x4 mmk(const LAS unsigned char* X, int xr, const LAS unsigned char* Y, int yr, f32x4 acc, int c15, int g) {
#pragma unroll
    for (int k = 0; k + 32 <= KLEN; k += 32) acc = mm32(X, xr, Y, yr, k, acc, c15, g);
    if (KLEN % 32) acc = mm16(X, xr, Y, yr, KLEN - 16, acc, c15, g);
    return acc;
}
template <int NTL, int KLEN>
__device__ __forceinline__ void mm_batch(const LAS unsigned char* X, const int (&xr)[NTL], const LAS unsigned char* Y, const int (&yr)[NTL], f32x4 (&acc)[NTL], int c15, int g) {
#pragma unroll
    for (int k = 0; k + 32 <= KLEN; k += 32) { bf16x8 a[NTL], b[NTL];
#pragma unroll
        for (int t = 0; t < NTL; ++t) { a[t] = *(const LAS bf16x8*)(X + (xr[t] + c15) * ROWB + (k + 8 * g) * 2); b[t] = *(const LAS bf16x8*)(Y + (yr[t] + c15) * ROWB + (k + 8 * g) * 2); }
#pragma unroll
        for (int t = 0; t < NTL; ++t) { acc[t] = __builtin_amdgcn_mfma_f32_16x16x32_bf16(a[t], b[t], acc[t], 0, 0, 0); asm volatile("" : "+v"(acc[t]) : "v"(a[t]), "v"(b[t])); } }
    if (KLEN % 32) { bf16x4 a[NTL], b[NTL];
#pragma unroll
        for (int t = 0; t < NTL; ++t) { a[t] = *(const LAS bf16x4*)(X + (xr[t] + c15) * ROWB + (KLEN - 16 + 4 * g) * 2); b[t] = *(const LAS bf16x4*)(Y + (yr[t] + c15) * ROWB + (KLEN - 16 + 4 * g) * 2); }
#pragma unroll
        for (int t = 0; t < NTL; ++t) { acc[t] = __builtin_amdgcn_mfma_f32_16x16x16bf16_1k(a[t], b[t], acc[t], 0, 0, 0); asm volatile("" : "+v"(acc[t]) : "v"(a[t]), "v"(b[t])); } }
}
__device__ __forceinline__ float sum8_dpp(float v) {
    v += __int_as_float(__builtin_amdgcn_update_dpp(0, __float_as_int(v), 0xB1, 0xF, 0xF, true));
    v += __int_as_float(__builtin_amdgcn_update_dpp(0, __float_as_int(v), 0x4E, 0xF, 0xF, true));
    v += __int_as_float(__builtin_amdgcn_update_dpp(0, __float_as_int(v), 0x141, 0xF, 0xF, true));
    return v;
}
__device__ __forceinline__ void unpack8(const v4u w, float (&f)[8]) {
    f[0] = __uint_as_float(w.x << 16); f[1] = __uint_as_float(w.x & 0xffff0000u); f[2] = __uint_as_float(w.y << 16); f[3] = __uint_as_float(w.y & 0xffff0000u);
    f[4] = __uint_as_float(w.z << 16); f[5] = __uint_as_float(w.z & 0xffff0000u); f[6] = __uint_as_float(w.w << 16); f[7] = __uint_as_float(w.w & 0xffff0000u);
}
__device__ __forceinline__ v4u pack8(const float (&f)[8]) { v4u w; w.x = pk2(f[0], f[1]); w.y = pk2(f[2], f[3]); w.z = pk2(f[4], f[5]); w.w = pk2(f[6], f[7]); return w; }

struct GdnRaw { v4u q[4], k[4], v[4]; float ga, gb; };
__device__ __forceinline__ void gdn_load_raw(const Params& p, int ci, GdnRaw& R) {
    const int tid = TIDX(), tok = tid >> 3, c8 = tid & 7;
    const int b = ci >> 7, h = (ci >> 5) & 3, n = ci & 31, t0 = n * 64;
    const bf16* P = (const bf16*)(p.ws + WS_PROJ) + (size_t)b * SEQ * PC;
#pragma unroll
    for (int r = 0; r < 4; ++r) { const int row = t0 + tok - 3 + r, rowc = row < 0 ? 0 : row;
        const bf16* pr = P + (size_t)rowc * PC + h * 64 + 8 * c8;
        R.q[r] = *(const v4u*)(pr + C_GQ); R.k[r] = *(const v4u*)(pr + C_GK); R.v[r] = *(const v4u*)(pr + C_GV); }
    const float* AB = (const float*)(p.ws + WS_AB) + ((size_t)b * SEQ + t0 + tok) * 8;
    R.ga = AB[h]; R.gb = AB[4 + h];
}
constexpr int G_KH = 0, G_QH = 9216, G_VH = 18432, G_KTD = 27648, G_XT = 36864, G_AKK = 55296, G_AQK = 64512, G_TB = 73728, G_AD = 76800, G_SC = 80896;
constexpr int TBP = 24;
constexpr int G_CW = 132096;
constexpr int G_ST_MF = 83968, G_ST_SL = 101376, G_ST_QT = 118784, G_ST_Y = 0;
__device__ __forceinline__ void gdn_chunk(const Params& p, int l, int ci, int ci_next, GdnRaw& R, LAS unsigned char* lds) {
    const int tid = TIDX(), lane = tid & 63, wid = __builtin_amdgcn_readfirstlane(tid >> 6), c15 = lane & 15, g = lane >> 4;
    const int b = ci >> 7, h = (ci >> 5) & 3, n = ci & 31, t0 = n * 64;
    const bf16* P = (const bf16*)(p.ws + WS_PROJ) + (size_t)b * SEQ * PC;
    LAS float* sc_g = (LAS float*)(lds + G_SC); LAS float* sc_b = sc_g + 64; LAS float* sc_gc = sc_g + 128; LAS float* sc_eg = sc_g + 192; LAS float* sc_dl = sc_g + 256;
    __syncthreads();
    for (int rp_ = 0; rp_ < GREP_S1A; ++rp_) {
        const int tok = tid >> 3, c8 = tid & 7;
        float aq[8], ak[8], av[8];
#pragma unroll
        for (int i = 0; i < 8; ++i) { aq[i] = 0.f; ak[i] = 0.f; av[i] = 0.f; }
        f4 wgt[4][6];
        { const LAS float* wl_ = (const LAS float*)(lds + G_CW) + c8 * 96;
#pragma unroll
          for (int r = 0; r < 4; ++r)
#pragma unroll
              for (int j = 0; j < 6; ++j) wgt[r][j] = *(const LAS f4*)(wl_ + (r * 6 + j) * 4); }
#pragma unroll
        for (int r = 0; r < 4; ++r) {
            const float m = (t0 + tok - 3 + r) < 0 ? 0.f : 1.f;
            float xq[8], xk[8], xv[8];
            unpack8(R.q[r], xq); unpack8(R.k[r], xk); unpack8(R.v[r], xv);
            const float wq[8] = {wgt[r][0].x, wgt[r][0].y, wgt[r][0].z, wgt[r][0].w, wgt[r][1].x, wgt[r][1].y, wgt[r][1].z, wgt[r][1].w};
            const float wk[8] = {wgt[r][2].x, wgt[r][2].y, wgt[r][2].z, wgt[r][2].w, wgt[r][3].x, wgt[r][3].y, wgt[r][3].z, wgt[r][3].w};
            const float wv[8] = {wgt[r][4].x, wgt[r][4].y, wgt[r][4].z, wgt[r][4].w, wgt[r][5].x, wgt[r][5].y, wgt[r][5].z, wgt[r][5].w};
#pragma unroll
            for (int i = 0; i < 8; ++i) { aq[i] += m * wq[i] * xq[i]; ak[i] += m * wk[i] * xk[i]; av[i] += m * wv[i] * xv[i]; }
        }
        float sq = 0.f, sk = 0.f;
#pragma unroll
        for (int i = 0; i < 8; ++i) { aq[i] = fsilu(aq[i]); ak[i] = fsilu(ak[i]); av[i] = fsilu(av[i]); sq += aq[i] * aq[i]; sk += ak[i] * ak[i]; }
        sq = sum8_dpp(sq); sk = sum8_dpp(sk);
        const float rq = __builtin_amdgcn_rsqf(sq + EPS) * 0.125f, rk = __builtin_amdgcn_rsqf(sk + EPS);
#pragma unroll
        for (int i = 0; i < 8; ++i) { aq[i] *= rq; ak[i] *= rk; }
        *(LAS v4u*)(lds + G_QH + tok * ROWB + 16 * c8) = pack8(aq);
        *(LAS v4u*)(lds + G_KH + tok * ROWB + 16 * c8) = pack8(ak);
        *(LAS v4u*)(lds + G_VH + tok * ROWB + 16 * c8) = pack8(av);
        if (c8 == 0) { sc_g[tok] = -expf(p.a_log[l * NH + h]) * fsoftplus(R.ga + p.dt_bias[l * NH + h]); sc_b[tok] = fsigmoid(R.gb); }
    }
    __syncthreads();
    for (int rp_ = 0; rp_ < GREP_S1B; ++rp_) {
        const int d = tid & 63, tq = tid >> 6;
        float pre = 0.f, tot = 0.f;
#pragma unroll
        for (int j = 0; j < 64; j += 4) { const f4 g4 = *(const LAS f4*)(sc_g + j); const float s4 = (g4.x + g4.y) + (g4.z + g4.w); tot += s4; if (j < 8 * tq) pre += s4; }
        float gc[8], bt[8];
        { const f4 a = *(const LAS f4*)(sc_g + 8 * tq), c = *(const LAS f4*)(sc_g + 8 * tq + 4), b0 = *(const LAS f4*)(sc_b + 8 * tq), b1 = *(const LAS f4*)(sc_b + 8 * tq + 4);
          gc[0] = pre + a.x; gc[1] = gc[0] + a.y; gc[2] = gc[1] + a.z; gc[3] = gc[2] + a.w; gc[4] = gc[3] + c.x; gc[5] = gc[4] + c.y; gc[6] = gc[5] + c.z; gc[7] = gc[6] + c.w;
          bt[0] = b0.x; bt[1] = b0.y; bt[2] = b0.z; bt[3] = b0.w; bt[4] = b1.x; bt[5] = b1.y; bt[6] = b1.z; bt[7] = b1.w; }
        float xv[8], xw[8], xk[8];
#pragma unroll
        for (int i = 0; i < 8; ++i) { const float eg = fexp(gc[i]), ed = fexp(tot - gc[i]);
            const float kv = bf2f(*(const LAS bf16*)(lds + G_KH + (8 * tq + i) * ROWB + 2 * d)), vv = bf2f(*(const LAS bf16*)(lds + G_VH + (8 * tq + i) * ROWB + 2 * d));
            xv[i] = vv * bt[i]; xw[i] = kv * bt[i] * eg; xk[i] = kv * ed;
            if (d == 0) { sc_gc[8 * tq + i] = gc[i]; sc_eg[8 * tq + i] = eg; } }
        if (tid == 0) sc_dl[0] = fexp(tot);
        *(LAS v4u*)(lds + G_XT + d * ROWB + 16 * tq) = pack8(xv);
        *(LAS v4u*)(lds + G_XT + (64 + d) * ROWB + 16 * tq) = pack8(xw);
        *(LAS v4u*)(lds + G_KTD + d * ROWB + 16 * tq) = pack8(xk);
    }
    __syncthreads();
    for (int rp_ = 0; rp_ < GREP_S2A; ++rp_) {
#pragma unroll 1
        for (int step = 0; step < 2; ++step) {
            if (step == 1) __syncthreads();
            const bool isq = step == 1;
            if (isq && wid == 0) {
                const int blk = lane >> 4, c = lane & 15;
                const LAS float* Ad = (const LAS float*)(lds + G_AD) + blk * 256;
                float t[16];
#pragma unroll
                for (int i = 0; i < 16; ++i) { float s = (i == c) ? 1.f : 0.f;
#pragma unroll
                    for (int j = 0; j < i; ++j) s -= Ad[i * 16 + j] * t[j];
                    t[i] = s; *(LAS bf16*)(lds + G_TB + ((blk * 16 + i) * TBP + c) * 2) = (bf16)f2bf(s); }
            } else {
                for (int tt = isq ? wid - 1 : wid; tt < 10; tt += (isq ? 7 : 8)) {
                    const int I = (tt >= 6) ? 3 : (tt >= 3) ? 2 : (tt >= 1) ? 1 : 0, J = tt - (I * (I + 1)) / 2;
                    f32x4 acc = zacc();
                    acc = mmk<64>(lds + (isq ? G_QH : G_KH), 16 * I, lds + G_KH, 16 * J, acc, c15, g);
                    const int jj = 16 * J + c15; const float gj = sc_gc[jj];
#pragma unroll
                    for (int r = 0; r < 4; ++r) { const int ii = 16 * I + 4 * g + r; const float dec = fexp(sc_gc[ii] - gj);
                        if (isq) { const float v = (jj <= ii) ? acc[r] * dec : 0.f; *(LAS bf16*)(lds + G_AQK + ii * ROWB + 2 * jj) = (bf16)f2bf(v); }
                        else { const float v = (jj < ii) ? acc[r] * dec * sc_b[ii] : 0.f; *(LAS bf16*)(lds + G_AKK + ii * ROWB + 2 * jj) = (bf16)f2bf(-v);
                            if (I == J) ((LAS float*)(lds + G_AD))[I * 256 + (4 * g + r) * 16 + c15] = v; } }
                }
            }
        }
    }
    __syncthreads();
    {
        const int cb = 16 * wid;
#pragma unroll
        for (int I = 0; I < 4; ++I) {
            LAS unsigned char* xp = lds + G_XT + (cb + c15) * ROWB + (16 * I + 4 * g) * 2;
            const v2u rr = *(const LAS v2u*)xp;
            f32x4 acc = (f32x4){__uint_as_float(rr.x << 16), __uint_as_float(rr.x & 0xffff0000u), __uint_as_float(rr.y << 16), __uint_as_float(rr.y & 0xffff0000u)};
            if (I == 1) acc = mmk<16>(lds + G_AKK, 16, lds + G_XT, cb, acc, c15, g);
            if (I == 2) acc = mmk<32>(lds + G_AKK, 32, lds + G_XT, cb, acc, c15, g);
            if (I == 3) acc = mmk<48>(lds + G_AKK, 48, lds + G_XT, cb, acc, c15, g);
            const bf16x4 ta = *(const LAS bf16x4*)(lds + G_TB + ((I * 16 + c15) * TBP + 4 * g) * 2);
            v2u bw; bw.x = pk2(acc[0], acc[1]); bw.y = pk2(acc[2], acc[3]);
            const bf16x4 tb = __builtin_bit_cast(bf16x4, bw);
            f32x4 x = __builtin_amdgcn_mfma_f32_16x16x16bf16_1k(ta, tb, zacc(), 0, 0, 0);
            asm volatile("" : "+v"(x) : "v"(ta), "v"(tb));
            v2u xw; xw.x = pk2(x[0], x[1]); xw.y = pk2(x[2], x[3]);
            *(LAS v2u*)xp = xw;
            asm volatile("s_waitcnt lgkmcnt(0)" ::: "memory");
        }
    }
    __syncthreads();
    if (ci_next < scn::NCH) gdn_load_raw(p, ci_next, R);
    for (int rp_ = 0; rp_ < GREP_S4; ++rp_) {
        const int type = wid >> 1, hf = wid & 1;
        const float dlast = sc_dl[0];
        if (type < 2) {
#pragma unroll
            for (int half = 0; half < 2; ++half) {
                int xr[4], yr[4]; f32x4 acc[4];
#pragma unroll
                for (int i = 0; i < 4; ++i) { const int rb = 2 * half + (i >> 1), cbk = 2 * hf + (i & 1); acc[i] = zacc();
                    xr[i] = 16 * rb; yr[i] = (type == 0 ? 64 : 0) + 16 * cbk; }
                if (type == 0) mm_batch<4, 64>(lds + G_KTD, xr, lds + G_XT, yr, acc, c15, g);
                else { int yk[4];
#pragma unroll
                    for (int i = 0; i < 4; ++i) yk[i] = 16 * (2 * hf + (i & 1));
                    mm_batch<4, 64>(lds + G_XT, xr, lds + G_KTD, yk, acc, c15, g); }
#pragma unroll
                for (int i = 0; i < 4; ++i) { const int rb = 2 * half + (i >> 1), col = 16 * (2 * hf + (i & 1)) + c15;
#pragma unroll
                    for (int r = 0; r < 4; ++r) { const int row = 16 * rb + 4 * g + r;
                        if (type == 0) *(LAS float*)(lds + G_ST_MF + row * 272 + col * 4) = ((row == col) ? dlast : 0.f) - acc[i][r];
                        else *(LAS float*)(lds + G_ST_SL + row * 272 + col * 4) = acc[i][r]; } }
            }
        } else {
            const int ybase = (type == 2 ? 64 : 0);
#pragma unroll
            for (int rb = 0; rb < 4; ++rb) {
                int xr[2] = {16 * rb, 16 * rb}, yr[2] = {ybase + 16 * (2 * hf), ybase + 16 * (2 * hf + 1)}; f32x4 acc[2] = {zacc(), zacc()};
                if (rb == 0) mm_batch<2, 16>(lds + G_AQK, xr, lds + G_XT, yr, acc, c15, g);
                if (rb == 1) mm_batch<2, 32>(lds + G_AQK, xr, lds + G_XT, yr, acc, c15, g);
                if (rb == 2) mm_batch<2, 48>(lds + G_AQK, xr, lds + G_XT, yr, acc, c15, g);
                if (rb == 3) mm_batch<2, 64>(lds + G_AQK, xr, lds + G_XT, yr, acc, c15, g);
#pragma unroll
                for (int i = 0; i < 2; ++i) { const int col = 16 * (2 * hf + i) + c15;
#pragma unroll
                    for (int r = 0; r < 4; ++r) { const int row = 16 * rb + 4 * g + r;
                        if (type == 2) *(LAS bf16*)(lds + G_ST_QT + row * ROWB + 2 * col) = (bf16)f2bf(sc_eg[row] * bf2f(*(const LAS bf16*)(lds + G_QH + row * ROWB + 2 * col)) - acc[i][r]);
                        else *(LAS bf16*)(lds + G_ST_Y + row * ROWB + 2 * col) = (bf16)f2bf(acc[i][r]); } }
            }
        }
    }
    __syncthreads();
    {
        float* MF = (float*)(p.ws + WS_SCR + scn::B_GMF + (size_t)ci * scn::CH_SL);
        float* SL = (float*)(p.ws + WS_SCR + scn::B_GSL + (size_t)ci * scn::CH_SL);
        bf16* QT = (bf16*)(p.ws + WS_XB + scn::A_GQT + (size_t)ci * scn::CH_QT);
        bf16* Y = (bf16*)(p.ws + WS_Y) + ((size_t)b * SEQ + t0) * DM + 0 + h * 64;
#pragma unroll
        for (int i = 0; i < 2; ++i) { const int pz = tid + 512 * i, row = pz >> 4, c4 = pz & 15;
            *(v4u*)(MF + row * 64 + c4 * 4) = *(const LAS v4u*)(lds + G_ST_MF + row * 272 + c4 * 16);
            *(v4u*)(SL + row * 64 + c4 * 4) = *(const LAS v4u*)(lds + G_ST_SL + row * 272 + c4 * 16); }
        { const int row = tid >> 3, c8 = tid & 7;
            *(v4u*)(QT + row * 64 + c8 * 8) = *(const LAS v4u*)(lds + G_ST_QT + row * ROWB + c8 * 16);
            *(v4u*)(Y + (size_t)row * DM + c8 * 8) = *(const LAS v4u*)(lds + G_ST_Y + row * ROWB + c8 * 16); }
    }
}

struct HgrnRaw { bf16 q[8], f[8], v[8]; };
__device__ __forceinline__ void hgrn_load_raw(const Params& p, int ci, HgrnRaw& R) {
    const int tid = TIDX(), ch = tid & 63, tq = tid >> 6;
    const int b = ci >> 7, h = (ci >> 5) & 3, n = ci & 31, t0 = n * 64;
    const bf16* P = (const bf16*)(p.ws + WS_PROJ) + ((size_t)b * SEQ + t0) * PC + h * 64;
#pragma unroll
    for (int i = 0; i < 8; ++i) { const bf16* pr = P + (size_t)(8 * tq + i) * PC + ch; R.q[i] = pr[C_HQ]; R.f[i] = pr[C_HF]; R.v[i] = pr[C_HI]; }
}
constexpr int H_QD = 0, H_KD = 9216, H_QO = 18432, H_KO1 = 27648  , H_KO2 = 29952  , H_KO3 = 34560  , H_KTD = 41472, H_VT = 50688, H_A = 59904, H_SC = 69120  , H_ST_SL = 73728, H_ST_Y = 91136;
__device__ __forceinline__ void hgrn_chunk(const Params& p, int l, int ci, int ci_next, HgrnRaw& R, LAS unsigned char* lds) {
    const int tid = TIDX(), lane = tid & 63, wid = __builtin_amdgcn_readfirstlane(tid >> 6), c15 = lane & 15, g = lane >> 4;
    const int b = ci >> 7, h = (ci >> 5) & 3, n = ci & 31, t0 = n * 64;
    const bf16* P = (const bf16*)(p.ws + WS_PROJ) + ((size_t)b * SEQ + t0) * PC + h * 64;
    LAS float* s_tot = (LAS float*)(lds + H_SC); LAS float* s_gm = s_tot + 512; LAS float* s_gr = s_tot + 768;
    const int ch = tid & 63, tq = tid >> 6;
    float lb = 0.f;
    if (l == 1) { const float a0 = p.hgrn_lb[h * 64 + ch], a1 = p.hgrn_lb[GW + h * 64 + ch]; lb = __builtin_amdgcn_rcpf(1.0f + fexp(a0 - a1)); }
    float qv[8], kv[8], vv[8], G[8];
    {
        float run = 0.f;
#pragma unroll
        for (int i = 0; i < 8; ++i) {
            const float qr = bf2f(R.q[i]), fr = bf2f(R.f[i]); vv[i] = bf2f(R.v[i]);
            const float sg = fsigmoid(fr), fg = lb + (1.0f - lb) * sg;
            kv[i] = (1.0f - lb) * (1.0f - sg); qv[i] = fsilu(qr);
            run += 0.6931471805599453f * __builtin_amdgcn_logf(fg); G[i] = run; }
        __syncthreads();
        s_tot[tq * 64 + ch] = run;
    }
    __syncthreads();
    float Glast;
    {
        float pre = 0.f, tot = 0.f;
#pragma unroll
        for (int j = 0; j < 8; ++j) { const float tj = s_tot[j * 64 + ch]; tot += tj; if (j < tq) pre += tj; }
#pragma unroll
        for (int i = 0; i < 8; ++i) G[i] += pre;
        Glast = tot;
        if (tq & 1) s_gm[(tq >> 1) * 64 + ch] = G[0];
        else if (tq > 0) s_gr[(tq >> 1) * 64 + ch] = pre;
    }
    __syncthreads();
    {
        const int I = tq >> 1;
        const float gm = s_gm[I * 64 + ch], gr = (I > 0) ? s_gr[I * 64 + ch] : 0.f;
        const float gr1 = s_gr[64 + ch], gr2 = s_gr[128 + ch], gr3 = s_gr[192 + ch];
        bf16* QT = (bf16*)(p.ws + WS_XB + scn::A_HQT + (size_t)ci * scn::CH_QT);
        float kt[8];
#pragma unroll
        for (int i = 0; i < 8; ++i) { const int tok = 8 * tq + i;
            QT[tok * 64 + ch] = (bf16)f2bf(qv[i] * fexp(G[i]));
            *(LAS bf16*)(lds + H_QD + tok * ROWB + 2 * ch) = (bf16)f2bf(qv[i] * fexp(G[i] - gm));
            *(LAS bf16*)(lds + H_KD + tok * ROWB + 2 * ch) = (bf16)f2bf(kv[i] * fexp(gm - G[i]));
            if (I > 0) *(LAS bf16*)(lds + H_QO + tok * ROWB + 2 * ch) = (bf16)f2bf(qv[i] * fexp(G[i] - gr));
            if (I < 1) *(LAS bf16*)(lds + H_KO1 + tok * ROWB + 2 * ch) = (bf16)f2bf(kv[i] * fexp(gr1 - G[i]));
            if (I < 2) *(LAS bf16*)(lds + H_KO2 + tok * ROWB + 2 * ch) = (bf16)f2bf(kv[i] * fexp(gr2 - G[i]));
            if (I < 3) *(LAS bf16*)(lds + H_KO3 + tok * ROWB + 2 * ch) = (bf16)f2bf(kv[i] * fexp(gr3 - G[i]));
            kt[i] = kv[i] * fexp(Glast - G[i]); }
        *(LAS v4u*)(lds + H_KTD + ch * ROWB + 16 * tq) = pack8(kt);
        *(LAS v4u*)(lds + H_VT + ch * ROWB + 16 * tq) = pack8(vv);
        if (tq == 0) ((float*)(p.ws + WS_SCR + scn::B_HDL + (size_t)ci * scn::CH_DL))[ch] = fexp(Glast);
    }
    __syncthreads();
    if (ci_next < scn::NCH) hgrn_load_raw(p, ci_next, R);
    {
        for (int t = wid; t < 10; t += 8) {
            f32x4 acc = zacc();
            const int I = (t >= 6) ? 3 : (t >= 3) ? 2 : (t >= 1) ? 1 : 0, J = t - (I * (I + 1)) / 2;
            if (I == J) acc = mmk<64>(lds + H_QD, 16 * I, lds + H_KD, 16 * I, acc, c15, g);
            else acc = mmk<64>(lds + H_QO, 16 * I, lds + (I == 1 ? H_KO1 : I == 2 ? H_KO2 : H_KO3), 16 * J, acc, c15, g);
#pragma unroll
            for (int r = 0; r < 4; ++r) { const int ii = 16 * I + 4 * g + r, jj = 16 * J + c15; *(LAS bf16*)(lds + H_A + ii * ROWB + 2 * jj) = (bf16)f2bf((jj <= ii) ? acc[r] : 0.f); }
        }
        {
            int xr[2], yr[2]; f32x4 acc[2] = {zacc(), zacc()};
#pragma unroll
            for (int i = 0; i < 2; ++i) { const int u = wid + 8 * i; xr[i] = 16 * (u >> 2); yr[i] = 16 * (u & 3); }
            mm_batch<2, 64>(lds + H_VT, xr, lds + H_KTD, yr, acc, c15, g);
#pragma unroll
            for (int i = 0; i < 2; ++i) { const int u = wid + 8 * i, rb = u >> 2, cbk = u & 3;
#pragma unroll
                for (int r = 0; r < 4; ++r) *(LAS float*)(lds + H_ST_SL + (16 * rb + 4 * g + r) * 272 + (16 * cbk + c15) * 4) = acc[i][r]; }
        }
    }
    __syncthreads();
    {
        bf16* Y = (bf16*)(p.ws + WS_Y) + ((size_t)b * SEQ + t0) * DM + 256 + h * 64;
        {
            const int rb = wid >> 1, c0 = (wid & 1) * 2;
            int xr[2] = {16 * rb, 16 * rb}, yr[2] = {16 * c0, 16 * (c0 + 1)}; f32x4 acc[2] = {zacc(), zacc()};
            if (rb == 0) mm_batch<2, 16>(lds + H_A, xr, lds + H_VT, yr, acc, c15, g);
            else if (rb == 1) mm_batch<2, 32>(lds + H_A, xr, lds + H_VT, yr, acc, c15, g);
            else if (rb == 2) mm_batch<2, 48>(lds + H_A, xr, lds + H_VT, yr, acc, c15, g);
            else mm_batch<2, 64>(lds + H_A, xr, lds + H_VT, yr, acc, c15, g);
#pragma unroll
            for (int i = 0; i < 2; ++i)
#pragma unroll
                for (int r = 0; r < 4; ++r) *(LAS bf16*)(lds + H_ST_Y + (16 * rb + 4 * g + r) * ROWB + 2 * (16 * (c0 + i) + c15)) = (bf16)f2bf(acc[i][r]);
        }
        __syncthreads();
        float* SL = (float*)(p.ws + WS_SCR + scn::B_HSL + (size_t)ci * scn::CH_SL);
#pragma unroll
        for (int i = 0; i < 2; ++i) { const int pz = tid + 512 * i, row = pz >> 4, c4 = pz & 15; *(v4u*)(SL + row * 64 + c4 * 4) = *(const LAS v4u*)(lds + H_ST_SL + row * 272 + c4 * 16); }
        { const int row = tid >> 3, c8 = tid & 7; *(v4u*)(Y + (size_t)row * DM + c8 * 8) = *(const LAS v4u*)(lds + H_ST_Y + row * ROWB + c8 * 16); }
    }
}

#ifndef WY_GDN
#define WY_GDN 1
#endif
#ifndef WY_REP_G
#define WY_REP_G 1
#endif
#ifndef WY_REP_H
#define WY_REP_H 1
#endif
#ifndef WY_HGRN
#define WY_HGRN 1
#endif
__device__ __forceinline__ void phase_pre_mfma(const Params& p, int l, LAS unsigned char* lds) {
    const int wave = TIDX() >> 6;
    LAS float* wl = (LAS float*)(lds + 100 * 1024 + wave * 1024);
    const int gw = BIDX() * NWAVES + wave, NGW = gridDim.x * NWAVES;
    if (WY_GDN && WY_OUTMASK == 15) { for (int rep = 0; rep < WY_REP_G; ++rep) { GdnRaw R; if (BIDX() < scn::NCH) gdn_load_raw(p, BIDX(), R);
        { const int hh = (BIDX() >> 5) & 3; const float* cwp = p.conv_w + (size_t)l * 4 * 768 + hh * 64; LAS float* wl_ = (LAS float*)(lds + G_CW);
          __syncthreads();
          for (int i = TIDX(); i < 768; i += NT) { const int c8 = i / 96, rem = i % 96, r = rem / 24, j = (rem % 24) >> 2, e = rem & 3;
              wl_[i] = cwp[r * 768 + (j >> 1) * 256 + 8 * c8 + (j & 1) * 4 + e]; }
        } for (int ci = BIDX(); ci < scn::NCH; ci += gridDim.x) gdn_chunk(p, l, ci, ci + (int)gridDim.x, R, lds); } }
    else { for (int it = gw; it < 2 * scn::NCH; it += NGW) scn::gdn_pre<1>(p, l, it, wl); for (int it = gw; it < 2 * scn::NCH; it += NGW) scn::gdn_pre<0>(p, l, it, wl); }
    if (WY_HGRN) { for (int rep = 0; rep < WY_REP_H; ++rep) { HgrnRaw R; if (BIDX() < scn::NCH) hgrn_load_raw(p, BIDX(), R); for (int ci = BIDX(); ci < scn::NCH; ci += gridDim.x) hgrn_chunk(p, l, ci, ci + (int)gridDim.x, R, lds); } }
    else { __syncthreads(); for (int it = gw; it < scn::NCH; it += NGW) scn::hgrn_pre(p, l, it, wl); }
    __syncthreads();
    for (int it = gw; it < NB * NH * 8 * 4; it += NGW) scn::kmean_item(p, it);
}
}
#ifndef FUSED_POST
#define FUSED_POST 0
#endif
#ifndef GIN_ALIGN
#define GIN_ALIGN true
#endif
#ifndef GIN_SP2
#define GIN_SP2 true
#endif
#ifndef REP_PRE
#define REP_PRE 1
#endif
#ifndef REP_POST0
#define REP_POST0 1
#endif
#ifndef REP_PROLOGUE
#define REP_PROLOGUE 1
#endif
#ifndef REP_BAR
#define REP_BAR 1
#endif
#ifndef REP_GIN
#define REP_GIN 1
#endif
#ifndef REP_GOUT
#define REP_GOUT 1
#endif
#ifndef REP_OUT
#define REP_OUT 1
#endif
#ifndef REP_MIX
#define REP_MIX 1
#endif

__device__ __forceinline__ Params load_params() {
    const __attribute__((address_space(4))) Params* q = (const __attribute__((address_space(4))) Params*)__builtin_amdgcn_kernarg_segment_ptr();
    asm volatile("" : "+s"(q));
    return *(const Params*)q;
}
__device__ __forceinline__ void grid_barrier(LAS unsigned char* lds) {
    const Params p = load_params();
    XcdBarrier bar; bar.bar = (unsigned*)(p.ws + WS_CTL) + 4096; bar.x = xb_xcc_id(); bar.st = (volatile LAS unsigned*)(lds + 131072 + 64);
    xcd_barrier(bar);
}
__global__ void __launch_bounds__(NT, 2) fwd_megakernel(Params p_unused) {
    extern __shared__ __attribute__((aligned(16))) unsigned char lds_raw[];
    LAS unsigned char* lds = (LAS unsigned char*)lds_raw;
    {
        const Params p = load_params();
        volatile LAS unsigned* st = (volatile LAS unsigned*)(lds + 131072 + 64);
        if (TIDX() < 2) st[TIDX()] = 0u;
        __syncthreads();
        (void)xcd_barrier_post((unsigned*)(p.ws + WS_CTL) + 4096, st);
        for (int rep = 0; rep < REP_PROLOGUE; ++rep) phase_prologue(p, lds);
    }
    grid_barrier(lds);
#pragma unroll 1
    for (int l = 0; l < DEPTH; ++l) {
        for (int rep = 0; rep < REP_GIN; ++rep) {
            const Params p = load_params();
            pg8::Gemm g{(const bf16*)(p.ws + WS_XB), (const bf16*)(p.ws + WS_WIN) + (size_t)l * PC * DM, NTOK, PC, DM}; pg8::StaticOrder S; S.init(NTOK, PC, (int)gridDim.x, BIDX());
            pg8::EpiProj E{(bf16*)(p.ws + WS_PROJ), PC, (const float*)(p.ws + WS_RSTD)};
            pg8::gemm_phase<pg8::EpiProj, pg8::StaticOrder, GIN_ALIGN, GIN_SP2>(lds, g, S, E);
        }
        grid_barrier(lds);
        for (int rep = 0; rep < REP_PRE; ++rep) { const Params p = load_params(); wy::phase_pre_mfma(p, l, lds); }

        grid_barrier(lds);
        { const Params p = load_params(); phase_mix(p, l, lds); }
        for (int rep = 0; rep < REP_BAR; ++rep) grid_barrier(lds);
        for (int rep = 0; rep < REP_OUT; ++rep) { const Params p = load_params(); scn::phase_out(p, l, rep + 1 < REP_OUT); }
        grid_barrier(lds);
#if FUSED_POST
#pragma unroll 1
        for (int hf = 0; hf < 2; ++hf) {
            const Params p = load_params();
            const bool more = (l + 1 < DEPTH);
            const size_t ro = (size_t)hf * (NTOK / 2);
            pg8::Gemm g{(const bf16*)(p.ws + WS_Y) + ro * DM, (const bf16*)(p.ws + WS_WOUT) + (size_t)l * DM * DM, NTOK / 2, DM, DM}; pg8::StaticOrder S; S.init(NTOK / 2, DM, (int)gridDim.x, BIDX());
            pg8::PanelSsq st{(float*)(p.ws + WS_CTL + 262144), nullptr, (unsigned*)(p.ws + WS_CTL) + 2, EPS};
            pg8::EpiRmsRes E{(l == 0) ? p.x : p.out, p.out, more ? (bf16*)(p.ws + WS_XB) : nullptr, p.post_g + l * DM, DM, (int)ro, st, (unsigned*)(p.ws + WS_CTL) + 8192 + (l * 2 + hf) * 1024};
            pg8::gemm_phase<pg8::EpiRmsRes, pg8::StaticOrder, false, true>(lds, g, S, E);
        }
        grid_barrier(lds);
        if (l + 1 < DEPTH) { { const Params p = load_params(); phase_post2(p, l, lds); } grid_barrier(lds); }
#else
        for (int rep = 0; rep < REP_GOUT; ++rep) {
            const Params p = load_params();
            pg8::Gemm g{(const bf16*)(p.ws + WS_Y), (const bf16*)(p.ws + WS_WOUT) + (size_t)l * DM * DM, NTOK, DM, DM}; pg8::StaticOrder S; S.init(NTOK, DM, (int)gridDim.x, BIDX());
            pg8::EpiBf16Plain E{(bf16*)(p.ws + WS_PROJ), DM};
            pg8::gemm_phase<pg8::EpiBf16Plain, pg8::StaticOrder, true, true>(lds, g, S, E);
        }
        grid_barrier(lds);
        for (int rep = 0; rep < ((l == 0) ? REP_POST0 : 1); ++rep) { const Params p = load_params(); phase_post(p, l, lds); }
        grid_barrier(lds);
#endif
    }
}

extern "C" void kernel_launch(void* const* d_in, const int* in_sizes, int n_in, void* d_out, int out_size, void* d_ws, size_t ws_size, hipStream_t stream) {
    static int grid_blocks = 0;
    if (!grid_blocks) {
        if (ws_size < WS_END) { fprintf(stderr, "workspace too small: %zu < %zu\n", ws_size, (size_t)WS_END); grid_blocks = -1; return; }
        int dev = 0, cus = 0, per_cu = 0;
        (void)hipGetDevice(&dev);
        (void)hipDeviceGetAttribute(&cus, hipDeviceAttributeMultiprocessorCount, dev);
        (void)hipFuncSetAttribute((const void*)fwd_megakernel, hipFuncAttributeMaxDynamicSharedMemorySize, LDS_BYTES);
        (void)hipOccupancyMaxActiveBlocksPerMultiprocessor(&per_cu, (const void*)fwd_megakernel, NT, LDS_BYTES);
        if (per_cu < 1) { fprintf(stderr, "occupancy query says %d blocks/CU\n", per_cu); per_cu = 1; }
        grid_blocks = cus * 1;
    }
    if (grid_blocks < 0) return;
    (void)hipMemsetAsync((char*)d_ws + WS_CTL, 0, 65536, stream);
    Params p{};
    p.x = (const float*)d_in[0]; p.pre_g = (const float*)d_in[1]; p.post_g = (const float*)d_in[2]; p.w_in = (const float*)d_in[3];
    p.conv_w = (const float*)d_in[4]; p.a_log = (const float*)d_in[5]; p.dt_bias = (const float*)d_in[6]; p.gdn_g = (const float*)d_in[7];
    p.hgrn_lb = (const float*)d_in[8]; p.hgrn_g = (const float*)d_in[9]; p.lq1 = (const float*)d_in[10]; p.lk1 = (const float*)d_in[11];
    p.lq2 = (const float*)d_in[12]; p.lk2 = (const float*)d_in[13]; p.diff_g = (const float*)d_in[14]; p.w_out = (const float*)d_in[15];
    p.out = (float*)d_out; p.ws = (unsigned char*)d_ws;
    void* args[] = {&p};
    hipError_t e = hipLaunchCooperativeKernel((void*)fwd_megakernel, dim3(grid_blocks), dim3(NT), args, LDS_BYTES, stream);
    if (e != hipSuccess) fprintf(stderr, "cooperative launch failed: %s (grid %d)\n", hipGetErrorString(e), grid_blocks);
}
```

```cpp
#include <hip/hip_runtime.h>
#include <hip/hip_cooperative_groups.h>
#include <cstdio>
#include <cstdint>
#include <cmath>
namespace cg = cooperative_groups;
__device__ __forceinline__ int TIDX() { int t = threadIdx.x; asm volatile("" : "+v"(t)); return t; }
__device__ __forceinline__ int BIDX() { int b = blockIdx.x; asm volatile("" : "+s"(b)); return b; }
namespace pg8 {
#define PG8_LAS __attribute__((address_space(3)))
typedef unsigned short bf16_t;
typedef short bf16x8 __attribute__((ext_vector_type(8)));
typedef float f32x4 __attribute__((ext_vector_type(4)));
typedef unsigned u32x4 __attribute__((ext_vector_type(4)));
constexpr int BM = 256, BK = 64, HALF = 128, HTB = HALF * BK * 2  , STAGE_BYTES = 8 * HTB, NXCD = 8, WGM = 8;

__host__ __device__ __forceinline__ int lds_byte(int r, int c) { const int st = (r >> 4) * 2 + (c >> 5), rr = r & 15, cc = c & 31, ob = rr * 64 + cc * 2; return st * 1024 + (ob ^ (((ob >> 9) & 1) << 5)); }
__host__ __device__ __forceinline__ void stage_rc(int b, int& R, int& C) { const int st = b / 1024, sb = b % 1024, swz = sb ^ (((sb >> 9) & 1) << 5); R = (st >> 1) * 16 + swz / 64; C = (st & 1) * 32 + (swz % 64) / 2; }
__host__ __device__ __forceinline__ int perm32(int rho) { const int n = rho >> 4, i = rho & 15; return 8 * (i >> 2) + 4 * n + (i & 3); }

struct Unit { int pm, pn; };
struct Gemm { const bf16_t* A; const bf16_t* Bt; int M, N, K; };

struct StaticOrder {
    int nM, nN, nwg, G, c;
    __host__ __device__ void init(int M, int N, int G_, int c_) { nM = M / BM; nN = N / BM; nwg = nM * nN; G = G_; c = c_; }
    __host__ __device__ bool next(int i, Unit& u) const {
        const long L = (long)i * G + c; if (L >= nwg) return false;
        int wgid = (int)L; { const int q = nwg / NXCD, r = nwg % NXCD, xcd = wgid % NXCD, off = wgid / NXCD; wgid = (xcd < r ? xcd * (q + 1) : r * (q + 1) + (xcd - r) * q) + off; }
        const int nig = WGM * nN, gid = wgid / nig, fm = gid * WGM, gsz = (nM - fm) < WGM ? (nM - fm) : WGM;
        u.pm = fm + ((wgid % nig) % gsz); u.pn = (wgid % nig) / gsz; return true;
    }
    __device__ __forceinline__ void a_ready(const Unit&) const {}
    __device__ __forceinline__ void done(const Unit&) const {}
};
__device__ __forceinline__ unsigned cvt_pk_bf16(float lo, float hi) { unsigned r; asm volatile("v_cvt_pk_bf16_f32 %0, %1, %2" : "=v"(r) : "v"(lo), "v"(hi)); return r; }
struct EpiProj {
    static constexpr bool PERM = true, AFTER_DRAIN = false;
    bf16_t* O; int ldc; const float* rstd;
    __device__ __forceinline__ void operator()(const f32x4 (&acc)[2][2][4][2], const Unit& u, int wr, int wc, int fr, int fq) const {
        const int row0 = u.pm * BM + wr * 64 + fr, col0 = u.pn * BM + wc * 32 + 8 * fq;
#pragma unroll
        for (int ai = 0; ai < 2; ++ai)
#pragma unroll
            for (int m = 0; m < 4; ++m) { const int row = row0 + ai * HALF + m * 16; const float s = rstd[row]; bf16_t* rowp = O + (size_t)row * ldc + col0;
#pragma unroll
                for (int bj = 0; bj < 2; ++bj) { const f32x4 v0 = acc[ai][bj][m][0] * s, v1 = acc[ai][bj][m][1] * s;
                    u32x4 w; w.x = cvt_pk_bf16(v0[0], v0[1]); w.y = cvt_pk_bf16(v0[2], v0[3]); w.z = cvt_pk_bf16(v1[0], v1[1]); w.w = cvt_pk_bf16(v1[2], v1[3]);
                    *(u32x4*)(rowp + bj * HALF) = w; } }
    }
};
struct EpiF32 {
    static constexpr bool PERM = false, AFTER_DRAIN = false;
    float* O; int ldc;
    __device__ __forceinline__ void operator()(const f32x4 (&acc)[2][2][4][2], const Unit& u, int wr, int wc, int fr, int fq) const {
        const int row0 = u.pm * BM + wr * 64 + fr, col0 = u.pn * BM + wc * 32 + 4 * fq;
#pragma unroll
        for (int ai = 0; ai < 2; ++ai)
#pragma unroll
            for (int m = 0; m < 4; ++m) { float* rowp = O + (size_t)(row0 + ai * HALF + m * 16) * ldc + col0;
#pragma unroll
                for (int bj = 0; bj < 2; ++bj)
#pragma unroll
                    for (int n = 0; n < 2; ++n) *(f32x4*)(rowp + bj * HALF + n * 16) = acc[ai][bj][m][n]; }
    }
};
struct EpiBf16Plain {
    static constexpr bool PERM = true, AFTER_DRAIN = false;
    bf16_t* O; int ldc;
    __device__ __forceinline__ void operator()(const f32x4 (&acc)[2][2][4][2], const Unit& u, int wr, int wc, int fr, int fq) const {
        const int row0 = u.pm * BM + wr * 64 + fr, col0 = u.pn * BM + wc * 32 + 8 * fq;
#pragma unroll
        for (int ai = 0; ai < 2; ++ai)
#pragma unroll
            for (int m = 0; m < 4; ++m) { bf16_t* rowp = O + (size_t)(row0 + ai * HALF + m * 16) * ldc + col0;
#pragma unroll
                for (int bj = 0; bj < 2; ++bj) { const f32x4 v0 = acc[ai][bj][m][0], v1 = acc[ai][bj][m][1];
                    u32x4 w; w.x = cvt_pk_bf16(v0[0], v0[1]); w.y = cvt_pk_bf16(v0[2], v0[3]); w.z = cvt_pk_bf16(v1[0], v1[1]); w.w = cvt_pk_bf16(v1[2], v1[3]);
                    *(u32x4*)(rowp + bj * HALF) = w; } }
    }
};
struct PanelSsq {
    float* slots;
    unsigned* cnt;
    unsigned* tmo;
    float eps;
    __device__ __forceinline__ bool run(const f32x4 (&v)[2][2][4][2], int row_base, int pn, int wr, int wc, int fr, int fq, PG8_LAS unsigned char* lds, int wid, int lane) const {
        PG8_LAS float* P = (PG8_LAS float*)lds;
        PG8_LAS float* S = (PG8_LAS float*)(lds + 8192);
        PG8_LAS unsigned* flag = (PG8_LAS unsigned*)(lds + 8192 + 2048);
#pragma unroll
        for (int ai = 0; ai < 2; ++ai)
#pragma unroll
            for (int m = 0; m < 4; ++m) {
                float s = 0.f;
#pragma unroll
                for (int bj = 0; bj < 2; ++bj)
#pragma unroll
                    for (int n = 0; n < 2; ++n) { const f32x4 x = v[ai][bj][m][n]; s += (x[0] * x[0] + x[1] * x[1]) + (x[2] * x[2] + x[3] * x[3]); }
                s += __shfl_xor(s, 16); s += __shfl_xor(s, 32);
                if (fq == 0) P[(ai * HALF + wr * 64 + m * 16 + fr) * 4 + wc] = s;
            }
        asm volatile("s_waitcnt lgkmcnt(0)" ::: "memory"); __builtin_amdgcn_s_barrier(); asm volatile("" ::: "memory");
        const int row = wid * 32 + (lane & 31);
        if (lane < 32) { const float t = (P[row * 4 + 0] + P[row * 4 + 1]) + (P[row * 4 + 2] + P[row * 4 + 3]);
            __hip_atomic_store(slots + (size_t)(row_base + row) * 4 + pn, t, __ATOMIC_RELAXED, __HIP_MEMORY_SCOPE_AGENT); }
        asm volatile("s_waitcnt vmcnt(0)" ::: "memory");
        if (lane == 0) __hip_atomic_fetch_add(cnt, 1u, __ATOMIC_RELAXED, __HIP_MEMORY_SCOPE_AGENT);
        if (wid == 0) {
            bool dead = false; const unsigned long long t0 = __builtin_amdgcn_s_memrealtime();
            for (;;) {
                if ((unsigned)__builtin_amdgcn_readfirstlane(__hip_atomic_load(cnt, __ATOMIC_RELAXED, __HIP_MEMORY_SCOPE_AGENT)) >= 32u) break;
                if (__builtin_amdgcn_s_memrealtime() - t0 > 2000000ull) { if (lane == 0) __hip_atomic_store(tmo, 1u, __ATOMIC_RELAXED, __HIP_MEMORY_SCOPE_AGENT); dead = true; break; }
                __builtin_amdgcn_s_sleep(2);
            }
            __builtin_amdgcn_fence(__ATOMIC_ACQUIRE, "agent");
            if (lane == 0) flag[0] = dead ? 1u : 0u;
        }
        asm volatile("s_waitcnt vmcnt(0) lgkmcnt(0)" ::: "memory"); __builtin_amdgcn_s_barrier(); asm volatile("" ::: "memory");
        const bool bad = flag[0] != 0u;
        if (lane < 32) { const float* sl = slots + (size_t)(row_base + row) * 4; float t = 0.f;
#pragma unroll
            for (int k = 0; k < 4; ++k) t += __hip_atomic_load(sl + k, __ATOMIC_RELAXED, __HIP_MEMORY_SCOPE_AGENT);
            S[row] = 1.0f / sqrtf(t * (1.0f / 1024.0f) + eps); }
        asm volatile("s_waitcnt lgkmcnt(0)" ::: "memory"); __builtin_amdgcn_s_barrier(); asm volatile("" ::: "memory");
        return bad;
    }
};
struct EpiRmsRes {
    static constexpr bool PERM = false, AFTER_DRAIN = true;
    const float* base; float* out; bf16_t* xb; const float* gain; int ldc; int row_off; PanelSsq st; unsigned* cnt_base;
    __device__ __forceinline__ void fused(f32x4 (&acc)[2][2][4][2], const Unit& u, int wr, int wc, int fr, int fq, PG8_LAS unsigned char* lds, int wid, int lane) const {
        typedef unsigned u32x2v __attribute__((ext_vector_type(2)));
        PanelSsq s2 = st; s2.cnt = cnt_base + 16 * u.pm;
        const int rowb = row_off + u.pm * BM;
        const bool bad = s2.run(acc, rowb, u.pn, wr, wc, fr, fq, lds, wid, lane);
        const PG8_LAS float* S = (const PG8_LAS float*)(lds + 8192);
        const int col0 = u.pn * BM + wc * 32 + 4 * fq;
        const float qnan = __builtin_nanf("");
        f32x4 gv[2][2];
#pragma unroll
        for (int bj = 0; bj < 2; ++bj)
#pragma unroll
            for (int n = 0; n < 2; ++n) gv[bj][n] = *(const f32x4*)(gain + col0 + bj * HALF + n * 16);
#pragma unroll
        for (int ai = 0; ai < 2; ++ai)
#pragma unroll
            for (int m = 0; m < 4; ++m) { const int r = ai * HALF + wr * 64 + m * 16 + fr; const float rs = S[r]; const size_t off = (size_t)(rowb + r) * ldc + col0;
#pragma unroll
                for (int bj = 0; bj < 2; ++bj)
#pragma unroll
                    for (int n = 0; n < 2; ++n) { const f32x4 bs = *(const f32x4*)(base + off + bj * HALF + n * 16); f32x4 o = bs + acc[ai][bj][m][n] * rs * gv[bj][n];
                        if (bad) o = (f32x4){qnan, qnan, qnan, qnan};
                        *(f32x4*)(out + off + bj * HALF + n * 16) = o;
                        if (xb) { u32x2v w; w.x = cvt_pk_bf16(o[0], o[1]); w.y = cvt_pk_bf16(o[2], o[3]); *(u32x2v*)(xb + off + bj * HALF + n * 16) = w; } }
                if (m & 1) asm volatile("" ::: "memory"); }
    }
};
template <class Epi, class Sched, bool ALIGN_EPI = false, bool SP2 = false>
__device__ __forceinline__ void gemm_phase(PG8_LAS unsigned char* lds, const Gemm g, const Sched& S, const Epi& E) {
    const int tid = TIDX(), wid = __builtin_amdgcn_readfirstlane(tid >> 6), lane = tid & 63, wr = wid >> 2, wc = wid & 3, fr = lane & 15, fq = lane >> 4;
    const int K = g.K, nt = K / BK;
    unsigned voffA[2], voffB[2];
#pragma unroll
    for (int i = 0; i < 2; ++i) { int R, C; stage_rc(tid * 16 + i * 8192, R, C); const int Rb = Epi::PERM ? ((R & ~31) + perm32(R & 31)) : R;
        voffA[i] = (unsigned)(R * K + C) * 2u; voffB[i] = (unsigned)(Rb * K + C) * 2u; }
    const size_t kstep = (size_t)(BK * 2);
    const size_t hstep = (size_t)HALF * K * 2;
    const size_t tstep = 2 * hstep;
    const unsigned ldsw = (unsigned)wid * 1024u;
    const int aoff = lds_byte(wr * 64 + fr, fq * 8), boff = lds_byte(wc * 32 + fr, fq * 8);
#define PG8_SA(b, h) (((b) * 2 + (h)) * HTB)
#define PG8_SB(b, h) ((4 + (b) * 2 + (h)) * HTB)
#define PG8_STAGE(bufoff, gbase, voff) do { _Pragma("unroll") for (int _i = 0; _i < 2; ++_i) \
        __builtin_amdgcn_global_load_lds((const unsigned*)((const char*)(gbase) + (voff)[_i]), (PG8_LAS unsigned*)(lds + (bufoff) + ldsw + _i * 8192), 16, 0, 0); } while (0)
#define PG8_LDA(dst, b, h) do { _Pragma("unroll") for (int m = 0; m < 4; ++m) _Pragma("unroll") for (int k = 0; k < 2; ++k) dst[m][k] = *(const PG8_LAS bf16x8*)(lds + PG8_SA(b, h) + aoff + m * 2048 + k * 1024); } while (0)
#define PG8_LDB(dst, b, h) do { _Pragma("unroll") for (int n = 0; n < 2; ++n) _Pragma("unroll") for (int k = 0; k < 2; ++k) dst[n][k] = *(const PG8_LAS bf16x8*)(lds + PG8_SB(b, h) + boff + n * 2048 + k * 1024); } while (0)
#define PG8_MMA(ai, bj, At, Bt) do { __builtin_amdgcn_s_setprio(1); _Pragma("unroll") for (int m = 0; m < 4; ++m) _Pragma("unroll") for (int n = 0; n < 2; ++n) _Pragma("unroll") for (int k = 0; k < 2; ++k) \
        acc[ai][bj][m][n] = __builtin_amdgcn_mfma_f32_16x16x32_bf16(Bt[n][k], At[m][k], acc[ai][bj][m][n], 0, 0, 0); __builtin_amdgcn_s_setprio(0); } while (0)
#define PG8_WAIT_V(n) asm volatile("s_waitcnt vmcnt(" #n ")" ::: "memory")
#define PG8_WAIT_L(n) asm volatile("s_waitcnt lgkmcnt(" #n ")" ::: "memory")
#define PG8_BAR __builtin_amdgcn_s_barrier()
#define PG8_SCHED __builtin_amdgcn_sched_barrier(0)
    Unit cur, nxt; int ui = 0;
    if (!S.next(0, cur)) return;
    f32x4 acc[2][2][4][2];
#pragma unroll
    for (int a = 0; a < 2; ++a)
#pragma unroll
        for (int b = 0; b < 2; ++b)
#pragma unroll
            for (int m = 0; m < 4; ++m)
#pragma unroll
                for (int n = 0; n < 2; ++n) acc[a][b][m][n] = (f32x4){0.f, 0.f, 0.f, 0.f};
    bf16x8 At[4][2], B0[2][2], B1[2][2];
    const char* cA = (const char*)g.A + (size_t)cur.pm * tstep; const char* cB = (const char*)g.Bt + (size_t)cur.pn * tstep;
    S.a_ready(cur);
    if constexpr (SP2) {
        PG8_STAGE(PG8_SB(0, 0), cB, voffB); PG8_STAGE(PG8_SB(0, 1), cB + hstep, voffB); PG8_STAGE(PG8_SA(0, 0), cA, voffA); PG8_STAGE(PG8_SA(0, 1), cA + hstep, voffA);
        if (wr == 1) PG8_BAR;
        PG8_WAIT_V(2); PG8_BAR;
        PG8_STAGE(PG8_SB(1, 0), cB + kstep, voffB); PG8_STAGE(PG8_SA(1, 0), cA + kstep, voffA); PG8_STAGE(PG8_SB(1, 1), cB + hstep + kstep, voffB);
        PG8_WAIT_V(6); PG8_BAR;
    } else {
        PG8_STAGE(PG8_SB(0, 0), cB, voffB); PG8_STAGE(PG8_SA(0, 0), cA, voffA); PG8_STAGE(PG8_SB(0, 1), cB + hstep, voffB); PG8_STAGE(PG8_SA(0, 1), cA + hstep, voffA);
        if (wr == 1) PG8_BAR;
        PG8_WAIT_V(4); PG8_BAR;
        PG8_STAGE(PG8_SB(1, 0), cB + kstep, voffB); PG8_STAGE(PG8_SA(1, 0), cA + kstep, voffA); PG8_STAGE(PG8_SB(1, 1), cB + hstep + kstep, voffB);
        PG8_WAIT_V(6); PG8_BAR;
    }
    for (;;) {
        const bool has_next = S.next(ui + 1, nxt);
        const char* nA = has_next ? (const char*)g.A + (size_t)nxt.pm * tstep : cA; const char* nB = has_next ? (const char*)g.Bt + (size_t)nxt.pn * tstep : cB;
        for (int t = 0; t < nt; t += 2) {
            const bool last = (t == nt - 2);
            const char* a1 = cA + (size_t)(t + 1) * kstep;
            const char* a2 = last ? nA : cA + (size_t)(t + 2) * kstep; const char* b2 = last ? nB : cB + (size_t)(t + 2) * kstep;
            const char* a3 = a2 + kstep; const char* b3 = b2 + kstep;
            if (last && has_next) S.a_ready(nxt);
            if constexpr (SP2) {
            PG8_LDB(B0, 0, 0); PG8_LDB(B1, 0, 1); PG8_SCHED; PG8_LDA(At, 0, 0); PG8_STAGE(PG8_SA(1, 1), a1 + hstep, voffA);
            PG8_WAIT_V(8); PG8_WAIT_L(0); PG8_BAR; PG8_MMA(0, 0, At, B0); PG8_MMA(0, 1, At, B1); PG8_BAR; PG8_SCHED;
            PG8_LDA(At, 0, 1); PG8_STAGE(PG8_SB(0, 0), b2, voffB); PG8_STAGE(PG8_SB(0, 1), b2 + hstep, voffB); PG8_STAGE(PG8_SA(0, 0), a2, voffA);
            PG8_WAIT_V(8); PG8_WAIT_L(0); PG8_BAR; PG8_MMA(1, 0, At, B0); PG8_MMA(1, 1, At, B1); PG8_BAR; PG8_SCHED;
            PG8_LDB(B0, 1, 0); PG8_LDB(B1, 1, 1); PG8_SCHED; PG8_LDA(At, 1, 0); PG8_STAGE(PG8_SA(0, 1), a2 + hstep, voffA);
            PG8_WAIT_V(8); PG8_WAIT_L(0); PG8_BAR; PG8_MMA(0, 0, At, B0); PG8_MMA(0, 1, At, B1); PG8_BAR; PG8_SCHED;
            PG8_LDA(At, 1, 1); PG8_STAGE(PG8_SB(1, 0), b3, voffB); PG8_STAGE(PG8_SB(1, 1), b3 + hstep, voffB); PG8_STAGE(PG8_SA(1, 0), a3, voffA);
            PG8_WAIT_V(8); PG8_WAIT_L(0); PG8_BAR; PG8_MMA(1, 0, At, B0); PG8_MMA(1, 1, At, B1); PG8_BAR; PG8_SCHED;
            } else {
            PG8_LDB(B0, 0, 0); PG8_SCHED; PG8_LDA(At, 0, 0); PG8_STAGE(PG8_SA(1, 1), a1 + hstep, voffA);
            PG8_WAIT_L(8); PG8_BAR; PG8_WAIT_L(0); PG8_MMA(0, 0, At, B0); PG8_BAR; PG8_SCHED;
            PG8_LDB(B1, 0, 1); PG8_STAGE(PG8_SB(0, 0), b2, voffB);
            PG8_BAR; PG8_WAIT_L(0); PG8_MMA(0, 1, At, B1); PG8_BAR;
            PG8_LDA(At, 0, 1); PG8_STAGE(PG8_SA(0, 0), a2, voffA);
            PG8_BAR; PG8_WAIT_L(0); PG8_MMA(1, 0, At, B0); PG8_BAR; PG8_SCHED;
            PG8_STAGE(PG8_SB(0, 1), b2 + hstep, voffB);
            PG8_WAIT_V(6); PG8_BAR; PG8_MMA(1, 1, At, B1); PG8_BAR;
            PG8_LDB(B0, 1, 0); PG8_SCHED; PG8_LDA(At, 1, 0); PG8_STAGE(PG8_SA(0, 1), a2 + hstep, voffA);
            PG8_WAIT_L(8); PG8_BAR; PG8_WAIT_L(0); PG8_MMA(0, 0, At, B0); PG8_BAR; PG8_SCHED;
            PG8_LDB(B1, 1, 1); PG8_STAGE(PG8_SB(1, 0), b3, voffB);
            PG8_BAR; PG8_WAIT_L(0); PG8_MMA(0, 1, At, B1); PG8_BAR;
            PG8_LDA(At, 1, 1); PG8_STAGE(PG8_SA(1, 0), a3, voffA);
            PG8_BAR; PG8_WAIT_L(0); PG8_MMA(1, 0, At, B0); PG8_BAR; PG8_SCHED;
            PG8_STAGE(PG8_SB(1, 1), b3 + hstep, voffB);
            PG8_WAIT_V(6); PG8_BAR; PG8_MMA(1, 1, At, B1); PG8_BAR;
            }
        }
        if constexpr (ALIGN_EPI) { if (wr == 0) PG8_BAR; }
        if constexpr (!Epi::AFTER_DRAIN) { E(acc, cur, wr, wc, fr, fq); S.done(cur); }
        if (!has_next) break;
#pragma unroll
        for (int a = 0; a < 2; ++a)
#pragma unroll
            for (int b = 0; b < 2; ++b)
#pragma unroll
                for (int m = 0; m < 4; ++m)
#pragma unroll
                    for (int n = 0; n < 2; ++n) acc[a][b][m][n] = (f32x4){0.f, 0.f, 0.f, 0.f};
        cur = nxt; cA = nA; cB = nB; ++ui;
        if constexpr (ALIGN_EPI) { if (wr == 1) PG8_BAR; }
    }
    PG8_WAIT_V(0);
    if constexpr (!ALIGN_EPI) { if (wr == 0) PG8_BAR; }
    PG8_BAR;
    if constexpr (Epi::AFTER_DRAIN) { E.fused(acc, cur, wr, wc, fr, fq, lds, wid, lane); S.done(cur); }
#undef PG8_SA
#undef PG8_SB
#undef PG8_STAGE
#undef PG8_LDA
#undef PG8_LDB
#undef PG8_MMA
#undef PG8_WAIT_V
#undef PG8_WAIT_L
#undef PG8_BAR
#undef PG8_SCHED
}
}

#define LAS __attribute__((address_space(3)))
typedef unsigned short bf16;
typedef unsigned v4u __attribute__((ext_vector_type(4)));
typedef unsigned v2u __attribute__((ext_vector_type(2)));
typedef float f4 __attribute__((ext_vector_type(4)));
constexpr int DM = 1024, NB = 16, SEQ = 2048, DEPTH = 2, NTOK = NB * SEQ;
constexpr int GW = 256, NH = 4, HD = 64;
constexpr int INC = 4104;
constexpr int PC = 4096;
constexpr int NT = 512, NWAVES = 8;
constexpr float EPS = 1e-6f;
constexpr int C_GQ = 0, C_GK = 256, C_GV = 512, C_GZ = 768;
constexpr int C_HQ = 1024, C_HF = 1280, C_HI = 1536, C_HZ = 1792;
constexpr int C_MQ = 2048, C_MK = 2304, C_MV = 2560, C_MZ = 2816;
constexpr int C_DQ = 3072, C_DK = 3328, C_DV = 3584, C_DZ = 3840;
constexpr int LDS_BYTES = 147456;

constexpr size_t MiB = 1u << 20;
constexpr size_t WS_CTL = 0;
constexpr size_t WS_PROJ = 1 * MiB;
constexpr size_t WS_XB = WS_PROJ + 256 * MiB;
constexpr size_t WS_Y = WS_XB + 64 * MiB;
constexpr size_t WS_WIN = WS_Y + 64 * MiB;
constexpr size_t WS_WOUT = WS_WIN + 16 * MiB;
constexpr size_t WS_RSTD = WS_WOUT + 4 * MiB;
constexpr size_t WS_AB = WS_RSTD + 1 * MiB;
constexpr size_t WS_KMEAN = WS_AB + 1 * MiB;
constexpr size_t WS_SCR = WS_KMEAN + 1 * MiB;
constexpr size_t WS_END = WS_SCR + 104 * MiB;

struct Params {
    const float* x; const float* pre_g; const float* post_g; const float* w_in; const float* conv_w;
    const float* a_log; const float* dt_bias; const float* gdn_g; const float* hgrn_lb; const float* hgrn_g;
    const float* lq1; const float* lk1; const float* lq2; const float* lk2; const float* diff_g; const float* w_out;
    float* out; unsigned char* ws;
};

__device__ __forceinline__ float sigmoidf_(float x) { return 1.0f / (1.0f + expf(-x)); }
__device__ __forceinline__ float siluf_(float x) { return x / (1.0f + expf(-x)); }
__device__ __forceinline__ float softplusf_(float x) { return fmaxf(x, 0.f) + log1pf(expf(-fabsf(x))); }
__device__ __forceinline__ float fexp(float x) { return __builtin_amdgcn_exp2f(x * 1.4426950408889634f); }
__device__ __forceinline__ float fsigmoid(float x) { return __builtin_amdgcn_rcpf(1.0f + fexp(-x)); }
__device__ __forceinline__ float fsilu(float x) { return x * fsigmoid(x); }
__device__ __forceinline__ float fsoftplus(float x) { return fmaxf(x, 0.f) + 0.6931471805599453f * __builtin_amdgcn_logf(1.0f + fexp(-fabsf(x))); }
__device__ __forceinline__ float dpp_row16_sum(float v) {
    v += __int_as_float(__builtin_amdgcn_update_dpp(0, __float_as_int(v), 0xB1, 0xF, 0xF, true));
    v += __int_as_float(__builtin_amdgcn_update_dpp(0, __float_as_int(v), 0x4E, 0xF, 0xF, true));
    v += __int_as_float(__builtin_amdgcn_update_dpp(0, __float_as_int(v), 0x141, 0xF, 0xF, true));
    v += __int_as_float(__builtin_amdgcn_update_dpp(0, __float_as_int(v), 0x140, 0xF, 0xF, true));
    return v;
}
__device__ __forceinline__ float wave_sum(float v);
__device__ __forceinline__ float xor32_sum(float v) { const auto rr = __builtin_amdgcn_permlane32_swap(__float_as_uint(v), __float_as_uint(v), false, false); return __uint_as_float(rr[0]) + __uint_as_float(rr[1]); }
__device__ __forceinline__ float xor32_max(float v) { const auto rr = __builtin_amdgcn_permlane32_swap(__float_as_uint(v), __float_as_uint(v), false, false); return fmaxf(__uint_as_float(rr[0]), __uint_as_float(rr[1])); }
__device__ __forceinline__ float fwave_sum(float v) { v = dpp_row16_sum(v);
    return (__int_as_float(__builtin_amdgcn_readlane(__float_as_int(v), 0)) + __int_as_float(__builtin_amdgcn_readlane(__float_as_int(v), 16))) + (__int_as_float(__builtin_amdgcn_readlane(__float_as_int(v), 32)) + __int_as_float(__builtin_amdgcn_readlane(__float_as_int(v), 48))); }
__device__ __forceinline__ float bf2f(bf16 v) { return __uint_as_float((unsigned)v << 16); }
__device__ __forceinline__ unsigned pk2(float lo, float hi) { typedef float f2_ __attribute__((ext_vector_type(2))); typedef __bf16 b2_ __attribute__((ext_vector_type(2))); const f2_ v = {lo, hi}; return __builtin_bit_cast(unsigned, __builtin_convertvector(v, b2_)); }
__device__ __forceinline__ unsigned f2bf(float f) { return pk2(f, 0.f) & 0xffffu; }
__device__ __forceinline__ float rlane(float v, int l) { return __int_as_float(__builtin_amdgcn_readlane(__float_as_int(v), l)); }

__device__ __forceinline__ void transpose_item(const float* W, int ldw, int K, const float* gk, bf16* WT, int n_src0, int n_dst0, int k0, LAS float* scr, int lane) {
#pragma unroll 8
    for (int i = 0; i < 32; ++i) { const int kk = 2 * i + (lane >> 5); float v = W[(size_t)(k0 + kk) * ldw + n_src0 + (lane & 31)]; if (gk) v *= gk[k0 + kk]; scr[kk * 33 + (lane & 31)] = v; }
    asm volatile("s_waitcnt lgkmcnt(0)" ::: "memory");
    const int c = lane & 7;
#pragma unroll
    for (int j = 0; j < 4; ++j) { const int n = (lane >> 3) + 8 * j; const LAS float* s = scr + (8 * c) * 33 + n;
        v4u o; o.x = pk2(s[0 * 33], s[1 * 33]); o.y = pk2(s[2 * 33], s[3 * 33]); o.z = pk2(s[4 * 33], s[5 * 33]); o.w = pk2(s[6 * 33], s[7 * 33]);
        *(v4u*)(WT + (size_t)(n_dst0 + n) * K + k0 + 8 * c) = o; }
    asm volatile("s_waitcnt lgkmcnt(0)" ::: "memory");
}
__device__ __forceinline__ void load_wab(const Params& p, int l, LAS float* wab) {
    const float* W = p.w_in + (size_t)l * DM * INC; const float* g = p.pre_g + l * DM;
    for (int i = TIDX(); i < 8 * DM; i += NT) { const int k = i >> 3, j = i & 7; wab[j * DM + k] = W[(size_t)k * INC + 768 + j] * g[k]; }
}
__device__ __forceinline__ void row_prep(const float4 (&v)[4], int row, int lane, bf16* xb, float* rstd, float* ab, const LAS float* wab) {
    float ss = 0.f;
#pragma unroll
    for (int j = 0; j < 4; ++j) ss += v[j].x * v[j].x + v[j].y * v[j].y + v[j].z * v[j].z + v[j].w * v[j].w;
    ss = wave_sum(ss);
    const float rs = rsqrtf(ss * (1.0f / DM) + EPS);
    v2u* o8 = (v2u*)(xb + (size_t)row * DM) + lane;
#pragma unroll
    for (int j = 0; j < 4; ++j) { v2u w; w.x = pk2(v[j].x, v[j].y); w.y = pk2(v[j].z, v[j].w); o8[64 * j] = w; }
    float acc[8];
#pragma unroll
    for (int j8 = 0; j8 < 8; ++j8) { float a = 0.f;
#pragma unroll
        for (int j = 0; j < 4; ++j) { const f4 w = *(const LAS f4*)(wab + j8 * DM + 256 * j + 4 * lane); a += v[j].x * w.x + v[j].y * w.y + v[j].z * w.z + v[j].w * w.w; }
        acc[j8] = wave_sum(a); }
    if (lane == 0) { rstd[row] = rs;
        *(float4*)(ab + (size_t)row * 8) = make_float4(acc[0] * rs, acc[1] * rs, acc[2] * rs, acc[3] * rs);
        *(float4*)(ab + (size_t)row * 8 + 4) = make_float4(acc[4] * rs, acc[5] * rs, acc[6] * rs, acc[7] * rs); }
}

__device__ __forceinline__ void phase_prologue(const Params& p, LAS unsigned char* lds) {
    const int lane = TIDX() & 63, wave = TIDX() >> 6;
    LAS float* wab = (LAS float*)lds;
    load_wab(p, 0, wab);
    __syncthreads();
    LAS float* scr = (LAS float*)(lds + 32768 + wave * 12288);
    const int gw = BIDX() * NWAVES + wave, NGW = gridDim.x * NWAVES;
    bf16* win_t = (bf16*)(p.ws + WS_WIN); bf16* wout_t = (bf16*)(p.ws + WS_WOUT);
    constexpr int I_IN = (DM / 64) * (PC / 32), I_OUT = (DM / 64) * (DM / 32);
    for (int it = gw; it < DEPTH * (I_IN + I_OUT); it += NGW) {
        int r = it; const int l = r / (I_IN + I_OUT); r -= l * (I_IN + I_OUT);
        if (r < I_IN) { const int kb = r / (PC / 32), nb = r % (PC / 32), n0 = 32 * nb;
            transpose_item(p.w_in + (size_t)l * DM * INC, INC, DM, p.pre_g + l * DM, win_t + (size_t)l * PC * DM, n0 + (n0 >= 768 ? 8 : 0), n0, 64 * kb, scr, lane); }
        else { r -= I_IN; const int kb = r / (DM / 32), nb = r % (DM / 32);
            transpose_item(p.w_out + (size_t)l * DM * DM, DM, DM, nullptr, wout_t + (size_t)l * DM * DM, 32 * nb, 32 * nb, 64 * kb, scr, lane); }
    }
    bf16* xb = (bf16*)(p.ws + WS_XB); float* rstd = (float*)(p.ws + WS_RSTD); float* ab = (float*)(p.ws + WS_AB);
    float4 nx[4];
    if (gw < NTOK) {
#pragma unroll
        for (int j = 0; j < 4; ++j) nx[j] = ((const float4*)(p.x + (size_t)gw * DM) + lane)[64 * j]; }
#pragma unroll 1
    for (int row = gw; row < NTOK; row += NGW) {
        float4 v[4];
#pragma unroll
        for (int j = 0; j < 4; ++j) v[j] = nx[j];
        const int nrow = row + NGW;
        if (nrow < NTOK) {
#pragma unroll
            for (int j = 0; j < 4; ++j) nx[j] = ((const float4*)(p.x + (size_t)nrow * DM) + lane)[64 * j]; }
        row_prep(v, row, lane, xb, rstd, ab, wab);
    }
}

__device__ __forceinline__ void phase_post(const Params& p, int l, LAS unsigned char* lds) {
    const int lane = TIDX() & 63, wave = TIDX() >> 6;
    LAS float* wab = (LAS float*)lds;
    const bool more = (l + 1 < DEPTH);
    if (more) load_wab(p, l + 1, wab);
    __syncthreads();
    const int gw = BIDX() * NWAVES + wave, NGW = gridDim.x * NWAVES;
    const float* xin = (l == 0) ? p.x : p.out;
    const float* g = p.post_g + l * DM;
    bf16* xb = (bf16*)(p.ws + WS_XB); float* rstd = (float*)(p.ws + WS_RSTD); float* ab = (float*)(p.ws + WS_AB);
    float4 gg[4];
#pragma unroll
    for (int j = 0; j < 4; ++j) gg[j] = ((const float4*)g)[lane + 64 * j];
    v2u ny[4]; float4 nx[4];
    if (gw < NTOK) {
#pragma unroll
        for (int j = 0; j < 4; ++j) { ny[j] = ((const v2u*)((const bf16*)(p.ws + WS_PROJ) + (size_t)gw * DM) + lane)[64 * j]; nx[j] = ((const float4*)(xin + (size_t)gw * DM) + lane)[64 * j]; } }
#pragma unroll 1
    for (int row = gw; row < NTOK; row += NGW) {
        float4 v[4], xx[4]; float ss = 0.f;
#pragma unroll
        for (int j = 0; j < 4; ++j) { const v2u w = ny[j]; xx[j] = nx[j];
            v[j] = make_float4(__uint_as_float(w.x << 16), __uint_as_float(w.x & 0xffff0000u), __uint_as_float(w.y << 16), __uint_as_float(w.y & 0xffff0000u));
            ss += v[j].x * v[j].x + v[j].y * v[j].y + v[j].z * v[j].z + v[j].w * v[j].w; }
        const int nrow = row + NGW;
        if (nrow < NTOK) {
#pragma unroll
            for (int j = 0; j < 4; ++j) { ny[j] = ((const v2u*)((const bf16*)(p.ws + WS_PROJ) + (size_t)nrow * DM) + lane)[64 * j]; nx[j] = ((const float4*)(xin + (size_t)nrow * DM) + lane)[64 * j]; } }
        ss = wave_sum(ss);
        const float rs = rsqrtf(ss * (1.0f / DM) + EPS);
        float4* orow = (float4*)(p.out + (size_t)row * DM) + lane;
#pragma unroll
        for (int j = 0; j < 4; ++j) {
            v[j] = make_float4(xx[j].x + v[j].x * rs * gg[j].x, xx[j].y + v[j].y * rs * gg[j].y, xx[j].z + v[j].z * rs * gg[j].z, xx[j].w + v[j].w * rs * gg[j].w);
            orow[64 * j] = v[j]; }
        if (more) row_prep(v, row, lane, xb, rstd, ab, wab);
    }
}


__device__ __forceinline__ float wave_sum(float v) { return fwave_sum(v); }

__device__ __forceinline__ void phase_post2(const Params& p, int l, LAS unsigned char* lds) {
    const int lane = TIDX() & 63, wave = TIDX() >> 6;
    LAS float* wab = (LAS float*)lds;
    load_wab(p, l + 1, wab);
    __syncthreads();
    const int gw = BIDX() * NWAVES + wave, NGW = gridDim.x * NWAVES;
    const bf16* xb = (const bf16*)(p.ws + WS_XB); float* rstd = (float*)(p.ws + WS_RSTD); float* ab = (float*)(p.ws + WS_AB);
    for (int row = gw; row < NTOK; row += NGW) {
        const v2u* xr = (const v2u*)(xb + (size_t)row * DM) + lane;
        float4 v[4]; float ss = 0.f;
#pragma unroll
        for (int j = 0; j < 4; ++j) { const v2u w = xr[64 * j];
            v[j] = make_float4(__uint_as_float(w.x << 16), __uint_as_float(w.x & 0xffff0000u), __uint_as_float(w.y << 16), __uint_as_float(w.y & 0xffff0000u));
            ss += v[j].x * v[j].x + v[j].y * v[j].y + v[j].z * v[j].z + v[j].w * v[j].w; }
        ss = wave_sum(ss);
        const float rs = rsqrtf(ss * (1.0f / DM) + EPS);
        float acc[8];
#pragma unroll
        for (int j8 = 0; j8 < 8; ++j8) { float a = 0.f;
#pragma unroll
            for (int j = 0; j < 4; ++j) { const f4 w = *(const LAS f4*)(wab + j8 * DM + 256 * j + 4 * lane); a += v[j].x * w.x + v[j].y * w.y + v[j].z * w.z + v[j].w * w.w; }
            acc[j8] = wave_sum(a); }
        if (lane == 0) { rstd[row] = rs;
            *(float4*)(ab + (size_t)row * 8) = make_float4(acc[0] * rs, acc[1] * rs, acc[2] * rs, acc[3] * rs);
            *(float4*)(ab + (size_t)row * 8 + 4) = make_float4(acc[4] * rs, acc[5] * rs, acc[6] * rs, acc[7] * rs); }
    }
}
#define XB_TMO      128
#define XB_XCNT(j)  (256  + 64 * (j))
#define XB_XSUB(j)  (1280 + 64 * (j))
#define XB_XGEN(j)  (2304 + 64 * (j))
#define XB_TOP      3328
#define XB_TOPGEN   3392
#define XCD_BAR_WORDS 3456
#define XB_SPIN_CAP (1u << 18)

__device__ __forceinline__ unsigned xb_ld(unsigned* p)              { return __hip_atomic_load(p, __ATOMIC_RELAXED, __HIP_MEMORY_SCOPE_AGENT); }
__device__ __forceinline__ unsigned xb_add(unsigned* p, unsigned v) { return __hip_atomic_fetch_add(p, v, __ATOMIC_RELAXED, __HIP_MEMORY_SCOPE_AGENT); }
__device__ __forceinline__ unsigned xb_xcc_id() { return (unsigned)__builtin_amdgcn_s_getreg((3 << 11) | 20) & 0xFu; }
#define XB_SPIN(cond, bar) do { unsigned _sp = 0; while (cond) { __builtin_amdgcn_s_sleep(1); \
    if ((++_sp & 255u) == 0u) { if (xb_ld(&(bar)[XB_TMO])) break; if (_sp > XB_SPIN_CAP) { atomicAdd(&(bar)[XB_TMO], 1u); break; } } } } while (0)

struct XcdBarrier {
    unsigned* bar; unsigned x;
    volatile LAS unsigned* st;
};

__device__ __forceinline__ XcdBarrier xcd_barrier_post(unsigned* bar, volatile LAS unsigned* st) {
    XcdBarrier b; b.bar = bar; b.x = xb_xcc_id(); b.st = st;
    if (TIDX() == 0) (void)xb_add(&bar[XB_XCNT(b.x)], 1u);
    return b;
}
__device__ __forceinline__ void xcd_barrier_complete(unsigned* bar, unsigned x, unsigned& nloc, unsigned& nx) {
    const unsigned G = gridDim.x * gridDim.y * gridDim.z;
    unsigned sum, cnt, mine, sp = 0u;
    for (;;) {
        sum = 0u; cnt = 0u; mine = 0u;
#pragma unroll
        for (unsigned j = 0; j < 16; ++j) { const unsigned c = xb_ld(&bar[XB_XCNT(j)]); sum += c; cnt += (c > 0u) ? 1u : 0u; mine = (j == x) ? c : mine; }
        if (sum == G) break;
        __builtin_amdgcn_s_sleep(1);
        if ((++sp & 255u) == 0u) { if (xb_ld(&bar[XB_TMO])) break; if (sp > XB_SPIN_CAP) { atomicAdd(&bar[XB_TMO], 1u); break; } }
    }
    nloc = mine > 0u ? mine : 1u; nx = cnt > 0u ? cnt : 1u;
}

__device__ __forceinline__ void xcd_barrier(const XcdBarrier& b) {
    asm volatile("s_waitcnt vmcnt(0)" ::: "memory");
    __syncthreads();
    if (TIDX() == 0) {
        unsigned* bar = b.bar;
        __builtin_amdgcn_s_waitcnt(0);
        unsigned nloc = b.st[0], nx = b.st[1];
        if (nloc == 0u) { xcd_barrier_complete(bar, b.x, nloc, nx); b.st[0] = nloc; b.st[1] = nx; }
        const unsigned old = xb_add(&bar[XB_XSUB(b.x)], 1u);
        const unsigned gen = old / nloc;
        if (old + 1u == (gen + 1u) * nloc) {
            __builtin_amdgcn_fence(__ATOMIC_RELEASE, "agent");
            asm volatile("s_waitcnt vmcnt(0)" ::: "memory");
            const unsigned og = xb_add(&bar[XB_TOP], 1u);
            const unsigned tg = og / nx;
            if (og + 1u == (tg + 1u) * nx) xb_add(&bar[XB_TOPGEN], 1u);
            else XB_SPIN(xb_ld(&bar[XB_TOPGEN]) == tg, bar);
            __builtin_amdgcn_fence(__ATOMIC_ACQUIRE, "agent");
            xb_add(&bar[XB_XGEN(b.x)], 1u);
            asm volatile("s_waitcnt vmcnt(0)" ::: "memory");
        } else {
            XB_SPIN(xb_ld(&bar[XB_XGEN(b.x)]) == gen, bar);
            __builtin_amdgcn_fence(__ATOMIC_ACQUIRE, "agent");
            asm volatile("s_waitcnt vmcnt(0)" ::: "memory");
        }
    }
    __syncthreads();
}

namespace att {
typedef short bf16x8 __attribute__((ext_vector_type(8)));
typedef short s16x4 __attribute__((ext_vector_type(4)));
typedef float f32x16 __attribute__((ext_vector_type(16)));
constexpr int KCH = 1024, VOFF = 8192, BUFB = 16384, NSLOT = 4;
constexpr float NEG = -1e30f, LOG2E = 1.4426950408889634f;
__device__ __forceinline__ void glds16(const void* gsrc, unsigned lds_dst) { unsigned keep;
    asm volatile("s_mov_b32 %0, m0\n\ts_mov_b32 m0, %2\n\ts_nop 0\n\tglobal_load_lds_dwordx4 %1, off\n\ts_mov_b32 m0, %0" : "=&s"(keep) : "v"(gsrc), "s"(lds_dst) : "memory"); }
__device__ __forceinline__ unsigned cvtpk(float lo, float hi) { typedef float f2 __attribute__((ext_vector_type(2))); typedef __bf16 b2 __attribute__((ext_vector_type(2))); f2 v = {lo, hi}; b2 b = __builtin_convertvector(v, b2); return __builtin_bit_cast(unsigned, b); }
__device__ __forceinline__ s16x4 vtr(const LAS unsigned char* p) { return __builtin_bit_cast(s16x4, __builtin_amdgcn_ds_read_tr16_b64_v4i16((LAS s16x4*)p)); }
__device__ __forceinline__ unsigned scale_pk(unsigned w, float c) { return cvtpk(__uint_as_float(w << 16) * c, __uint_as_float(w & 0xffff0000u) * c); }
__device__ __forceinline__ float max16(const f32x16& a) {
    float m0 = fmaxf(fmaxf(a[0], a[1]), fmaxf(a[2], a[3])), m1 = fmaxf(fmaxf(a[4], a[5]), fmaxf(a[6], a[7]));
    float m2 = fmaxf(fmaxf(a[8], a[9]), fmaxf(a[10], a[11])), m3 = fmaxf(fmaxf(a[12], a[13]), fmaxf(a[14], a[15]));
    return fmaxf(fmaxf(m0, m1), fmaxf(m2, m3));
}

template <int MODE>
__device__ __forceinline__ void attn_unit(const Params& p, int l, int b, int h, int qb, LAS unsigned char* lds) {
    constexpr int NMAP = MODE == 0 ? 2 : 1, NKS = MODE == 0 ? 2 : 4;
    const int tid = TIDX(), lane = tid & 63, wid = __builtin_amdgcn_readfirstlane(tid >> 6), r32 = lane & 31, hi = lane >> 5;
    const bf16* P = (const bf16*)(p.ws + WS_PROJ) + (size_t)b * SEQ * PC;
    const int QC = (MODE == 0 ? C_DQ : C_MQ) + h * 64, KC = (MODE == 0 ? C_DK : C_MK) + h * 64, VC = (MODE == 0 ? C_DV : C_MV) + h * 64, ZC = (MODE == 0 ? C_DZ : C_MZ) + h * 64;
    const float slope = exp2f(-(float)(MODE == 0 ? 2 * h + 1 : 2 * h + 2));
    const float sl2 = slope * LOG2E;
    const float c1 = (MODE == 0 ? 0.17677669529663687f : 0.125f) * LOG2E;
    const int q0 = qb * 256 + wid * 32, qpos = q0 + r32;
    bf16x8 qf[NMAP][NKS];
#pragma unroll
    for (int mp = 0; mp < NMAP; ++mp)
#pragma unroll
        for (int ks = 0; ks < NKS; ++ks) { const v4u raw = *(const v4u*)(P + (size_t)qpos * PC + QC + mp * 32 + ks * 16 + hi * 8);
            v4u s; s.x = scale_pk(raw.x, c1); s.y = scale_pk(raw.y, c1); s.z = scale_pk(raw.z, c1); s.w = scale_pk(raw.w, c1); qf[mp][ks] = __builtin_bit_cast(bf16x8, s); }
    const bf16* zrow = P + (size_t)qpos * PC + ZC;
    v2u zpre[2][4];
#pragma unroll
    for (int d = 0; d < 2; ++d)
#pragma unroll
        for (int g4 = 0; g4 < 4; ++g4) zpre[d][g4] = *(const v2u*)(zrow + d * 32 + 8 * g4 + 4 * hi);
    unsigned sel = 0;
    if (MODE == 1) {
        const float* km = (const float*)(p.ws + WS_KMEAN) + (size_t)((b * NH + h) * 8) * 256;
        LAS float* kml = (LAS float*)(lds + NSLOT * BUFB + 64);
        __syncthreads();
        if (tid < qb * 64) { const int jj = tid >> 6, dd = tid & 63; kml[tid] = (km[jj * 256 + dd] + km[jj * 256 + 64 + dd]) + (km[jj * 256 + 128 + dd] + km[jj * 256 + 192 + dd]); }
        __syncthreads();
        float g[7];
#pragma unroll
        for (int j = 0; j < 7; ++j) { g[j] = -INFINITY;
            if (j < qb) { float s = 0.f;
#pragma unroll
                for (int ks = 0; ks < NKS; ++ks) { const v4u qq = __builtin_bit_cast(v4u, qf[0][ks]); const f4 k0 = *(const LAS f4*)(kml + j * 64 + ks * 16 + hi * 8), k1 = *(const LAS f4*)(kml + j * 64 + ks * 16 + hi * 8 + 4);
                    s += __uint_as_float(qq.x << 16) * k0.x + __uint_as_float(qq.x & 0xffff0000u) * k0.y + __uint_as_float(qq.y << 16) * k0.z + __uint_as_float(qq.y & 0xffff0000u) * k0.w
                       + __uint_as_float(qq.z << 16) * k1.x + __uint_as_float(qq.z & 0xffff0000u) * k1.y + __uint_as_float(qq.w << 16) * k1.z + __uint_as_float(qq.w & 0xffff0000u) * k1.w; }
                g[j] = xor32_sum(s); } }
#pragma unroll
        for (int r = 0; r < 3; ++r) { float best = -INFINITY; int bi = -1;
#pragma unroll
            for (int j = 0; j < 7; ++j) if (j < qb && !((sel >> j) & 1u) && g[j] > best) { best = g[j]; bi = j; }
            if (bi >= 0) sel |= 1u << bi; }
    }
    f32x16 cr;
#pragma unroll
    for (int r = 0; r < 16; ++r) cr[r] = sl2 * (float)((r & 3) + 8 * (r >> 2) + 4 * hi);
    const bf16* ksrc = P + (size_t)lane * PC + KC + wid * 8;
    const bf16* vsrc = P + (size_t)(16 * (wid & 3) + (lane >> 2)) * PC + VC + (wid >> 2) * 32 + (lane & 3) * 8;
    const int kdst = wid * 1024, vdst = VOFF + wid * 1024;
    const unsigned lds0 = (unsigned)(uintptr_t)lds;
#define ATT_DMA(T_) do { const unsigned sl_ = lds0 + (unsigned)(((T_) & (NSLOT - 1)) * BUFB); \
        glds16(ksrc + (size_t)(T_) * 64 * PC, (unsigned)__builtin_amdgcn_readfirstlane(sl_ + kdst)); \
        glds16(vsrc + (size_t)(T_) * 64 * PC, (unsigned)__builtin_amdgcn_readfirstlane(sl_ + vdst)); } while (0)
    const int koff = hi * KCH + r32 * 16;
    const int voff = VOFF + ((lane >> 4) & 1) * 32 + (lane & 3) * 8 + (4 * hi + ((lane & 15) >> 2)) * 64;
    f32x16 O[NMAP][2];
    float m[NMAP], lsum[NMAP];
#pragma unroll
    for (int mp = 0; mp < NMAP; ++mp) { m[mp] = NEG; lsum[mp] = 0.f;
#pragma unroll
        for (int d = 0; d < 2; ++d)
#pragma unroll
            for (int r = 0; r < 16; ++r) O[mp][d][r] = 0.f; }
    const int Tlast = 4 * qb + 3;
    __syncthreads();
    ATT_DMA(Tlast); ATT_DMA(Tlast - 1); ATT_DMA(Tlast - 2);
    for (int T = Tlast; T >= 0; --T) {
        if (T >= 2) asm volatile("s_waitcnt vmcnt(4)" ::: "memory"); else if (T == 1) asm volatile("s_waitcnt vmcnt(2)" ::: "memory"); else asm volatile("s_waitcnt vmcnt(0)" ::: "memory");
        __builtin_amdgcn_s_barrier();
        asm volatile("" ::: "memory");
        if (T >= 3) ATT_DMA(T - 3);
        const LAS unsigned char* kb = lds + (T & (NSLOT - 1)) * BUFB;
        bool selq = true; bool work = (64 * T <= q0 + 31);
        if (MODE == 1) { const int j = T >> 2; if (j < qb) { selq = (sel >> j) & 1u; work = work && __any(selq); } }
        if (work) {
            const bool diag = (64 * T + 63 > q0);
            const float tb0 = sl2 * (float)(64 * T - qb * 256), tb1 = tb0 + 32.f * sl2;
            unsigned pk[NMAP][2][2][4];
#pragma unroll
            for (int mp = 0; mp < NMAP; ++mp) {
                f32x16 u0 = cr, u1 = cr;
#pragma unroll
                for (int ks = 0; ks < NKS; ++ks) { const int cb = ((MODE == 0 ? 4 * mp : 0) + 2 * ks) * KCH;
                    const bf16x8 k0 = *(const LAS bf16x8*)(kb + koff + cb), k1 = *(const LAS bf16x8*)(kb + koff + cb + 512);
                    u0 = __builtin_amdgcn_mfma_f32_32x32x16_bf16(k0, qf[mp][ks], u0, 0, 0, 0);
                    u1 = __builtin_amdgcn_mfma_f32_32x32x16_bf16(k1, qf[mp][ks], u1, 0, 0, 0); }
                if (diag) { const int thr = qpos - 64 * T - 4 * hi;
#pragma unroll
                    for (int r = 0; r < 16; ++r) { const int c = (r & 3) + 8 * (r >> 2); if (c > thr) u0[r] = NEG; if (c + 32 > thr) u1[r] = NEG; } }
                float mu = fmaxf(max16(u0) + tb0, max16(u1) + tb1);
                if (MODE == 1) { if (!selq) mu = NEG; }
                mu = xor32_max(mu);
                const float mn = fmaxf(m[mp], mu);
                if (!__all(mn == m[mp])) { const float al = __builtin_amdgcn_exp2f(m[mp] - mn); lsum[mp] *= al;
#pragma unroll
                    for (int d = 0; d < 2; ++d)
#pragma unroll
                        for (int r = 0; r < 16; ++r) O[mp][d][r] *= al;
                    m[mp] = mn; }
                float ms0 = mn - tb0, ms1 = mn - tb1;
                if (MODE == 1) { if (!selq) { ms0 = 1e30f; ms1 = 1e30f; } }
                float ls = 0.f;
#pragma unroll
                for (int r = 0; r < 16; ++r) { u0[r] = __builtin_amdgcn_exp2f(u0[r] - ms0); u1[r] = __builtin_amdgcn_exp2f(u1[r] - ms1); ls += u0[r] + u1[r]; }
                lsum[mp] += ls;
#pragma unroll
                for (int s = 0; s < 2; ++s)
#pragma unroll
                    for (int i = 0; i < 4; ++i) { pk[mp][0][s][i] = cvtpk(u0[8 * s + 2 * i], u0[8 * s + 2 * i + 1]); pk[mp][1][s][i] = cvtpk(u1[8 * s + 2 * i], u1[8 * s + 2 * i + 1]); }
            }
#pragma unroll
            for (int d = 0; d < 2; ++d)
#pragma unroll
                for (int kh = 0; kh < 2; ++kh)
#pragma unroll
                    for (int s = 0; s < 2; ++s) {
                        const s16x4 lo = vtr(kb + voff + d * 4096 + kh * 2048 + s * 1024), hh = vtr(kb + voff + d * 4096 + kh * 2048 + s * 1024 + 512);
                        const bf16x8 vf = (bf16x8){lo[0], lo[1], lo[2], lo[3], hh[0], hh[1], hh[2], hh[3]};
#pragma unroll
                        for (int mp = 0; mp < NMAP; ++mp) { const v4u pw = {pk[mp][kh][s][0], pk[mp][kh][s][1], pk[mp][kh][s][2], pk[mp][kh][s][3]};
                            O[mp][d] = __builtin_amdgcn_mfma_f32_32x32x16_bf16(vf, __builtin_bit_cast(bf16x8, pw), O[mp][d], 0, 0, 0); }
                    }
        }
        asm volatile("s_waitcnt lgkmcnt(0)" ::: "memory");
    }
#undef ATT_DMA
    bf16* yrow = (bf16*)(p.ws + WS_Y) + ((size_t)b * SEQ + qpos) * DM + (MODE == 0 ? 768 : 512) + h * 64;
    if (MODE == 0) {
        const LAS float* cst = (const LAS float*)(lds + NSLOT * BUFB + 4096);
        const float lam = cst[0], lam_init = cst[1];
        const float l0 = xor32_sum(lsum[0]), l1 = xor32_sum(lsum[NMAP - 1]);
        const float i0 = 1.0f / l0, i1 = lam / l1;
        float ss = 0.f;
#pragma unroll
        for (int d = 0; d < 2; ++d)
#pragma unroll
            for (int r = 0; r < 16; ++r) { const float o = O[0][d][r] * i0 - O[NMAP - 1][d][r] * i1; O[0][d][r] = o; ss += o * o; }
        ss = xor32_sum(ss);
        const float rs = rsqrtf(ss * (1.0f / 64.0f) + EPS) * (1.0f - lam_init);
#pragma unroll
        for (int d = 0; d < 2; ++d)
#pragma unroll
            for (int g4 = 0; g4 < 4; ++g4) { const int dd = d * 32 + 8 * g4 + 4 * hi;
                const f4 gn = *(const LAS f4*)(cst + 16 + dd); const v2u z = zpre[d][g4];
                const float z0 = __uint_as_float(z.x << 16), z1 = __uint_as_float(z.x & 0xffff0000u), z2 = __uint_as_float(z.y << 16), z3 = __uint_as_float(z.y & 0xffff0000u);
                v2u w; w.x = cvtpk(O[0][d][4 * g4] * rs * gn.x * fsilu(z0), O[0][d][4 * g4 + 1] * rs * gn.y * fsilu(z1));
                w.y = cvtpk(O[0][d][4 * g4 + 2] * rs * gn.z * fsilu(z2), O[0][d][4 * g4 + 3] * rs * gn.w * fsilu(z3));
                *(v2u*)(yrow + dd) = w; }
    } else {
        const float l0 = xor32_sum(lsum[0]);
        const float i0 = 1.0f / l0;
#pragma unroll
        for (int d = 0; d < 2; ++d)
#pragma unroll
            for (int g4 = 0; g4 < 4; ++g4) { const int dd = d * 32 + 8 * g4 + 4 * hi;
                const v2u z = zpre[d][g4];
                const float z0 = __uint_as_float(z.x << 16), z1 = __uint_as_float(z.x & 0xffff0000u), z2 = __uint_as_float(z.y << 16), z3 = __uint_as_float(z.y & 0xffff0000u);
                v2u w; w.x = cvtpk(O[0][d][4 * g4] * i0 * fsilu(z0), O[0][d][4 * g4 + 1] * i0 * fsilu(z1));
                w.y = cvtpk(O[0][d][4 * g4 + 2] * i0 * fsilu(z2), O[0][d][4 * g4 + 3] * i0 * fsilu(z3));
                *(v2u*)(yrow + dd) = w; }
    }
}
}

__device__ __forceinline__ void phase_attn_mfma(const Params& p, int l, LAS unsigned char* lds) {
    for (int c = BIDX(); c < NB * NH * 4; c += gridDim.x) {
        const int bh = c >> 2, s = c & 3, b = bh >> 2, h = bh & 3;
        att::attn_unit<0>(p, l, b, h, 7 - s, lds);
        att::attn_unit<1>(p, l, b, h, 7 - s, lds);
        att::attn_unit<0>(p, l, b, h, s, lds);
        att::attn_unit<1>(p, l, b, h, s, lds);
    }
}

namespace scn {
typedef short bf16x8 __attribute__((ext_vector_type(8)));
typedef float f32x4 __attribute__((ext_vector_type(4)));
constexpr size_t CH_QT = 64 * 64 * 2, CH_OI = 64 * 64 * 2, CH_SL = 64 * 64 * 4, CH_M = 64 * 64 * 2, CH_DL = 64 * 4;
constexpr int NCH = NB * NH * 32;
constexpr size_t A_GST = 0, A_HST = 16 * MiB, A_GQT = 32 * MiB, A_HQT = 48 * MiB;
constexpr size_t B_GSL = 0, B_HSL = 32 * MiB, B_GMF = 64 * MiB, B_HDL = 96 * MiB;

__device__ __forceinline__ f32x4 mfma16(bf16x8 a, bf16x8 b, f32x4 c) { f32x4 r = __builtin_amdgcn_mfma_f32_16x16x32_bf16(a, b, c, 0, 0, 0); asm volatile("" : "+v"(r) : "v"(a), "v"(b)); return r; }
__device__ __forceinline__ float f_hi(float x) { return __uint_as_float(f2bf(x) << 16); }

template <int PART>
__device__ __forceinline__ void gdn_pre(const Params& p, int l, int item, LAS float* wl) {
    const int lane = TIDX() & 63, half = lane >> 5, j = lane & 31;
    const int ci = item >> 1, cb = (item & 1) * 32;
    const int b = ci >> 7, h = (ci >> 5) & 3, n = ci & 31, t0 = n * 64;
    const bf16* P = (const bf16*)(p.ws + WS_PROJ) + (size_t)b * SEQ * PC;
    const float* AB = (const float*)(p.ws + WS_AB) + (size_t)b * SEQ * 8;
    const float* cw = p.conv_w + (size_t)l * 4 * 768;
    const int cq_ = C_GQ + h * 64 + lane, ck_ = C_GK + h * 64 + lane, cv_ = C_GV + h * 64 + cb + j;
    float wq[4], wk[4], wv[4];
#pragma unroll
    for (int i = 0; i < 4; ++i) { wq[i] = cw[i * 768 + 0 + h * 64 + lane]; wk[i] = cw[i * 768 + 256 + h * 64 + lane]; wv[i] = cw[i * 768 + 512 + h * 64 + cb + j]; }
    const float Aexp = expf(p.a_log[l * NH + h]), dtb = p.dt_bias[l * NH + h];
    float xq[3] = {0.f, 0.f, 0.f}, xk[3] = {0.f, 0.f, 0.f}, xv[3] = {0.f, 0.f, 0.f};
    if (t0 > 0) {
#pragma unroll
        for (int i = 0; i < 3; ++i) { const bf16* pr = P + (size_t)(t0 - 3 + i) * PC; xq[i] = bf2f(pr[cq_]); xk[i] = bf2f(pr[ck_]); if (PART == 0) xv[i] = bf2f(pr[cv_]); }
    }
    float S[32];
#pragma unroll
    for (int i = 0; i < 32; ++i) S[i] = (PART == 1 && (32 * half + i) == (cb + j)) ? 1.f : 0.f;
    bf16* OI = (bf16*)(p.ws + WS_Y) + ((size_t)b * SEQ + t0) * DM + 0 + h * 64;
    bf16* QT = (bf16*)(p.ws + WS_XB + A_GQT + (size_t)ci * CH_QT);
    const LAS float* wk_ = wl + 32 * half; const LAS float* wq_ = wl + 64 + 32 * half;
    float nq, nk, nv = 0.f, na, nb;
    { const bf16* pr = P + (size_t)t0 * PC; nq = bf2f(pr[cq_]); nk = bf2f(pr[ck_]); if (PART == 0) nv = bf2f(pr[cv_]); na = AB[t0 * 8 + h]; nb = AB[t0 * 8 + 4 + h]; }
#pragma unroll 1
    for (int t = 0; t < 64; ++t) {
        const float cq = nq, ck = nk, cv = nv, ca = na, cb2 = nb;
        if (t + 1 < 64) { const bf16* pr = P + (size_t)(t0 + t + 1) * PC; nq = bf2f(pr[cq_]); nk = bf2f(pr[ck_]); if (PART == 0) nv = bf2f(pr[cv_]); na = AB[(t0 + t + 1) * 8 + h]; nb = AB[(t0 + t + 1) * 8 + 4 + h]; }
        float qc = wq[0] * xq[0] + wq[1] * xq[1] + wq[2] * xq[2] + wq[3] * cq;
        float kc = wk[0] * xk[0] + wk[1] * xk[1] + wk[2] * xk[2] + wk[3] * ck;
        xq[0] = xq[1]; xq[1] = xq[2]; xq[2] = cq; xk[0] = xk[1]; xk[1] = xk[2]; xk[2] = ck;
        float vc = 0.f;
        if (PART == 0) { vc = wv[0] * xv[0] + wv[1] * xv[1] + wv[2] * xv[2] + wv[3] * cv; xv[0] = xv[1]; xv[1] = xv[2]; xv[2] = cv; vc = fsilu(vc); }
        qc = fsilu(qc); kc = fsilu(kc);
        const float qss = fwave_sum(qc * qc), kss = fwave_sum(kc * kc);
        const float qn = qc * __builtin_amdgcn_rsqf(qss + EPS) * 0.125f, kn = kc * __builtin_amdgcn_rsqf(kss + EPS);
        const float g = -Aexp * fsoftplus(ca + dtb), beta = fsigmoid(cb2), eg = fexp(g);
        asm volatile("s_waitcnt lgkmcnt(0)" ::: "memory");
        wl[lane] = kn; wl[64 + lane] = qn;
        asm volatile("s_waitcnt lgkmcnt(0)" ::: "memory");
        float ks0 = 0.f, ks1 = 0.f, ks2 = 0.f, ks3 = 0.f;
#pragma unroll
        for (int i = 0; i < 32; i += 4) { const f4 k4 = *(const LAS f4*)(wk_ + i);
            S[i] *= eg; S[i + 1] *= eg; S[i + 2] *= eg; S[i + 3] *= eg;
            ks0 += k4.x * S[i]; ks1 += k4.y * S[i + 1]; ks2 += k4.z * S[i + 2]; ks3 += k4.w * S[i + 3]; }
        const float kS = xor32_sum((ks0 + ks1) + (ks2 + ks3));
        const float vn = beta * (vc - kS);
        float o0 = 0.f, o1 = 0.f, o2 = 0.f, o3 = 0.f;
#pragma unroll
        for (int i = 0; i < 32; i += 4) { const f4 k4 = *(const LAS f4*)(wk_ + i); const f4 q4 = *(const LAS f4*)(wq_ + i);
            S[i] += k4.x * vn; S[i + 1] += k4.y * vn; S[i + 2] += k4.z * vn; S[i + 3] += k4.w * vn;
            o0 += q4.x * S[i]; o1 += q4.y * S[i + 1]; o2 += q4.z * S[i + 2]; o3 += q4.w * S[i + 3]; }
        const float o = xor32_sum((o0 + o1) + (o2 + o3));
        if (half == 0) { if (PART == 1) QT[t * 64 + cb + j] = (bf16)f2bf(o); else OI[(size_t)t * DM + cb + j] = (bf16)f2bf(o); }
    }
    if (PART == 0) {
        float* SL = (float*)(p.ws + WS_SCR + B_GSL + (size_t)ci * CH_SL) + (cb + j) * 64 + 32 * half;
#pragma unroll
        for (int i = 0; i < 32; i += 4) *(float4*)(SL + i) = make_float4(S[i], S[i + 1], S[i + 2], S[i + 3]);
    } else {
        float* MF = (float*)(p.ws + WS_SCR + B_GMF + (size_t)ci * CH_SL) + (32 * half) * 64 + cb + j;
#pragma unroll
        for (int i = 0; i < 32; ++i) { MF[i * 64] = S[i]; if ((i & 7) == 7) asm volatile("" ::: "memory"); }
    }
}

__device__ __forceinline__ void hgrn_pre(const Params& p, int l, int ci, LAS float* wl) {
    const int lane = TIDX() & 63;
    const int b = ci >> 7, h = (ci >> 5) & 3, n = ci & 31, t0 = n * 64;
    const bf16* P = (const bf16*)(p.ws + WS_PROJ) + (size_t)b * SEQ * PC;
    float lb = 0.f;
    if (l == 1) { const float a0 = p.hgrn_lb[h * 64 + lane], a1 = p.hgrn_lb[GW + h * 64 + lane]; lb = 1.0f / (1.0f + expf(a0 - a1)); }
    float S[64];
#pragma unroll
    for (int d = 0; d < 64; ++d) S[d] = 0.f;
    float gam = 1.f;
    bf16* OI = (bf16*)(p.ws + WS_Y) + ((size_t)b * SEQ + t0) * DM + 256 + h * 64;
    bf16* QT = (bf16*)(p.ws + WS_XB + A_HQT + (size_t)ci * CH_QT);
    float nq, nf, nv;
    { const bf16* pr = P + (size_t)t0 * PC; nq = bf2f(pr[C_HQ + h * 64 + lane]); nf = bf2f(pr[C_HF + h * 64 + lane]); nv = bf2f(pr[C_HI + h * 64 + lane]); }
#pragma unroll 1
    for (int t = 0; t < 64; ++t) {
        const float cq = nq, cf = nf, vi = nv;
        if (t + 1 < 64) { const bf16* pr = P + (size_t)(t0 + t + 1) * PC; nq = bf2f(pr[C_HQ + h * 64 + lane]); nf = bf2f(pr[C_HF + h * 64 + lane]); nv = bf2f(pr[C_HI + h * 64 + lane]); }
        const float sg = fsigmoid(cf);
        const float fg = lb + (1.0f - lb) * sg;
        const float kk = (1.0f - lb) * (1.0f - sg);
        const float qq = fsilu(cq);
        gam *= fg;
        QT[t * 64 + lane] = (bf16)f2bf(qq * gam);
        asm volatile("s_waitcnt lgkmcnt(0)" ::: "memory");
        wl[lane] = fg; wl[64 + lane] = kk; wl[128 + lane] = qq;
        asm volatile("s_waitcnt lgkmcnt(0)" ::: "memory");
        float o0 = 0.f, o1 = 0.f, o2 = 0.f, o3 = 0.f;
#pragma unroll
        for (int d = 0; d < 64; d += 4) { const f4 f4_ = *(const LAS f4*)(wl + d); const f4 k4 = *(const LAS f4*)(wl + 64 + d); const f4 q4 = *(const LAS f4*)(wl + 128 + d);
            S[d] = f4_.x * S[d] + k4.x * vi; S[d + 1] = f4_.y * S[d + 1] + k4.y * vi; S[d + 2] = f4_.z * S[d + 2] + k4.z * vi; S[d + 3] = f4_.w * S[d + 3] + k4.w * vi;
            o0 += q4.x * S[d]; o1 += q4.y * S[d + 1]; o2 += q4.z * S[d + 2]; o3 += q4.w * S[d + 3]; }
        const float o = (o0 + o1) + (o2 + o3);
        OI[(size_t)t * DM + lane] = (bf16)f2bf(o);
    }
    float* SL = (float*)(p.ws + WS_SCR + B_HSL + (size_t)ci * CH_SL) + lane * 64;
#pragma unroll
    for (int d = 0; d < 64; d += 4) *(float4*)(SL + d) = make_float4(S[d], S[d + 1], S[d + 2], S[d + 3]);
    ((float*)(p.ws + WS_SCR + B_HDL + (size_t)ci * CH_DL))[lane] = gam;
}

__device__ __forceinline__ void kmean_item(const Params& p, int it) {
    const int lane = TIDX() & 63;
    const bf16* proj = (const bf16*)(p.ws + WS_PROJ); float* kmean = (float*)(p.ws + WS_KMEAN);
    const int sub = it & 3, j = (it >> 2) & 7, h = (it >> 5) & 3, b = it >> 7;
    const bf16* base = proj + ((size_t)b * SEQ + j * 256 + sub * 64) * PC + C_MK + h * 64 + lane;
    float acc[4] = {0.f, 0.f, 0.f, 0.f};
#pragma unroll
    for (int r0 = 0; r0 < 64; r0 += 16) { bf16 v[16];
#pragma unroll
        for (int i = 0; i < 16; ++i) v[i] = base[(size_t)(r0 + i) * PC];
#pragma unroll
        for (int i = 0; i < 16; ++i) acc[i & 3] += bf2f(v[i]); }
    kmean[(size_t)it * 64 + lane] = ((acc[0] + acc[1]) + (acc[2] + acc[3])) * (1.0f / 256.0f);
}

__device__ __forceinline__ void phase_pre(const Params& p, int l, LAS unsigned char* lds) {
    const int wave = TIDX() >> 6;
    LAS float* wl = (LAS float*)(lds + wave * 1024);
    const int gw = BIDX() * NWAVES + wave, NGW = gridDim.x * NWAVES;
    constexpr int N_G = 2 * NCH, N_H = NCH, N_K = NB * NH * 8;
    for (int it = gw; it < 2 * NCH; it += NGW) gdn_pre<1>(p, l, it, wl);
    for (int it = gw; it < 2 * NCH; it += NGW) gdn_pre<0>(p, l, it, wl);
    for (int it = gw; it < NCH; it += NGW) hgrn_pre(p, l, it, wl);
    for (int it = gw; it < N_K; it += NGW) kmean_item(p, it);
}

template <int KIND>
__device__ __forceinline__ void scan_unit(const Params& p, int l, int sp, LAS unsigned char* lds) {
    const int tid = TIDX(), lane = tid & 63, wid = __builtin_amdgcn_readfirstlane(tid >> 6), seq = wid >> 2, sl = wid & 3, c15 = lane & 15, g = lane >> 4;
    const int bh = sp * 2 + seq, dv = 16 * sl + c15;
    f32x4 S[4];
#pragma unroll
    for (int rb = 0; rb < 4; ++rb) S[rb] = (f32x4){0.f, 0.f, 0.f, 0.f};
    const unsigned char* SLb = p.ws + WS_SCR + (KIND == 0 ? B_GSL : B_HSL) + (size_t)bh * 32 * CH_SL;
    const unsigned char* MFb = p.ws + WS_SCR + B_GMF + (size_t)bh * 32 * CH_SL;
    const unsigned char* DLb = p.ws + WS_SCR + B_HDL + (size_t)bh * 32 * CH_DL;
    unsigned char* STb = p.ws + WS_XB + (KIND == 0 ? A_GST : A_HST) + (size_t)bh * 32 * CH_QT;
    constexpr int MP = 272;
    LAS unsigned char* mring = lds + seq * (3 * 64 * MP);
    const int mrow = 16 * sl + (lane >> 2), mq = (lane & 3) * 16;
    f32x4 ma[4], mb[4];
    f32x4 csl[4], nsl[4], cd[4], nd[4];
#define SCN_MLOAD(dst, n_) do { const float* MF_ = (const float*)(MFb + (size_t)(n_) * CH_SL) + mrow * 64 + mq; \
        _Pragma("unroll") for (int i = 0; i < 4; ++i) dst[i] = *(const f32x4*)(MF_ + 4 * i); } while (0)
#define SCN_MSTORE(src, n_) do { LAS unsigned char* d_ = mring + ((n_) % 3) * (64 * MP) + mrow * MP + mq * 4; \
        _Pragma("unroll") for (int i = 0; i < 4; ++i) *(LAS f32x4*)(d_ + 16 * i) = src[i]; } while (0)
#define SCN_SLOAD(dsl, dd, n_) do { const float* SL_ = (const float*)(SLb + (size_t)(n_) * CH_SL); \
        _Pragma("unroll") for (int rb = 0; rb < 4; ++rb) dsl[rb] = *(const f32x4*)(SL_ + dv * 64 + 16 * rb + 4 * g); \
        if (KIND == 1) { const float* DL_ = (const float*)(DLb + (size_t)(n_) * CH_DL); _Pragma("unroll") for (int rb = 0; rb < 4; ++rb) dd[rb] = *(const f32x4*)(DL_ + 16 * rb + 4 * g); } } while (0)
    __syncthreads();
    if (KIND == 0) { SCN_MLOAD(ma, 0); SCN_MSTORE(ma, 0); SCN_MLOAD(ma, 1); SCN_MLOAD(mb, 2); }
    SCN_SLOAD(nsl, nd, 0);
    __syncthreads();
#pragma unroll 1
    for (int n = 0; n < 32; ++n) {
#pragma unroll
        for (int i = 0; i < 4; ++i) { csl[i] = nsl[i]; if (KIND == 1) cd[i] = nd[i]; }
        if (n + 1 < 32) SCN_SLOAD(nsl, nd, n + 1);
        bf16* ST = (bf16*)(STb + (size_t)n * CH_QT) + dv * 64 + 4 * g;
#pragma unroll
        for (int rb = 0; rb < 4; ++rb) { v2u w; w.x = pk2(S[rb][0], S[rb][1]); w.y = pk2(S[rb][2], S[rb][3]); *(v2u*)(ST + 16 * rb) = w; }
        if (KIND == 0) {
            bf16x8 Bh[2], Bl[2];
#pragma unroll
            for (int ks = 0; ks < 2; ++ks) { const f32x4 a = S[2 * ks], c = S[2 * ks + 1];
                v4u w; w.x = pk2(a[0], a[1]); w.y = pk2(a[2], a[3]); w.z = pk2(c[0], c[1]); w.w = pk2(c[2], c[3]); Bh[ks] = __builtin_bit_cast(bf16x8, w);
                v4u x; x.x = pk2(a[0] - f_hi(a[0]), a[1] - f_hi(a[1])); x.y = pk2(a[2] - f_hi(a[2]), a[3] - f_hi(a[3])); x.z = pk2(c[0] - f_hi(c[0]), c[1] - f_hi(c[1])); x.w = pk2(c[2] - f_hi(c[2]), c[3] - f_hi(c[3])); Bl[ks] = __builtin_bit_cast(bf16x8, x); }
            const LAS unsigned char* mc = mring + (n % 3) * (64 * MP);
#pragma unroll
            for (int rb = 0; rb < 4; ++rb) { f32x4 acc = csl[rb];
#pragma unroll
                for (int ks = 0; ks < 2; ++ks) { const LAS unsigned char* mp_ = mc + (16 * rb + c15) * MP + (32 * ks + 4 * g) * 4;
                    const f32x4 m0 = *(const LAS f32x4*)mp_, m1 = *(const LAS f32x4*)(mp_ + 64); v4u hw, lw;
                    hw.x = pk2(m0[0], m0[1]); hw.y = pk2(m0[2], m0[3]); hw.z = pk2(m1[0], m1[1]); hw.w = pk2(m1[2], m1[3]);
                    lw.x = pk2(m0[0] - f_hi(m0[0]), m0[1] - f_hi(m0[1])); lw.y = pk2(m0[2] - f_hi(m0[2]), m0[3] - f_hi(m0[3])); lw.z = pk2(m1[0] - f_hi(m1[0]), m1[1] - f_hi(m1[1])); lw.w = pk2(m1[2] - f_hi(m1[2]), m1[3] - f_hi(m1[3]));
                    acc = mfma16(__builtin_bit_cast(bf16x8, lw), Bh[ks], acc);
                    acc = mfma16(__builtin_bit_cast(bf16x8, hw), Bl[ks], acc);
                    acc = mfma16(__builtin_bit_cast(bf16x8, hw), Bh[ks], acc); }
                S[rb] = acc; }
            if (n + 1 < 32) { if (n & 1) SCN_MSTORE(mb, n + 1); else SCN_MSTORE(ma, n + 1); }
            if (n + 3 < 32) { if (n & 1) SCN_MLOAD(mb, n + 3); else SCN_MLOAD(ma, n + 3); }
            __syncthreads();
        } else {
#pragma unroll
            for (int rb = 0; rb < 4; ++rb) S[rb] = cd[rb] * S[rb] + csl[rb];
        }
    }
#undef SCN_MLOAD
#undef SCN_MSTORE
#undef SCN_SLOAD
}

__device__ __forceinline__ float row16_sum(float v) {
    v += __int_as_float(__builtin_amdgcn_update_dpp(0, __float_as_int(v), 0xB1, 0xF, 0xF, true));
    v += __int_as_float(__builtin_amdgcn_update_dpp(0, __float_as_int(v), 0x4E, 0xF, 0xF, true));
    v += __int_as_float(__builtin_amdgcn_update_dpp(0, __float_as_int(v), 0x141, 0xF, 0xF, true));
    v += __int_as_float(__builtin_amdgcn_update_dpp(0, __float_as_int(v), 0x140, 0xF, 0xF, true));
    return v;
}

template <int KIND>
__device__ __forceinline__ void out_item(const Params& p, int l, int ci, bool dry) {
    const int lane = TIDX() & 63, c15 = lane & 15, g = lane >> 4;
    const int b = ci >> 7, h = (ci >> 5) & 3, n = ci & 31, t0 = n * 64;
    const bf16* P = (const bf16*)(p.ws + WS_PROJ) + ((size_t)b * SEQ + t0) * PC + (KIND == 0 ? C_GZ : C_HZ) + h * 64;
    bf16* Y = (bf16*)(p.ws + WS_Y) + ((size_t)b * SEQ + t0) * DM + (KIND == 0 ? 0 : 256) + h * 64;
    const bf16* QT = (const bf16*)(p.ws + WS_XB + (KIND == 0 ? A_GQT : A_HQT) + (size_t)ci * CH_QT);
    const bf16* ST = (const bf16*)(p.ws + WS_XB + (KIND == 0 ? A_GST : A_HST) + (size_t)ci * CH_QT);
    const float* ngp = (KIND == 0 ? p.gdn_g : p.hgrn_g) + l * HD;
    bf16x8 Bf[4][2];
#pragma unroll
    for (int cbk = 0; cbk < 4; ++cbk)
#pragma unroll
        for (int ks = 0; ks < 2; ++ks) Bf[cbk][ks] = *(const bf16x8*)(ST + (16 * cbk + c15) * 64 + 32 * ks + 8 * g);
    float ng[4];
#pragma unroll
    for (int cbk = 0; cbk < 4; ++cbk) ng[cbk] = ngp[16 * cbk + c15];
#pragma unroll
    for (int rb = 0; rb < 4; ++rb) {
        bf16x8 Af[2];
#pragma unroll
        for (int ks = 0; ks < 2; ++ks) Af[ks] = *(const bf16x8*)(QT + (16 * rb + c15) * 64 + 32 * ks + 8 * g);
        f32x4 o[4]; float zz[4][4];
#pragma unroll
        for (int cbk = 0; cbk < 4; ++cbk) {
            const bf16* yi = Y + (size_t)(16 * rb + 4 * g) * DM + 16 * cbk + c15; const bf16* zi = P + (size_t)(16 * rb + 4 * g) * PC + 16 * cbk + c15;
            o[cbk] = (f32x4){bf2f(yi[0]), bf2f(yi[DM]), bf2f(yi[2 * DM]), bf2f(yi[3 * DM])};
#pragma unroll
            for (int r = 0; r < 4; ++r) zz[cbk][r] = bf2f(zi[(size_t)r * PC]);
        }
#pragma unroll
        for (int cbk = 0; cbk < 4; ++cbk)
#pragma unroll
            for (int ks = 0; ks < 2; ++ks) o[cbk] = mfma16(Af[ks], Bf[cbk][ks], o[cbk]);
#pragma unroll
        for (int r = 0; r < 4; ++r) {
            float ss = o[0][r] * o[0][r] + o[1][r] * o[1][r] + o[2][r] * o[2][r] + o[3][r] * o[3][r];
            ss = row16_sum(ss);
            const float rs = rsqrtf(ss * (1.0f / 64.0f) + EPS);
#pragma unroll
            for (int cbk = 0; cbk < 4; ++cbk) { const bf16 ov = (bf16)f2bf(o[cbk][r] * rs * ng[cbk] * fsilu(zz[cbk][r])); if (dry) asm volatile("" :: "v"(ov)); else Y[(size_t)(16 * rb + 4 * g + r) * DM + 16 * cbk + c15] = ov; }
        }
    }
}
__device__ __forceinline__ void phase_out(const Params& p, int l, bool dry = false) {
    const int wave = TIDX() >> 6;
    const int gw = BIDX() * NWAVES + wave, NGW = gridDim.x * NWAVES;
    for (int it = gw; it < 2 * NCH; it += NGW) { if (it < NCH) out_item<0>(p, l, it, dry); else out_item<1>(p, l, it - NCH, dry); }
}
}

#ifndef REP_SCAN
#define REP_SCAN 1
#endif
#ifndef REP_ATT
#define REP_ATT 1
#endif
#ifndef REP_ATT_KIND
#define REP_ATT_KIND 2
#endif
#ifndef REP_ATT_QB
#define REP_ATT_QB 0
#endif
#ifndef REP_ATT_DRY
#define REP_ATT_DRY 0
#endif
__device__ __forceinline__ void phase_mix(const Params& p, int l, LAS unsigned char* lds) {
    const int c = BIDX();
    for (int rep = 0; rep < REP_SCAN; ++rep)
    for (int u = c; u < 64; u += gridDim.x) { if (u < 32) scn::scan_unit<0>(p, l, u, lds); else scn::scan_unit<1>(p, l, u - 32, lds); }
    LAS unsigned* bc = (LAS unsigned*)(lds + att::NSLOT * att::BUFB);
    {
        LAS float* cst = (LAS float*)(lds + att::NSLOT * att::BUFB + 4096);
        __syncthreads();
        if (TIDX() < 64) { const int lane = TIDX();
            float pr = (lane < 32) ? p.lq1[l * 32 + lane] * p.lk1[l * 32 + lane] : -(p.lq2[l * 32 + lane - 32] * p.lk2[l * 32 + lane - 32]);
#pragma unroll
            for (int o = 16; o > 0; o >>= 1) pr += __shfl_xor(pr, o);
            const float e_mine = expf(lane < 32 ? pr : -pr), e_other = __shfl_xor(e_mine, 32);
            const float lam_init = 0.8f - 0.6f * expf(-0.3f * (float)l);
            if (lane == 0) { cst[0] = e_mine - e_other + lam_init; cst[1] = lam_init; }
            cst[16 + lane] = p.diff_g[l * HD + lane]; }
    }
    for (int rep = 0; rep < REP_ATT; ++rep) {
    unsigned* ctr = (unsigned*)(p.ws + WS_CTL) + 64 * (1 + l + 2 * rep);
    for (;;) {
        __syncthreads();
        if (TIDX() == 0) bc[0] = atomicAdd(ctr, 1u);
        __syncthreads();
        const unsigned u = bc[0];
        if (u >= 1024u) break;
        const int kind = (int)(u >> 9), qb = 7 - (int)((u >> 6) & 7), bh = u & 63, b = bh >> 2, h = bh & 3;
        if (kind == 0) att::attn_unit<0>(p, l, b, h, qb, lds); else att::attn_unit<1>(p, l, b, h, qb, lds);
    }
    }
}

#ifndef GREP_S1A
#define GREP_S1A 1
#endif
#ifndef GREP_S1B
#define GREP_S1B 1
#endif
#ifndef GREP_S2A
#define GREP_S2A 1
#endif
#ifndef GREP_S2B
#define GREP_S2B 1
#endif
#ifndef GREP_S4
#define GREP_S4 1
#endif
#ifndef WY_OUTMASK
#define WY_OUTMASK 15
#endif
namespace wy {
typedef short bf16x8 __attribute__((ext_vector_type(8)));
typedef short bf16x4 __attribute__((ext_vector_type(4)));
typedef float f32x4 __attribute__((ext_vector_type(4)));
constexpr int LP = 72, ROWB = LP * 2;
__device__ __forceinline__ f32x4 mm32(const LAS unsigned char* X, int xr, const LAS unsigned char* Y, int yr, int k0, f32x4 acc, int c15, int g) {
    const bf16x8 a = *(const LAS bf16x8*)(X + (xr + c15) * ROWB + (k0 + 8 * g) * 2);
    const bf16x8 b = *(const LAS bf16x8*)(Y + (yr + c15) * ROWB + (k0 + 8 * g) * 2);
    f32x4 r = __builtin_amdgcn_mfma_f32_16x16x32_bf16(a, b, acc, 0, 0, 0);
    asm volatile("" : "+v"(r) : "v"(a), "v"(b));
    return r;
}
__device__ __forceinline__ f32x4 mm16(const LAS unsigned char* X, int xr, const LAS unsigned char* Y, int yr, int k0, f32x4 acc, int c15, int g) {
    const bf16x4 a = *(const LAS bf16x4*)(X + (xr + c15) * ROWB + (k0 + 4 * g) * 2);
    const bf16x4 b = *(const LAS bf16x4*)(Y + (yr + c15) * ROWB + (k0 + 4 * g) * 2);
    f32x4 r = __builtin_amdgcn_mfma_f32_16x16x16bf16_1k(a, b, acc, 0, 0, 0);
    asm volatile("" : "+v"(r) : "v"(a), "v"(b));
    return r;
}
__device__ __forceinline__ f32x4 zacc() { f32x4 z = (f32x4){0.f, 0.f, 0.f, 0.f}; asm volatile("" : "+v"(z)); return z; }
template <int KLEN>
__device__ __forceinline__ f32x4 mmk(const LAS unsigned char* X, int xr, const LAS unsigned char* Y, int yr, f32x4 acc, int c15, int g) {
#pragma unroll
    for (int k = 0; k + 32 <= KLEN; k += 32) acc = mm32(X, xr, Y, yr, k, acc, c15, g);
    if (KLEN % 32) acc = mm16(X, xr, Y, yr, KLEN - 16, acc, c15, g);
    return acc;
}
template <int NTL, int KLEN>
__device__ __forceinline__ void mm_batch(const LAS unsigned char* X, const int (&xr)[NTL], const LAS unsigned char* Y, const int (&yr)[NTL], f32x4 (&acc)[NTL], int c15, int g) {
#pragma unroll
    for (int k = 0; k + 32 <= KLEN; k += 32) { bf16x8 a[NTL], b[NTL];
#pragma unroll
        for (int t = 0; t < NTL; ++t) { a[t] = *(const LAS bf16x8*)(X + (xr[t] + c15) * ROWB + (k + 8 * g) * 2); b[t] = *(const LAS bf16x8*)(Y + (yr[t] + c15) * ROWB + (k + 8 * g) * 2); }
#pragma unroll
        for (int t = 0; t < NTL; ++t) { acc[t] = __builtin_amdgcn_mfma_f32_16x16x32_bf16(a[t], b[t], acc[t], 0, 0, 0); asm volatile("" : "+v"(acc[t]) : "v"(a[t]), "v"(b[t])); } }
    if (KLEN % 32) { bf16x4 a[NTL], b[NTL];
#pragma unroll
        for (int t = 0; t < NTL; ++t) { a[t] = *(const LAS bf16x4*)(X + (xr[t] + c15) * ROWB + (KLEN - 16 + 4 * g) * 2); b[t] = *(const LAS bf16x4*)(Y + (yr[t] + c15) * ROWB + (KLEN - 16 + 4 * g) * 2); }
#pragma unroll
        for (int t = 0; t < NTL; ++t) { acc[t] = __builtin_amdgcn_mfma_f32_16x16x16bf16_1k(a[t], b[t], acc[t], 0, 0, 0); asm volatile("" : "+v"(acc[t]) : "v"(a[t]), "v"(b[t])); } }
}
__device__ __forceinline__ float sum8_dpp(float v) {
    v += __int_as_float(__builtin_amdgcn_update_dpp(0, __float_as_int(v), 0xB1, 0xF, 0xF, true));
    v += __int_as_float(__builtin_amdgcn_update_dpp(0, __float_as_int(v), 0x4E, 0xF, 0xF, true));
    v += __int_as_float(__builtin_amdgcn_update_dpp(0, __float_as_int(v), 0x141, 0xF, 0xF, true));
    return v;
}
__device__ __forceinline__ void unpack8(const v4u w, float (&f)[8]) {
    f[0] = __uint_as_float(w.x << 16); f[1] = __uint_as_float(w.x & 0xffff0000u); f[2] = __uint_as_float(w.y << 16); f[3] = __uint_as_float(w.y & 0xffff0000u);
    f[4] = __uint_as_float(w.z << 16); f[5] = __uint_as_float(w.z & 0xffff0000u); f[6] = __uint_as_float(w.w << 16); f[7] = __uint_as_float(w.w & 0xffff0000u);
}
__device__ __forceinline__ v4u pack8(const float (&f)[8]) { v4u w; w.x = pk2(f[0], f[1]); w.y = pk2(f[2], f[3]); w.z = pk2(f[4], f[5]); w.w = pk2(f[6], f[7]); return w; }

struct GdnRaw { v4u q[4], k[4], v[4]; float ga, gb; };
__device__ __forceinline__ void gdn_load_raw(const Params& p, int ci, GdnRaw& R) {
    const int tid = TIDX(), tok = tid >> 3, c8 = tid & 7;
    const int b = ci >> 7, h = (ci >> 5) & 3, n = ci & 31, t0 = n * 64;
    const bf16* P = (const bf16*)(p.ws + WS_PROJ) + (size_t)b * SEQ * PC;
#pragma unroll
    for (int r = 0; r < 4; ++r) { const int row = t0 + tok - 3 + r, rowc = row < 0 ? 0 : row;
        const bf16* pr = P + (size_t)rowc * PC + h * 64 + 8 * c8;
        R.q[r] = *(const v4u*)(pr + C_GQ); R.k[r] = *(const v4u*)(pr + C_GK); R.v[r] = *(const v4u*)(pr + C_GV); }
    const float* AB = (const float*)(p.ws + WS_AB) + ((size_t)b * SEQ + t0 + tok) * 8;
    R.ga = AB[h]; R.gb = AB[4 + h];
}
constexpr int G_KH = 0, G_QH = 9216, G_VH = 18432, G_KTD = 27648, G_XT = 36864, G_AKK = 55296, G_AQK = 64512, G_TB = 73728, G_AD = 76800, G_SC = 80896;
constexpr int TBP = 24;
constexpr int G_CW = 132096;
constexpr int G_ST_MF = 83968, G_ST_SL = 101376, G_ST_QT = 118784, G_ST_Y = 0;
__device__ __forceinline__ void gdn_chunk(const Params& p, int l, int ci, int ci_next, GdnRaw& R, LAS unsigned char* lds) {
    const int tid = TIDX(), lane = tid & 63, wid = __builtin_amdgcn_readfirstlane(tid >> 6), c15 = lane & 15, g = lane >> 4;
    const int b = ci >> 7, h = (ci >> 5) & 3, n = ci & 31, t0 = n * 64;
    const bf16* P = (const bf16*)(p.ws + WS_PROJ) + (size_t)b * SEQ * PC;
    LAS float* sc_g = (LAS float*)(lds + G_SC); LAS float* sc_b = sc_g + 64; LAS float* sc_gc = sc_g + 128; LAS float* sc_eg = sc_g + 192; LAS float* sc_dl = sc_g + 256;
    __syncthreads();
    for (int rp_ = 0; rp_ < GREP_S1A; ++rp_) {
        const int tok = tid >> 3, c8 = tid & 7;
        float aq[8], ak[8], av[8];
#pragma unroll
        for (int i = 0; i < 8; ++i) { aq[i] = 0.f; ak[i] = 0.f; av[i] = 0.f; }
        f4 wgt[4][6];
        { const LAS float* wl_ = (const LAS float*)(lds + G_CW) + c8 * 96;
#pragma unroll
          for (int r = 0; r < 4; ++r)
#pragma unroll
              for (int j = 0; j < 6; ++j) wgt[r][j] = *(const LAS f4*)(wl_ + (r * 6 + j) * 4); }
#pragma unroll
        for (int r = 0; r < 4; ++r) {
            const float m = (t0 + tok - 3 + r) < 0 ? 0.f : 1.f;
            float xq[8], xk[8], xv[8];
            unpack8(R.q[r], xq); unpack8(R.k[r], xk); unpack8(R.v[r], xv);
            const float wq[8] = {wgt[r][0].x, wgt[r][0].y, wgt[r][0].z, wgt[r][0].w, wgt[r][1].x, wgt[r][1].y, wgt[r][1].z, wgt[r][1].w};
            const float wk[8] = {wgt[r][2].x, wgt[r][2].y, wgt[r][2].z, wgt[r][2].w, wgt[r][3].x, wgt[r][3].y, wgt[r][3].z, wgt[r][3].w};
            const float wv[8] = {wgt[r][4].x, wgt[r][4].y, wgt[r][4].z, wgt[r][4].w, wgt[r][5].x, wgt[r][5].y, wgt[r][5].z, wgt[r][5].w};
#pragma unroll
            for (int i = 0; i < 8; ++i) { aq[i] += m * wq[i] * xq[i]; ak[i] += m * wk[i] * xk[i]; av[i] += m * wv[i] * xv[i]; }
        }
        float sq = 0.f, sk = 0.f;
#pragma unroll
        for (int i = 0; i < 8; ++i) { aq[i] = fsilu(aq[i]); ak[i] = fsilu(ak[i]); av[i] = fsilu(av[i]); sq += aq[i] * aq[i]; sk += ak[i] * ak[i]; }
        sq = sum8_dpp(sq); sk = sum8_dpp(sk);
        const float rq = __builtin_amdgcn_rsqf(sq + EPS) * 0.125f, rk = __builtin_amdgcn_rsqf(sk + EPS);
#pragma unroll
        for (int i = 0; i < 8; ++i) { aq[i] *= rq; ak[i] *= rk; }
        *(LAS v4u*)(lds + G_QH + tok * ROWB + 16 * c8) = pack8(aq);
        *(LAS v4u*)(lds + G_KH + tok * ROWB + 16 * c8) = pack8(ak);
        *(LAS v4u*)(lds + G_VH + tok * ROWB + 16 * c8) = pack8(av);
        if (c8 == 0) { sc_g[tok] = -expf(p.a_log[l * NH + h]) * fsoftplus(R.ga + p.dt_bias[l * NH + h]); sc_b[tok] = fsigmoid(R.gb); }
    }
    __syncthreads();
    for (int rp_ = 0; rp_ < GREP_S1B; ++rp_) {
        const int d = tid & 63, tq = tid >> 6;
        float pre = 0.f, tot = 0.f;
#pragma unroll
        for (int j = 0; j < 64; j += 4) { const f4 g4 = *(const LAS f4*)(sc_g + j); const float s4 = (g4.x + g4.y) + (g4.z + g4.w); tot += s4; if (j < 8 * tq) pre += s4; }
        float gc[8], bt[8];
        { const f4 a = *(const LAS f4*)(sc_g + 8 * tq), c = *(const LAS f4*)(sc_g + 8 * tq + 4), b0 = *(const LAS f4*)(sc_b + 8 * tq), b1 = *(const LAS f4*)(sc_b + 8 * tq + 4);
          gc[0] = pre + a.x; gc[1] = gc[0] + a.y; gc[2] = gc[1] + a.z; gc[3] = gc[2] + a.w; gc[4] = gc[3] + c.x; gc[5] = gc[4] + c.y; gc[6] = gc[5] + c.z; gc[7] = gc[6] + c.w;
          bt[0] = b0.x; bt[1] = b0.y; bt[2] = b0.z; bt[3] = b0.w; bt[4] = b1.x; bt[5] = b1.y; bt[6] = b1.z; bt[7] = b1.w; }
        float xv[8], xw[8], xk[8];
#pragma unroll
        for (int i = 0; i < 8; ++i) { const float eg = fexp(gc[i]), ed = fexp(tot - gc[i]);
            const float kv = bf2f(*(const LAS bf16*)(lds + G_KH + (8 * tq + i) * ROWB + 2 * d)), vv = bf2f(*(const LAS bf16*)(lds + G_VH + (8 * tq + i) * ROWB + 2 * d));
            xv[i] = vv * bt[i]; xw[i] = kv * bt[i] * eg; xk[i] = kv * ed;
            if (d == 0) { sc_gc[8 * tq + i] = gc[i]; sc_eg[8 * tq + i] = eg; } }
        if (tid == 0) sc_dl[0] = fexp(tot);
        *(LAS v4u*)(lds + G_XT + d * ROWB + 16 * tq) = pack8(xv);
        *(LAS v4u*)(lds + G_XT + (64 + d) * ROWB + 16 * tq) = pack8(xw);
        *(LAS v4u*)(lds + G_KTD + d * ROWB + 16 * tq) = pack8(xk);
    }
    __syncthreads();
    for (int rp_ = 0; rp_ < GREP_S2A; ++rp_) {
#pragma unroll 1
        for (int step = 0; step < 2; ++step) {
            if (step == 1) __syncthreads();
            const bool isq = step == 1;
            if (isq && wid == 0) {
                const int blk = lane >> 4, c = lane & 15;
                const LAS float* Ad = (const LAS float*)(lds + G_AD) + blk * 256;
                float t[16];
#pragma unroll
                for (int i = 0; i < 16; ++i) { float s = (i == c) ? 1.f : 0.f;
#pragma unroll
                    for (int j = 0; j < i; ++j) s -= Ad[i * 16 + j] * t[j];
                    t[i] = s; *(LAS bf16*)(lds + G_TB + ((blk * 16 + i) * TBP + c) * 2) = (bf16)f2bf(s); }
            } else {
                for (int tt = isq ? wid - 1 : wid; tt < 10; tt += (isq ? 7 : 8)) {
                    const int I = (tt >= 6) ? 3 : (tt >= 3) ? 2 : (tt >= 1) ? 1 : 0, J = tt - (I * (I + 1)) / 2;
                    f32x4 acc = zacc();
                    acc = mmk<64>(lds + (isq ? G_QH : G_KH), 16 * I, lds + G_KH, 16 * J, acc, c15, g);
                    const int jj = 16 * J + c15; const float gj = sc_gc[jj];
#pragma unroll
                    for (int r = 0; r < 4; ++r) { const int ii = 16 * I + 4 * g + r; const float dec = fexp(sc_gc[ii] - gj);
                        if (isq) { const float v = (jj <= ii) ? acc[r] * dec : 0.f; *(LAS bf16*)(lds + G_AQK + ii * ROWB + 2 * jj) = (bf16)f2bf(v); }
                        else { const float v = (jj < ii) ? acc[r] * dec * sc_b[ii] : 0.f; *(LAS bf16*)(lds + G_AKK + ii * ROWB + 2 * jj) = (bf16)f2bf(-v);
                            if (I == J) ((LAS float*)(lds + G_AD))[I * 256 + (4 * g + r) * 16 + c15] = v; } }
                }
            }
        }
    }
    __syncthreads();
    {
        const int cb = 16 * wid;
#pragma unroll
        for (int I = 0; I < 4; ++I) {
            LAS unsigned char* xp = lds + G_XT + (cb + c15) * ROWB + (16 * I + 4 * g) * 2;
            const v2u rr = *(const LAS v2u*)xp;
            f32x4 acc = (f32x4){__uint_as_float(rr.x << 16), __uint_as_float(rr.x & 0xffff0000u), __uint_as_float(rr.y << 16), __uint_as_float(rr.y & 0xffff0000u)};
            if (I == 1) acc = mmk<16>(lds + G_AKK, 16, lds + G_XT, cb, acc, c15, g);
            if (I == 2) acc = mmk<32>(lds + G_AKK, 32, lds + G_XT, cb, acc, c15, g);
            if (I == 3) acc = mmk<48>(lds + G_AKK, 48, lds + G_XT, cb, acc, c15, g);
            const bf16x4 ta = *(const LAS bf16x4*)(lds + G_TB + ((I * 16 + c15) * TBP + 4 * g) * 2);
            v2u bw; bw.x = pk2(acc[0], acc[1]); bw.y = pk2(acc[2], acc[3]);
            const bf16x4 tb = __builtin_bit_cast(bf16x4, bw);
            f32x4 x = __builtin_amdgcn_mfma_f32_16x16x16bf16_1k(ta, tb, zacc(), 0, 0, 0);
            asm volatile("" : "+v"(x) : "v"(ta), "v"(tb));
            v2u xw; xw.x = pk2(x[0], x[1]); xw.y = pk2(x[2], x[3]);
            *(LAS v2u*)xp = xw;
            asm volatile("s_waitcnt lgkmcnt(0)" ::: "memory");
        }
    }
    __syncthreads();
    if (ci_next < scn::NCH) gdn_load_raw(p, ci_next, R);
    for (int rp_ = 0; rp_ < GREP_S4; ++rp_) {
        const int type = wid >> 1, hf = wid & 1;
        const float dlast = sc_dl[0];
        if (type < 2) {
#pragma unroll
            for (int half = 0; half < 2; ++half) {
                int xr[4], yr[4]; f32x4 acc[4];
#pragma unroll
                for (int i = 0; i < 4; ++i) { const int rb = 2 * half + (i >> 1), cbk = 2 * hf + (i & 1); acc[i] = zacc();
                    xr[i] = 16 * rb; yr[i] = (type == 0 ? 64 : 0) + 16 * cbk; }
                if (type == 0) mm_batch<4, 64>(lds + G_KTD, xr, lds + G_XT, yr, acc, c15, g);
                else { int yk[4];
#pragma unroll
                    for (int i = 0; i < 4; ++i) yk[i] = 16 * (2 * hf + (i & 1));
                    mm_batch<4, 64>(lds + G_XT, xr, lds + G_KTD, yk, acc, c15, g); }
#pragma unroll
                for (int i = 0; i < 4; ++i) { const int rb = 2 * half + (i >> 1), col = 16 * (2 * hf + (i & 1)) + c15;
#pragma unroll
                    for (int r = 0; r < 4; ++r) { const int row = 16 * rb + 4 * g + r;
                        if (type == 0) *(LAS float*)(lds + G_ST_MF + row * 272 + col * 4) = ((row == col) ? dlast : 0.f) - acc[i][r];
                        else *(LAS float*)(lds + G_ST_SL + row * 272 + col * 4) = acc[i][r]; } }
            }
        } else {
            const int ybase = (type == 2 ? 64 : 0);
#pragma unroll
            for (int rb = 0; rb < 4; ++rb) {
                int xr[2] = {16 * rb, 16 * rb}, yr[2] = {ybase + 16 * (2 * hf), ybase + 16 * (2 * hf + 1)}; f32x4 acc[2] = {zacc(), zacc()};
                if (rb == 0) mm_batch<2, 16>(lds + G_AQK, xr, lds + G_XT, yr, acc, c15, g);
                if (rb == 1) mm_batch<2, 32>(lds + G_AQK, xr, lds + G_XT, yr, acc, c15, g);
                if (rb == 2) mm_batch<2, 48>(lds + G_AQK, xr, lds + G_XT, yr, acc, c15, g);
                if (rb == 3) mm_batch<2, 64>(lds + G_AQK, xr, lds + G_XT, yr, acc, c15, g);
#pragma unroll
                for (int i = 0; i < 2; ++i) { const int col = 16 * (2 * hf + i) + c15;
#pragma unroll
                    for (int r = 0; r < 4; ++r) { const int row = 16 * rb + 4 * g + r;
                        if (type == 2) *(LAS bf16*)(lds + G_ST_QT + row * ROWB + 2 * col) = (bf16)f2bf(sc_eg[row] * bf2f(*(const LAS bf16*)(lds + G_QH + row * ROWB + 2 * col)) - acc[i][r]);
                        else *(LAS bf16*)(lds + G_ST_Y + row * ROWB + 2 * col) = (bf16)f2bf(acc[i][r]); } }
            }
        }
    }
    __syncthreads();
    {
        float* MF = (float*)(p.ws + WS_SCR + scn::B_GMF + (size_t)ci * scn::CH_SL);
        float* SL = (float*)(p.ws + WS_SCR + scn::B_GSL + (size_t)ci * scn::CH_SL);
        bf16* QT = (bf16*)(p.ws + WS_XB + scn::A_GQT + (size_t)ci * scn::CH_QT);
        bf16* Y = (bf16*)(p.ws + WS_Y) + ((size_t)b * SEQ + t0) * DM + 0 + h * 64;
#pragma unroll
        for (int i = 0; i < 2; ++i) { const int pz = tid + 512 * i, row = pz >> 4, c4 = pz & 15;
            *(v4u*)(MF + row * 64 + c4 * 4) = *(const LAS v4u*)(lds + G_ST_MF + row * 272 + c4 * 16);
            *(v4u*)(SL + row * 64 + c4 * 4) = *(const LAS v4u*)(lds + G_ST_SL + row * 272 + c4 * 16); }
        { const int row = tid >> 3, c8 = tid & 7;
            *(v4u*)(QT + row * 64 + c8 * 8) = *(const LAS v4u*)(lds + G_ST_QT + row * ROWB + c8 * 16);
            *(v4u*)(Y + (size_t)row * DM + c8 * 8) = *(const LAS v4u*)(lds + G_ST_Y + row * ROWB + c8 * 16); }
    }
}

struct HgrnRaw { bf16 q[8], f[8], v[8]; };
__device__ __forceinline__ void hgrn_load_raw(const Params& p, int ci, HgrnRaw& R) {
    const int tid = TIDX(), ch = tid & 63, tq = tid >> 6;
    const int b = ci >> 7, h = (ci >> 5) & 3, n = ci & 31, t0 = n * 64;
    const bf16* P = (const bf16*)(p.ws + WS_PROJ) + ((size_t)b * SEQ + t0) * PC + h * 64;
#pragma unroll
    for (int i = 0; i < 8; ++i) { const bf16* pr = P + (size_t)(8 * tq + i) * PC + ch; R.q[i] = pr[C_HQ]; R.f[i] = pr[C_HF]; R.v[i] = pr[C_HI]; }
}
constexpr int H_QD = 0, H_KD = 9216, H_QO = 18432, H_KO1 = 27648  , H_KO2 = 29952  , H_KO3 = 34560  , H_KTD = 41472, H_VT = 50688, H_A = 59904, H_SC = 69120  , H_ST_SL = 73728, H_ST_Y = 91136;
__device__ __forceinline__ void hgrn_chunk(const Params& p, int l, int ci, int ci_next, HgrnRaw& R, LAS unsigned char* lds) {
    const int tid = TIDX(), lane = tid & 63, wid = __builtin_amdgcn_readfirstlane(tid >> 6), c15 = lane & 15, g = lane >> 4;
    const int b = ci >> 7, h = (ci >> 5) & 3, n = ci & 31, t0 = n * 64;
    const bf16* P = (const bf16*)(p.ws + WS_PROJ) + ((size_t)b * SEQ + t0) * PC + h * 64;
    LAS float* s_tot = (LAS float*)(lds + H_SC); LAS float* s_gm = s_tot + 512; LAS float* s_gr = s_tot + 768;
    const int ch = tid & 63, tq = tid >> 6;
    float lb = 0.f;
    if (l == 1) { const float a0 = p.hgrn_lb[h * 64 + ch], a1 = p.hgrn_lb[GW + h * 64 + ch]; lb = __builtin_amdgcn_rcpf(1.0f + fexp(a0 - a1)); }
    float qv[8], kv[8], vv[8], G[8];
    {
        float run = 0.f;
#pragma unroll
        for (int i = 0; i < 8; ++i) {
            const float qr = bf2f(R.q[i]), fr = bf2f(R.f[i]); vv[i] = bf2f(R.v[i]);
            const float sg = fsigmoid(fr), fg = lb + (1.0f - lb) * sg;
            kv[i] = (1.0f - lb) * (1.0f - sg); qv[i] = fsilu(qr);
            run += 0.6931471805599453f * __builtin_amdgcn_logf(fg); G[i] = run; }
        __syncthreads();
        s_tot[tq * 64 + ch] = run;
    }
    __syncthreads();
    float Glast;
    {
        float pre = 0.f, tot = 0.f;
#pragma unroll
        for (int j = 0; j < 8; ++j) { const float tj = s_tot[j * 64 + ch]; tot += tj; if (j < tq) pre += tj; }
#pragma unroll
        for (int i = 0; i < 8; ++i) G[i] += pre;
        Glast = tot;
        if (tq & 1) s_gm[(tq >> 1) * 64 + ch] = G[0];
        else if (tq > 0) s_gr[(tq >> 1) * 64 + ch] = pre;
    }
    __syncthreads();
    {
        const int I = tq >> 1;
        const float gm = s_gm[I * 64 + ch], gr = (I > 0) ? s_gr[I * 64 + ch] : 0.f;
        const float gr1 = s_gr[64 + ch], gr2 = s_gr[128 + ch], gr3 = s_gr[192 + ch];
        bf16* QT = (bf16*)(p.ws + WS_XB + scn::A_HQT + (size_t)ci * scn::CH_QT);
        float kt[8];
#pragma unroll
        for (int i = 0; i < 8; ++i) { const int tok = 8 * tq + i;
            QT[tok * 64 + ch] = (bf16)f2bf(qv[i] * fexp(G[i]));
            *(LAS bf16*)(lds + H_QD + tok * ROWB + 2 * ch) = (bf16)f2bf(qv[i] * fexp(G[i] - gm));
            *(LAS bf16*)(lds + H_KD + tok * ROWB + 2 * ch) = (bf16)f2bf(kv[i] * fexp(gm - G[i]));
            if (I > 0) *(LAS bf16*)(lds + H_QO + tok * ROWB + 2 * ch) = (bf16)f2bf(qv[i] * fexp(G[i] - gr));
            if (I < 1) *(LAS bf16*)(lds + H_KO1 + tok * ROWB + 2 * ch) = (bf16)f2bf(kv[i] * fexp(gr1 - G[i]));
            if (I < 2) *(LAS bf16*)(lds + H_KO2 + tok * ROWB + 2 * ch) = (bf16)f2bf(kv[i] * fexp(gr2 - G[i]));
            if (I < 3) *(LAS bf16*)(lds + H_KO3 + tok * ROWB + 2 * ch) = (bf16)f2bf(kv[i] * fexp(gr3 - G[i]));
            kt[i] = kv[i] * fexp(Glast - G[i]); }
        *(LAS v4u*)(lds + H_KTD + ch * ROWB + 16 * tq) = pack8(kt);
        *(LAS v4u*)(lds + H_VT + ch * ROWB + 16 * tq) = pack8(vv);
        if (tq == 0) ((float*)(p.ws + WS_SCR + scn::B_HDL + (size_t)ci * scn::CH_DL))[ch] = fexp(Glast);
    }
    __syncthreads();
    if (ci_next < scn::NCH) hgrn_load_raw(p, ci_next, R);
    {
        for (int t = wid; t < 10; t += 8) {
            f32x4 acc = zacc();
            const int I = (t >= 6) ? 3 : (t >= 3) ? 2 : (t >= 1) ? 1 : 0, J = t - (I * (I + 1)) / 2;
            if (I == J) acc = mmk<64>(lds + H_QD, 16 * I, lds + H_KD, 16 * I, acc, c15, g);
            else acc = mmk<64>(lds + H_QO, 16 * I, lds + (I == 1 ? H_KO1 : I == 2 ? H_KO2 : H_KO3), 16 * J, acc, c15, g);
#pragma unroll
            for (int r = 0; r < 4; ++r) { const int ii = 16 * I + 4 * g + r, jj = 16 * J + c15; *(LAS bf16*)(lds + H_A + ii * ROWB + 2 * jj) = (bf16)f2bf((jj <= ii) ? acc[r] : 0.f); }
        }
        {
            int xr[2], yr[2]; f32x4 acc[2] = {zacc(), zacc()};
#pragma unroll
            for (int i = 0; i < 2; ++i) { const int u = wid + 8 * i; xr[i] = 16 * (u >> 2); yr[i] = 16 * (u & 3); }
            mm_batch<2, 64>(lds + H_VT, xr, lds + H_KTD, yr, acc, c15, g);
#pragma unroll
            for (int i = 0; i < 2; ++i) { const int u = wid + 8 * i, rb = u >> 2, cbk = u & 3;
#pragma unroll
                for (int r = 0; r < 4; ++r) *(LAS float*)(lds + H_ST_SL + (16 * rb + 4 * g + r) * 272 + (16 * cbk + c15) * 4) = acc[i][r]; }
        }
    }
    __syncthreads();
    {
        bf16* Y = (bf16*)(p.ws + WS_Y) + ((size_t)b * SEQ + t0) * DM + 256 + h * 64;
        {
            const int rb = wid >> 1, c0 = (wid & 1) * 2;
            int xr[2] = {16 * rb, 16 * rb}, yr[2] = {16 * c0, 16 * (c0 + 1)}; f32x4 acc[2] = {zacc(), zacc()};
            if (rb == 0) mm_batch<2, 16>(lds + H_A, xr, lds + H_VT, yr, acc, c15, g);
            else if (rb == 1) mm_batch<2, 32>(lds + H_A, xr, lds + H_VT, yr, acc, c15, g);
            else if (rb == 2) mm_batch<2, 48>(lds + H_A, xr, lds + H_VT, yr, acc, c15, g);
            else mm_batch<2, 64>(lds + H_A, xr, lds + H_VT, yr, acc, c15, g);
#pragma unroll
            for (int i = 0; i < 2; ++i)
#pragma unroll
                for (int r = 0; r < 4; ++r) *(LAS bf16*)(lds + H_ST_Y + (16 * rb + 4 * g + r) * ROWB + 2 * (16 * (c0 + i) + c15)) = (bf16)f2bf(acc[i][r]);
        }
        __syncthreads();
        float* SL = (float*)(p.ws + WS_SCR + scn::B_HSL + (size_t)ci * scn::CH_SL);
#pragma unroll
        for (int i = 0; i < 2; ++i) { const int pz = tid + 512 * i, row = pz >> 4, c4 = pz & 15; *(v4u*)(SL + row * 64 + c4 * 4) = *(const LAS v4u*)(lds + H_ST_SL + row * 272 + c4 * 16); }
        { const int row = tid >> 3, c8 = tid & 7; *(v4u*)(Y + (size_t)row * DM + c8 * 8) = *(const LAS v4u*)(lds + H_ST_Y + row * ROWB + c8 * 16); }
    }
}

#ifndef WY_GDN
#define WY_GDN 1
#endif
#ifndef WY_REP_G
#define WY_REP_G 1
#endif
#ifndef WY_REP_H
#define WY_REP_H 1
#endif
#ifndef WY_HGRN
#define WY_HGRN 1
#endif
__device__ __forceinline__ void phase_pre_mfma(const Params& p, int l, LAS unsigned char* lds) {
    const int wave = TIDX() >> 6;
    LAS float* wl = (LAS float*)(lds + 100 * 1024 + wave * 1024);
    const int gw = BIDX() * NWAVES + wave, NGW = gridDim.x * NWAVES;
    if (WY_GDN && WY_OUTMASK == 15) { for (int rep = 0; rep < WY_REP_G; ++rep) { GdnRaw R; if (BIDX() < scn::NCH) gdn_load_raw(p, BIDX(), R);
        { const int hh = (BIDX() >> 5) & 3; const float* cwp = p.conv_w + (size_t)l * 4 * 768 + hh * 64; LAS float* wl_ = (LAS float*)(lds + G_CW);
          __syncthreads();
          for (int i = TIDX(); i < 768; i += NT) { const int c8 = i / 96, rem = i % 96, r = rem / 24, j = (rem % 24) >> 2, e = rem & 3;
              wl_[i] = cwp[r * 768 + (j >> 1) * 256 + 8 * c8 + (j & 1) * 4 + e]; }
        } for (int ci = BIDX(); ci < scn::NCH; ci += gridDim.x) gdn_chunk(p, l, ci, ci + (int)gridDim.x, R, lds); } }
    else { for (int it = gw; it < 2 * scn::NCH; it += NGW) scn::gdn_pre<1>(p, l, it, wl); for (int it = gw; it < 2 * scn::NCH; it += NGW) scn::gdn_pre<0>(p, l, it, wl); }
    if (WY_HGRN) { for (int rep = 0; rep < WY_REP_H; ++rep) { HgrnRaw R; if (BIDX() < scn::NCH) hgrn_load_raw(p, BIDX(), R); for (int ci = BIDX(); ci < scn::NCH; ci += gridDim.x) hgrn_chunk(p, l, ci, ci + (int)gridDim.x, R, lds); } }
    else { __syncthreads(); for (int it = gw; it < scn::NCH; it += NGW) scn::hgrn_pre(p, l, it, wl); }
    __syncthreads();
    for (int it = gw; it < NB * NH * 8 * 4; it += NGW) scn::kmean_item(p, it);
}
}
#ifndef FUSED_POST
#define FUSED_POST 0
#endif
#ifndef GIN_ALIGN
#define GIN_ALIGN true
#endif
#ifndef GIN_SP2
#define GIN_SP2 true
#endif
#ifndef REP_PRE
#define REP_PRE 1
#endif
#ifndef REP_POST0
#define REP_POST0 1
#endif
#ifndef REP_PROLOGUE
#define REP_PROLOGUE 1
#endif
#ifndef REP_BAR
#define REP_BAR 1
#endif
#ifndef REP_GIN
#define REP_GIN 1
#endif
#ifndef REP_GOUT
#define REP_GOUT 1
#endif
#ifndef REP_OUT
#define REP_OUT 1
#endif
#ifndef REP_MIX
#define REP_MIX 1
#endif

__device__ __forceinline__ Params load_params() {
    const __attribute__((address_space(4))) Params* q = (const __attribute__((address_space(4))) Params*)__builtin_amdgcn_kernarg_segment_ptr();
    asm volatile("" : "+s"(q));
    return *(const Params*)q;
}
__device__ __forceinline__ void grid_barrier(LAS unsigned char* lds) {
    const Params p = load_params();
    XcdBarrier bar; bar.bar = (unsigned*)(p.ws + WS_CTL) + 4096; bar.x = xb_xcc_id(); bar.st = (volatile LAS unsigned*)(lds + 131072 + 64);
    xcd_barrier(bar);
}
__global__ void __launch_bounds__(NT, 2) fwd_megakernel(Params p_unused) {
    extern __shared__ __attribute__((aligned(16))) unsigned char lds_raw[];
    LAS unsigned char* lds = (LAS unsigned char*)lds_raw;
    {
        const Params p = load_params();
        volatile LAS unsigned* st = (volatile LAS unsigned*)(lds + 131072 + 64);
        if (TIDX() < 2) st[TIDX()] = 0u;
        __syncthreads();
        (void)xcd_barrier_post((unsigned*)(p.ws + WS_CTL) + 4096, st);
        for (int rep = 0; rep < REP_PROLOGUE; ++rep) phase_prologue(p, lds);
    }
    grid_barrier(lds);
#pragma unroll 1
    for (int l = 0; l < DEPTH; ++l) {
        for (int rep = 0; rep < REP_GIN; ++rep) {
            const Params p = load_params();
            pg8::Gemm g{(const bf16*)(p.ws + WS_XB), (const bf16*)(p.ws + WS_WIN) + (size_t)l * PC * DM, NTOK, PC, DM}; pg8::StaticOrder S; S.init(NTOK, PC, (int)gridDim.x, BIDX());
            pg8::EpiProj E{(bf16*)(p.ws + WS_PROJ), PC, (const float*)(p.ws + WS_RSTD)};
            pg8::gemm_phase<pg8::EpiProj, pg8::StaticOrder, GIN_ALIGN, GIN_SP2>(lds, g, S, E);
        }
        grid_barrier(lds);
        for (int rep = 0; rep < REP_PRE; ++rep) { const Params p = load_params(); wy::phase_pre_mfma(p, l, lds); }

        grid_barrier(lds);
        { const Params p = load_params(); phase_mix(p, l, lds); }
        for (int rep = 0; rep < REP_BAR; ++rep) grid_barrier(lds);
        for (int rep = 0; rep < REP_OUT; ++rep) { const Params p = load_params(); scn::phase_out(p, l, rep + 1 < REP_OUT); }
        grid_barrier(lds);
#if FUSED_POST
#pragma unroll 1
        for (int hf = 0; hf < 2; ++hf) {
            const Params p = load_params();
            const bool more = (l + 1 < DEPTH);
            const size_t ro = (size_t)hf * (NTOK / 2);
            pg8::Gemm g{(const bf16*)(p.ws + WS_Y) + ro * DM, (const bf16*)(p.ws + WS_WOUT) + (size_t)l * DM * DM, NTOK / 2, DM, DM}; pg8::StaticOrder S; S.init(NTOK / 2, DM, (int)gridDim.x, BIDX());
            pg8::PanelSsq st{(float*)(p.ws + WS_CTL + 262144), nullptr, (unsigned*)(p.ws + WS_CTL) + 2, EPS};
            pg8::EpiRmsRes E{(l == 0) ? p.x : p.out, p.out, more ? (bf16*)(p.ws + WS_XB) : nullptr, p.post_g + l * DM, DM, (int)ro, st, (unsigned*)(p.ws + WS_CTL) + 8192 + (l * 2 + hf) * 1024};
            pg8::gemm_phase<pg8::EpiRmsRes, pg8::StaticOrder, false, true>(lds, g, S, E);
        }
        grid_barrier(lds);
        if (l + 1 < DEPTH) { { const Params p = load_params(); phase_post2(p, l, lds); } grid_barrier(lds); }
#else
        for (int rep = 0; rep < REP_GOUT; ++rep) {
            const Params p = load_params();
            pg8::Gemm g{(const bf16*)(p.ws + WS_Y), (const bf16*)(p.ws + WS_WOUT) + (size_t)l * DM * DM, NTOK, DM, DM}; pg8::StaticOrder S; S.init(NTOK, DM, (int)gridDim.x, BIDX());
            pg8::EpiBf16Plain E{(bf16*)(p.ws + WS_PROJ), DM};
            pg8::gemm_phase<pg8::EpiBf16Plain, pg8::StaticOrder, true, true>(lds, g, S, E);
        }
        grid_barrier(lds);
        for (int rep = 0; rep < ((l == 0) ? REP_POST0 : 1); ++rep) { const Params p = load_params(); phase_post(p, l, lds); }
        grid_barrier(lds);
#endif
    }
}

extern "C" void kernel_launch(void* const* d_in, const int* in_sizes, int n_in, void* d_out, int out_size, void* d_ws, size_t ws_size, hipStream_t stream) {
    static int grid_blocks = 0;
    if (!grid_blocks) {
        if (ws_size < WS_END) { fprintf(stderr, "workspace too small: %zu < %zu\n", ws_size, (size_t)WS_END); grid_blocks = -1; return; }
        int dev = 0, cus = 0, per_cu = 0;
        (void)hipGetDevice(&dev);
        (void)hipDeviceGetAttribute(&cus, hipDeviceAttributeMultiprocessorCount, dev);
        (void)hipFuncSetAttribute((const void*)fwd_megakernel, hipFuncAttributeMaxDynamicSharedMemorySize, LDS_BYTES);
        (void)hipOccupancyMaxActiveBlocksPerMultiprocessor(&per_cu, (const void*)fwd_megakernel, NT, LDS_BYTES);
        if (per_cu < 1) { fprintf(stderr, "occupancy query says %d blocks/CU\n", per_cu); per_cu = 1; }
        grid_blocks = cus * 1;
    }
    if (grid_blocks < 0) return;
    (void)hipMemsetAsync((char*)d_ws + WS_CTL, 0, 65536, stream);
    Params p{};
    p.x = (const float*)d_in[0]; p.pre_g = (const float*)d_in[1]; p.post_g = (const float*)d_in[2]; p.w_in = (const float*)d_in[3];
    p.conv_w = (const float*)d_in[4]; p.a_log = (const float*)d_in[5]; p.dt_bias = (const float*)d_in[6]; p.gdn_g = (const float*)d_in[7];
    p.hgrn_lb = (const float*)d_in[8]; p.hgrn_g = (const float*)d_in[9]; p.lq1 = (const float*)d_in[10]; p.lk1 = (const float*)d_in[11];
    p.lq2 = (const float*)d_in[12]; p.lk2 = (const float*)d_in[13]; p.diff_g = (const float*)d_in[14]; p.w_out = (const float*)d_in[15];
    p.out = (float*)d_out; p.ws = (unsigned char*)d_ws;
    void* args[] = {&p};
    hipError_t e = hipLaunchCooperativeKernel((void*)fwd_megakernel, dim3(grid_blocks), dim3(NT), args, LDS_BYTES, stream);
    if (e != hipSuccess) fprintf(stderr, "cooperative launch failed: %s (grid %d)\n", hipGetErrorString(e), grid_blocks);
}
```
